# Optimizing an MI355X kernel written in HIP

```python
import jax, jax.numpy as jnp
from jax import lax
import numpy as np

D_MODEL = 2048
BATCH = 2
SEQ = 8192
DEPTH = 1

CHUNK = 64
D_MIX = D_MODEL
CONV_WIDTH = D_MIX // 2
CONV_HEADS = 8
CONV_HEAD_DIM = CONV_WIDTH // CONV_HEADS
CONV_K = 3
POOL_WIDTH = D_MIX - CONV_WIDTH
POOL_WINDOWS = (2, 4, 8, 16)
N_POOL_GROUPS = len(POOL_WINDOWS)
POOL_GROUP_DIM = POOL_WIDTH // N_POOL_GROUPS
IN_PROJ_WIDTH = 3 * CONV_WIDTH + POOL_WIDTH
D_FF = ((8 * D_MODEL // 3 + 255) // 256) * 256
EPS = 1e-6

kernel_name = "hybrid_shortconv_multiscale_pool_block"


def rms_norm(x, g):
    xf = x.astype(jnp.float32)
    y = xf * lax.rsqrt(jnp.mean(xf * xf, axis=-1, keepdims=True) + EPS)
    return (y * g.astype(jnp.float32)).astype(x.dtype)


def rms_norm_plain(x):
    xf = x.astype(jnp.float32)
    y = xf * lax.rsqrt(jnp.mean(xf * xf, axis=-1, keepdims=True) + EPS)
    return y.astype(x.dtype)


def short_conv_causal(u, w):
    c = u.shape[-1]
    rhs = w[:, None, :].astype(u.dtype)
    return lax.conv_general_dilated(
        u, rhs, window_strides=(1,), padding=[(CONV_K - 1, 0)],
        dimension_numbers=("NWC", "WIO", "NWC"), feature_group_count=c)


def multiscale_pool_causal(v):
    bn, s, _ = v.shape
    vg = v.reshape(bn, s, N_POOL_GROUPS, POOL_GROUP_DIM).astype(jnp.float32)
    cs = jnp.cumsum(vg, axis=1)
    pos = jnp.arange(1, s + 1, dtype=jnp.float32)
    outs = []
    for gi, w in enumerate(POOL_WINDOWS):
        c = cs[:, :, gi]
        prev = jnp.pad(c, ((0, 0), (w, 0), (0, 0)))[:, :s]
        cnt = jnp.minimum(pos, float(w))[None, :, None]
        outs.append((c - prev) / cnt - vg[:, :, gi])
    return jnp.stack(outs, axis=2)


def setup_inputs(seed: int = 0) -> dict:
    key = jax.random.key(seed)
    ks = jax.random.split(key, 16)
    L = DEPTH

    def nrm(k, shape, fan_in):
        return jax.random.normal(k, shape, jnp.float32) * (fan_in ** -0.5)

    def gain(k, shape):
        return 1.0 + 0.05 * jax.random.normal(k, shape, jnp.float32)

    return {
        "x": jax.random.normal(ks[0], (BATCH, SEQ, D_MODEL), jnp.float32),
        "ln_mix_pre": gain(ks[1], (L, D_MODEL)),
        "w_in": nrm(ks[2], (L, D_MODEL, IN_PROJ_WIDTH), D_MODEL),
        "conv_w": nrm(ks[3], (L, CONV_K, CONV_WIDTH), CONV_K),
        "pool_w": nrm(ks[4], (L, N_POOL_GROUPS, POOL_GROUP_DIM, POOL_GROUP_DIM), POOL_GROUP_DIM),
        "pool_scale": gain(ks[5], (L, POOL_WIDTH)),
        "w_out": nrm(ks[6], (L, D_MIX, D_MODEL), D_MIX),
        "ln_mix_post": gain(ks[7], (L, D_MODEL)),
        "ln_ffn_pre": gain(ks[8], (L, D_MODEL)),
        "w_gate": nrm(ks[9], (L, D_MODEL, D_FF), D_MODEL),
        "w_up": nrm(ks[10], (L, D_MODEL, D_FF), D_MODEL),
        "w_down": nrm(ks[11], (L, D_FF, D_MODEL), D_FF),
        "ln_ffn_post": gain(ks[12], (L, D_MODEL)),
    }


def reference(x, ln_mix_pre, w_in, conv_w, pool_w, pool_scale, w_out, ln_mix_post,
              ln_ffn_pre, w_gate, w_up, w_down, ln_ffn_post):
    bn, s, _ = x.shape
    for l in range(DEPTH):
        h = rms_norm(x, ln_mix_pre[l])
        proj = jnp.einsum("bsd,de->bse", h, w_in[l])
        gate_b, gate_c, u, v = jnp.split(
            proj, [CONV_WIDTH, 2 * CONV_WIDTH, 3 * CONV_WIDTH], axis=-1)

        y_conv = gate_b * short_conv_causal(gate_c * u, conv_w[l])
        y_conv = rms_norm_plain(y_conv.reshape(bn, s, CONV_HEADS, CONV_HEAD_DIM))
        y_conv = y_conv.reshape(bn, s, CONV_WIDTH)

        pooled = multiscale_pool_causal(v).astype(v.dtype)
        y_pool = jnp.einsum("bsgc,gcd->bsgd", pooled, pool_w[l])
        y_pool = rms_norm_plain(y_pool).reshape(bn, s, POOL_WIDTH) * pool_scale[l]

        mixed = jnp.concatenate([y_conv, y_pool], axis=-1)
        mix_out = jnp.einsum("bse,ed->bsd", mixed, w_out[l])
        x = x + rms_norm(mix_out, ln_mix_post[l])

        hf = rms_norm(x, ln_ffn_pre[l])
        g = jnp.einsum("bsd,df->bsf", hf, w_gate[l])
        up = jnp.einsum("bsd,df->bsf", hf, w_up[l])
        ff = jnp.einsum("bsf,fd->bsd", jax.nn.silu(g) * up, w_down[l])
        x = x + rms_norm(ff, ln_ffn_post[l])
    return x
```

```cpp
#include <hip/hip_runtime.h>
#include <hip/hip_cooperative_groups.h>
#include <cstdio>
#include <cstdint>
namespace cg = cooperative_groups;
namespace pg8 {
#define PG8_LAS __attribute__((address_space(3)))
typedef unsigned short bf16_t;
typedef short bf16x8 __attribute__((ext_vector_type(8)));
typedef float f32x4 __attribute__((ext_vector_type(4)));
typedef unsigned u32x4 __attribute__((ext_vector_type(4)));
constexpr int BM = 256, BK = 64, HALF = 128, HTB = HALF * BK * 2  , STAGE_BYTES = 8 * HTB, NXCD = 8, WGM = 8;

__host__ __device__ __forceinline__ int lds_byte(int r, int c) { const int st = (r >> 4) * 2 + (c >> 5), rr = r & 15, cc = c & 31, ob = rr * 64 + cc * 2; return st * 1024 + (ob ^ (((ob >> 9) & 1) << 5)); }
__host__ __device__ __forceinline__ void stage_rc(int b, int& R, int& C) { const int st = b / 1024, sb = b % 1024, swz = sb ^ (((sb >> 9) & 1) << 5); R = (st >> 1) * 16 + swz / 64; C = (st & 1) * 32 + (swz % 64) / 2; }
__host__ __device__ __forceinline__ int perm32(int rho) { const int n = rho >> 4, i = rho & 15; return 8 * (i >> 2) + 4 * n + (i & 3); }

struct Unit { int pm, pn; };
struct Gemm { const bf16_t* A; const bf16_t* Bt; int M, N, K; int bdiv; };
__device__ __forceinline__ int btile(const Gemm& g, const Unit& u) { return u.pn + (g.bdiv ? (u.pm / g.bdiv) * (g.N / BM) : 0); }

struct StaticOrder {
    int nM, nN, nwg, G, c;
    __host__ __device__ void init(int M, int N, int G_, int c_) { nM = M / BM; nN = N / BM; nwg = nM * nN; G = G_; c = c_; }
    __host__ __device__ bool next(int i, Unit& u) const {
        const long L = (long)i * G + c; if (L >= nwg) return false;
        int wgid = (int)L; { const int q = nwg / NXCD, r = nwg % NXCD, xcd = wgid % NXCD, off = wgid / NXCD; wgid = (xcd < r ? xcd * (q + 1) : r * (q + 1) + (xcd - r) * q) + off; }
        const int nig = WGM * nN, gid = wgid / nig, fm = gid * WGM, gsz = (nM - fm) < WGM ? (nM - fm) : WGM;
        u.pm = fm + ((wgid % nig) % gsz); u.pn = (wgid % nig) / gsz; return true;
    }
    __device__ __forceinline__ void a_ready(const Unit&) const {}
    __device__ __forceinline__ void done(const Unit&) const {}
};

__device__ __forceinline__ unsigned cvt_pk_bf16(float lo, float hi) { unsigned r; asm volatile("v_cvt_pk_bf16_f32 %0, %1, %2" : "=v"(r) : "v"(lo), "v"(hi)); return r; }

struct EpiBf16 {
    static constexpr bool PERM = true, AFTER_DRAIN = false;
    bf16_t* O; int ldc;
    __device__ __forceinline__ void operator()(const f32x4 (&acc)[2][2][4][2], const Unit& u, int wr, int wc, int fr, int fq) const {
        const int row0 = u.pm * BM + wr * 64 + fr; const int col0 = u.pn * BM + wc * 32 + 8 * fq;
#pragma unroll
        for (int ai = 0; ai < 2; ++ai)
#pragma unroll
            for (int m = 0; m < 4; ++m) { bf16_t* rowp = O + (size_t)(row0 + ai * HALF + m * 16) * ldc + col0;
#pragma unroll
                for (int bj = 0; bj < 2; ++bj) { const f32x4 v0 = acc[ai][bj][m][0], v1 = acc[ai][bj][m][1];
                    u32x4 w; w.x = cvt_pk_bf16(v0[0], v0[1]); w.y = cvt_pk_bf16(v0[2], v0[3]); w.z = cvt_pk_bf16(v1[0], v1[1]); w.w = cvt_pk_bf16(v1[2], v1[3]);
                    *(u32x4*)(rowp + bj * HALF) = w; } }
    }
};

__device__ __forceinline__ float silu_mul(float g, float u) { const float e = __builtin_amdgcn_exp2f(g * -1.4426950408889634f); return g * __builtin_amdgcn_rcpf(1.0f + e) * u; }
struct EpiSwiGLU {
    static constexpr bool PERM = true, AFTER_DRAIN = false;
    bf16_t* O; int ldc;
    __device__ __forceinline__ void operator()(const f32x4 (&acc)[2][2][4][2], const Unit& u, int wr, int wc, int fr, int fq) const {
        const int row0 = u.pm * BM + wr * 64 + fr; const int col0 = u.pn * HALF + wc * 32 + 8 * fq;
#pragma unroll
        for (int ai = 0; ai < 2; ++ai)
#pragma unroll
            for (int m = 0; m < 4; ++m) { bf16_t* rowp = O + (size_t)(row0 + ai * HALF + m * 16) * ldc + col0;
                const f32x4 g0 = acc[ai][0][m][0], g1 = acc[ai][0][m][1], u0 = acc[ai][1][m][0], u1 = acc[ai][1][m][1];
                u32x4 w; w.x = cvt_pk_bf16(silu_mul(g0[0], u0[0]), silu_mul(g0[1], u0[1])); w.y = cvt_pk_bf16(silu_mul(g0[2], u0[2]), silu_mul(g0[3], u0[3]));
                w.z = cvt_pk_bf16(silu_mul(g1[0], u1[0]), silu_mul(g1[1], u1[1])); w.w = cvt_pk_bf16(silu_mul(g1[2], u1[2]), silu_mul(g1[3], u1[3]));
                *(u32x4*)rowp = w; }
    }
};

struct EpiF32Stat {
    static constexpr bool PERM = false, AFTER_DRAIN = false;
    float* O; int ldc; float* part;
    __device__ __forceinline__ void operator()(const f32x4 (&acc)[2][2][4][2], const Unit& u, int wr, int wc, int fr, int fq) const {
        const int col0 = u.pn * BM + wc * 32 + 4 * fq;
#pragma unroll
        for (int ai = 0; ai < 2; ++ai)
#pragma unroll
            for (int m = 0; m < 4; ++m) { const int r = u.pm * BM + ai * HALF + wr * 64 + m * 16 + fr; float* rowp = O + (size_t)r * ldc + col0; float s = 0.f;
#pragma unroll
                for (int bj = 0; bj < 2; ++bj)
#pragma unroll
                    for (int n = 0; n < 2; ++n) { const f32x4 v = acc[ai][bj][m][n]; *(f32x4*)(rowp + bj * HALF + n * 16) = v; s += (v[0] * v[0] + v[1] * v[1]) + (v[2] * v[2] + v[3] * v[3]); }
                s += __shfl_xor(s, 16); s += __shfl_xor(s, 32);
                if (fq == 0) part[(size_t)r * 32 + u.pn * 4 + wc] = s; }
    }
};

struct EpiPool {
    static constexpr bool PERM = true, AFTER_DRAIN = false;
    bf16_t* O; int ldc; const float* scale; PG8_LAS float* scr; float eps;
    __device__ __forceinline__ void operator()(const f32x4 (&acc)[2][2][4][2], const Unit& u, int wr, int wc, int fr, int fq) const {
        const int grp = u.pm >> 6, rb = u.pm & 63;
#pragma unroll
        for (int ai = 0; ai < 2; ++ai)
#pragma unroll
            for (int m = 0; m < 4; ++m) { float s = 0.f;
#pragma unroll
                for (int bj = 0; bj < 2; ++bj)
#pragma unroll
                    for (int n = 0; n < 2; ++n) { const f32x4 v = acc[ai][bj][m][n]; s += (v[0] * v[0] + v[1] * v[1]) + (v[2] * v[2] + v[3] * v[3]); }
                s += __shfl_xor(s, 16); s += __shfl_xor(s, 32);
                if (fq == 0) scr[(ai * HALF + wr * 64 + m * 16 + fr) * 4 + wc] = s;
                asm volatile("" ::: "memory"); }
        asm volatile("s_waitcnt lgkmcnt(0)" ::: "memory"); __builtin_amdgcn_s_barrier(); asm volatile("" ::: "memory");
        const int gc0 = grp * BM + wc * 32 + 8 * fq;
#pragma unroll
        for (int ai = 0; ai < 2; ++ai)
#pragma unroll
            for (int m = 0; m < 4; ++m) { const int rl = ai * HALF + wr * 64 + m * 16 + fr; const f32x4 p = *(const PG8_LAS f32x4*)(scr + rl * 4);
                const float rstd = __builtin_amdgcn_rsqf(((p[0] + p[1]) + (p[2] + p[3])) * (1.0f / 256.0f) + eps);
                bf16_t* rowp = O + (size_t)(rb * BM + rl) * ldc + 1024 + gc0;
#pragma unroll
                for (int bj = 0; bj < 2; ++bj) { const f32x4 s0 = *(const f32x4*)(scale + gc0 + bj * HALF), s1 = *(const f32x4*)(scale + gc0 + bj * HALF + 4);
                    const f32x4 v0 = acc[ai][bj][m][0] * rstd * s0, v1 = acc[ai][bj][m][1] * rstd * s1;
                    u32x4 w; w.x = cvt_pk_bf16(v0[0], v0[1]); w.y = cvt_pk_bf16(v0[2], v0[3]); w.z = cvt_pk_bf16(v1[0], v1[1]); w.w = cvt_pk_bf16(v1[2], v1[3]);
                    *(u32x4*)(rowp + bj * HALF) = w; }
                asm volatile("" ::: "memory"); }
        asm volatile("s_waitcnt lgkmcnt(0)" ::: "memory"); __builtin_amdgcn_s_barrier(); asm volatile("" ::: "memory");
    }
};

template <class Epi, class Sched, bool ALIGN_EPI = false, bool SP2 = false>
__device__ __forceinline__ void gemm_phase(PG8_LAS unsigned char* lds, const Gemm g, const Sched& S, const Epi& E) {
    const int tid = threadIdx.x, wid = __builtin_amdgcn_readfirstlane(tid >> 6), lane = tid & 63, wr = wid >> 2, wc = wid & 3, fr = lane & 15, fq = lane >> 4;
    const int K = g.K, nt = K / BK;
    unsigned voffA[2], voffB[2];
#pragma unroll
    for (int i = 0; i < 2; ++i) { int R, C; stage_rc(tid * 16 + i * 8192, R, C); const int Rb = Epi::PERM ? ((R & ~31) + perm32(R & 31)) : R;
        voffA[i] = (unsigned)(R * K + C) * 2u; voffB[i] = (unsigned)(Rb * K + C) * 2u; }
    const size_t kstep = (size_t)(BK * 2);
    const size_t hstep = (size_t)HALF * K * 2;
    const size_t tstep = 2 * hstep;
    const unsigned ldsw = (unsigned)wid * 1024u;
    const int aoff = lds_byte(wr * 64 + fr, fq * 8), boff = lds_byte(wc * 32 + fr, fq * 8);
#define PG8_SA(b, h) (((b) * 2 + (h)) * HTB)
#define PG8_SB(b, h) ((4 + (b) * 2 + (h)) * HTB)
#define PG8_STAGE(bufoff, gbase, voff) do { _Pragma("unroll") for (int _i = 0; _i < 2; ++_i) \
        __builtin_amdgcn_global_load_lds((const unsigned*)((const char*)(gbase) + (voff)[_i]), (PG8_LAS unsigned*)(lds + (bufoff) + ldsw + _i * 8192), 16, 0, 0); } while (0)
#define PG8_LDA(dst, b, h) do { _Pragma("unroll") for (int m = 0; m < 4; ++m) _Pragma("unroll") for (int k = 0; k < 2; ++k) dst[m][k] = *(const PG8_LAS bf16x8*)(lds + PG8_SA(b, h) + aoff + m * 2048 + k * 1024); } while (0)
#define PG8_LDB(dst, b, h) do { _Pragma("unroll") for (int n = 0; n < 2; ++n) _Pragma("unroll") for (int k = 0; k < 2; ++k) dst[n][k] = *(const PG8_LAS bf16x8*)(lds + PG8_SB(b, h) + boff + n * 2048 + k * 1024); } while (0)
#define PG8_MMA(ai, bj, At, Bt) do { __builtin_amdgcn_s_setprio(1); _Pragma("unroll") for (int m = 0; m < 4; ++m) _Pragma("unroll") for (int n = 0; n < 2; ++n) _Pragma("unroll") for (int k = 0; k < 2; ++k) \
        acc[ai][bj][m][n] = __builtin_amdgcn_mfma_f32_16x16x32_bf16(Bt[n][k], At[m][k], acc[ai][bj][m][n], 0, 0, 0); __builtin_amdgcn_s_setprio(0); } while (0)
#define PG8_WAIT_V(n) asm volatile("s_waitcnt vmcnt(" #n ")" ::: "memory")
#define PG8_WAIT_L(n) asm volatile("s_waitcnt lgkmcnt(" #n ")" ::: "memory")
#define PG8_BAR __builtin_amdgcn_s_barrier()
#define PG8_SCHED __builtin_amdgcn_sched_barrier(0)
    Unit cur, nxt; int ui = 0;
    if (!S.next(0, cur)) return;
    f32x4 acc[2][2][4][2];
#pragma unroll
    for (int a = 0; a < 2; ++a)
#pragma unroll
        for (int b = 0; b < 2; ++b)
#pragma unroll
            for (int m = 0; m < 4; ++m)
#pragma unroll
                for (int n = 0; n < 2; ++n) acc[a][b][m][n] = (f32x4){0.f, 0.f, 0.f, 0.f};
    bf16x8 At[4][2], B0[2][2], B1[2][2];
    const char* cA = (const char*)g.A + (size_t)cur.pm * tstep; const char* cB = (const char*)g.Bt + (size_t)btile(g, cur) * tstep;
    S.a_ready(cur);
    if constexpr (SP2) {
        PG8_STAGE(PG8_SB(0, 0), cB, voffB); PG8_STAGE(PG8_SB(0, 1), cB + hstep, voffB); PG8_STAGE(PG8_SA(0, 0), cA, voffA); PG8_STAGE(PG8_SA(0, 1), cA + hstep, voffA);
        if (wr == 1) PG8_BAR;
        PG8_WAIT_V(2); PG8_BAR;
        PG8_STAGE(PG8_SB(1, 0), cB + kstep, voffB); PG8_STAGE(PG8_SA(1, 0), cA + kstep, voffA); PG8_STAGE(PG8_SB(1, 1), cB + hstep + kstep, voffB);
        PG8_WAIT_V(6); PG8_BAR;
    } else {
        PG8_STAGE(PG8_SB(0, 0), cB, voffB); PG8_STAGE(PG8_SA(0, 0), cA, voffA); PG8_STAGE(PG8_SB(0, 1), cB + hstep, voffB); PG8_STAGE(PG8_SA(0, 1), cA + hstep, voffA);
        if (wr == 1) PG8_BAR;
        PG8_WAIT_V(4); PG8_BAR;
        PG8_STAGE(PG8_SB(1, 0), cB + kstep, voffB); PG8_STAGE(PG8_SA(1, 0), cA + kstep, voffA); PG8_STAGE(PG8_SB(1, 1), cB + hstep + kstep, voffB);
        PG8_WAIT_V(6); PG8_BAR;
    }
    for (;;) {
        const bool has_next = S.next(ui + 1, nxt);
        const char* nA = has_next ? (const char*)g.A + (size_t)nxt.pm * tstep : cA; const char* nB = has_next ? (const char*)g.Bt + (size_t)btile(g, nxt) * tstep : cB;
        for (int t = 0; t < nt; t += 2) {
            const bool last = (t == nt - 2);
            const char* a1 = cA + (size_t)(t + 1) * kstep;
            const char* a2 = last ? nA : cA + (size_t)(t + 2) * kstep; const char* b2 = last ? nB : cB + (size_t)(t + 2) * kstep;
            const char* a3 = a2 + kstep; const char* b3 = b2 + kstep;
            if (last && has_next) S.a_ready(nxt);
            if constexpr (SP2) {
            PG8_LDB(B0, 0, 0); PG8_LDB(B1, 0, 1); PG8_SCHED; PG8_LDA(At, 0, 0); PG8_STAGE(PG8_SA(1, 1), a1 + hstep, voffA);
            PG8_WAIT_V(8); PG8_WAIT_L(0); PG8_BAR; PG8_MMA(0, 0, At, B0); PG8_MMA(0, 1, At, B1); PG8_BAR; PG8_SCHED;
            PG8_LDA(At, 0, 1); PG8_STAGE(PG8_SB(0, 0), b2, voffB); PG8_STAGE(PG8_SB(0, 1), b2 + hstep, voffB); PG8_STAGE(PG8_SA(0, 0), a2, voffA);
            PG8_WAIT_V(8); PG8_WAIT_L(0); PG8_BAR; PG8_MMA(1, 0, At, B0); PG8_MMA(1, 1, At, B1); PG8_BAR; PG8_SCHED;
            PG8_LDB(B0, 1, 0); PG8_LDB(B1, 1, 1); PG8_SCHED; PG8_LDA(At, 1, 0); PG8_STAGE(PG8_SA(0, 1), a2 + hstep, voffA);
            PG8_WAIT_V(8); PG8_WAIT_L(0); PG8_BAR; PG8_MMA(0, 0, At, B0); PG8_MMA(0, 1, At, B1); PG8_BAR; PG8_SCHED;
            PG8_LDA(At, 1, 1); PG8_STAGE(PG8_SB(1, 0), b3, voffB); PG8_STAGE(PG8_SB(1, 1), b3 + hstep, voffB); PG8_STAGE(PG8_SA(1, 0), a3, voffA);
            PG8_WAIT_V(8); PG8_WAIT_L(0); PG8_BAR; PG8_MMA(1, 0, At, B0); PG8_MMA(1, 1, At, B1); PG8_BAR; PG8_SCHED;
            } else {
            PG8_LDB(B0, 0, 0); PG8_SCHED; PG8_LDA(At, 0, 0); PG8_STAGE(PG8_SA(1, 1), a1 + hstep, voffA);
            PG8_WAIT_L(8); PG8_BAR; PG8_WAIT_L(0); PG8_MMA(0, 0, At, B0); PG8_BAR; PG8_SCHED;
            PG8_LDB(B1, 0, 1); PG8_STAGE(PG8_SB(0, 0), b2, voffB);
            PG8_BAR; PG8_WAIT_L(0); PG8_MMA(0, 1, At, B1); PG8_BAR;
            PG8_LDA(At, 0, 1); PG8_STAGE(PG8_SA(0, 0), a2, voffA);
            PG8_BAR; PG8_WAIT_L(0); PG8_MMA(1, 0, At, B0); PG8_BAR; PG8_SCHED;
            PG8_STAGE(PG8_SB(0, 1), b2 + hstep, voffB);
            PG8_WAIT_V(6); PG8_BAR; PG8_MMA(1, 1, At, B1); PG8_BAR;
            PG8_LDB(B0, 1, 0); PG8_SCHED; PG8_LDA(At, 1, 0); PG8_STAGE(PG8_SA(0, 1), a2 + hstep, voffA);
            PG8_WAIT_L(8); PG8_BAR; PG8_WAIT_L(0); PG8_MMA(0, 0, At, B0); PG8_BAR; PG8_SCHED;
            PG8_LDB(B1, 1, 1); PG8_STAGE(PG8_SB(1, 0), b3, voffB);
            PG8_BAR; PG8_WAIT_L(0); PG8_MMA(0, 1, At, B1); PG8_BAR;
            PG8_LDA(At, 1, 1); PG8_STAGE(PG8_SA(1, 0), a3, voffA);
            PG8_BAR; PG8_WAIT_L(0); PG8_MMA(1, 0, At, B0); PG8_BAR; PG8_SCHED;
            PG8_STAGE(PG8_SB(1, 1), b3 + hstep, voffB);
            PG8_WAIT_V(6); PG8_BAR; PG8_MMA(1, 1, At, B1); PG8_BAR;
            }
        }
        if constexpr (ALIGN_EPI) { if (wr == 0) PG8_BAR; }
        if constexpr (!Epi::AFTER_DRAIN) { E(acc, cur, wr, wc, fr, fq); S.done(cur); }
        if (!has_next) break;
#pragma unroll
        for (int a = 0; a < 2; ++a)
#pragma unroll
            for (int b = 0; b < 2; ++b)
#pragma unroll
                for (int m = 0; m < 4; ++m)
#pragma unroll
                    for (int n = 0; n < 2; ++n) acc[a][b][m][n] = (f32x4){0.f, 0.f, 0.f, 0.f};
        cur = nxt; cA = nA; cB = nB; ++ui;
        if constexpr (ALIGN_EPI) { if (wr == 1) PG8_BAR; }
    }
    PG8_WAIT_V(0);
    if constexpr (!ALIGN_EPI) { if (wr == 0) PG8_BAR; }
    PG8_BAR;
    if constexpr (Epi::AFTER_DRAIN) { E.fused(acc, cur, wr, wc, fr, fq, lds, wid, lane); S.done(cur); }
#undef PG8_SA
#undef PG8_SB
#undef PG8_STAGE
#undef PG8_LDA
#undef PG8_LDB
#undef PG8_MMA
#undef PG8_WAIT_V
#undef PG8_WAIT_L
#undef PG8_BAR
#undef PG8_SCHED
}
}

#ifndef MK_MULTI
#define MK_MULTI 0
#endif
constexpr int NWAVES = 8;
constexpr int BATCH = 2, SEQ = 8192, D = 2048, CW = 1024, PW = 1024, NPROJ = 4096, FF = 5632;
constexpr int M = BATCH * SEQ;
constexpr float EPS = 1e-6f;
constexpr int NPHASE = 9;

constexpr size_t MiB = 1u << 20;
constexpr size_t WS_PART1 = 1 * MiB, WS_PART2 = 3 * MiB;
constexpr size_t WS_WD = 5 * MiB;
constexpr size_t WS_WIN = 27 * MiB;
constexpr size_t WS_WOUT = 43 * MiB;
constexpr size_t WS_WGU = 51 * MiB;
constexpr size_t WS_WPOOL = 95 * MiB;
constexpr size_t WS_H = 96 * MiB;
constexpr size_t WS_FF = 27 * MiB;
constexpr size_t WS_PROJ = 160 * MiB;
constexpr size_t WS_POOLED = 288 * MiB;
constexpr size_t WS_MIXED = 320 * MiB;
constexpr size_t WS_MIXOUT = 160 * MiB;
constexpr size_t WS_ACT = 160 * MiB;
constexpr size_t WS_END = 384 * MiB;
static_assert(WS_FF + (size_t)M * D * 4 <= WS_PROJ && WS_ACT + (size_t)M * FF * 2 <= WS_END && WS_WD + (size_t)D * FF * 2 <= WS_FF, "d_ws map");

constexpr int RING_BYTES = 131072, EPI_SCR_OFF = RING_BYTES, LDS_BYTES = 147456;

#define GAS __attribute__((address_space(1)))
#define LAS __attribute__((address_space(3)))
typedef unsigned short bf16;
typedef unsigned v4u __attribute__((ext_vector_type(4)));
typedef unsigned v2u __attribute__((ext_vector_type(2)));
typedef float f32x4 __attribute__((ext_vector_type(4)));
#define LDS_WAIT() asm volatile("s_waitcnt lgkmcnt(0)" ::: "memory")
__device__ __forceinline__ unsigned f2bf(float f) { unsigned u = __builtin_bit_cast(unsigned, f); return (u + 0x7fffu + ((u >> 16) & 1u)) >> 16; }
__device__ __forceinline__ unsigned pk2(float lo, float hi) { return f2bf(lo) | (f2bf(hi) << 16); }
__device__ __forceinline__ float bflo(unsigned w) { return __builtin_bit_cast(float, w << 16); }
__device__ __forceinline__ float bfhi(unsigned w) { return __builtin_bit_cast(float, w & 0xffff0000u); }
__device__ __forceinline__ float wave_sum(float v) {
#pragma unroll
    for (int o = 1; o < 64; o <<= 1) v += __shfl_xor(v, o);
    return v;
}

struct Frame {
    LAS unsigned char* lds;
    int tid, lane, wave, vcu, G;
    const float *x, *g_pre, *w_in, *conv_w, *pool_w, *pool_scale, *w_out, *g_post, *g_fpre, *w_gate, *w_up, *w_down, *g_fpost;
    float* out; unsigned char* ws;
};

template <int MODE>
__device__ __forceinline__ void p0_transpose_item(const float* W, int K, int N, bf16* WT, LAS float* scr, int item, int lane) {
    const int nblk = N / 32, kb = item / nblk, nb = item % nblk, k0 = 64 * kb, n0 = 32 * nb;
    const int drow0 = MODE == 0 ? n0 : ((n0 >> 7) * 256 + (n0 & 127) + (MODE == 2 ? 128 : 0));
#pragma unroll 8
    for (int i = 0; i < 32; ++i) { const int kk = 2 * i + (lane >> 5); scr[kk * 33 + (lane & 31)] = W[(size_t)(k0 + kk) * N + n0 + (lane & 31)]; }
    LDS_WAIT(); asm volatile("" ::: "memory");
    const int c = lane & 7;
#pragma unroll
    for (int j = 0; j < 4; ++j) { const int n = (lane >> 3) + 8 * j; const LAS float* s = scr + (8 * c) * 33 + n;
        v4u o; o.x = pk2(s[0 * 33], s[1 * 33]); o.y = pk2(s[2 * 33], s[3 * 33]); o.z = pk2(s[4 * 33], s[5 * 33]); o.w = pk2(s[6 * 33], s[7 * 33]);
        *(GAS v4u*)(WT + (size_t)(drow0 + n) * K + k0 + 8 * c) = o; }
    LDS_WAIT(); asm volatile("" ::: "memory");
}

__device__ __forceinline__ void p0_prologue(Frame& F) {
    LAS float* scr = (LAS float*)(F.lds + F.wave * 16384);
    const int gw = F.vcu * NWAVES + F.wave, NGW = F.G * NWAVES;
    unsigned char* ws = F.ws;
    constexpr int I_IN = (D / 64) * (NPROJ / 32), I_OUT = (D / 64) * (D / 32), I_G = (D / 64) * (FF / 32), I_D = (FF / 64) * (D / 32), I_P1 = (256 / 64) * (256 / 32), I_P = 4 * I_P1;
    constexpr int NITEMS = I_IN + I_OUT + 2 * I_G + I_D + I_P;
    for (int it = gw; it < NITEMS; it += NGW) {
        int r = it;
        if (r < I_IN) { p0_transpose_item<0>(F.w_in, D, NPROJ, (bf16*)(ws + WS_WIN), scr, r, F.lane); continue; } r -= I_IN;
        if (r < I_OUT) { p0_transpose_item<0>(F.w_out, D, D, (bf16*)(ws + WS_WOUT), scr, r, F.lane); continue; } r -= I_OUT;
        if (r < I_G) { p0_transpose_item<1>(F.w_gate, D, FF, (bf16*)(ws + WS_WGU), scr, r, F.lane); continue; } r -= I_G;
        if (r < I_G) { p0_transpose_item<2>(F.w_up, D, FF, (bf16*)(ws + WS_WGU), scr, r, F.lane); continue; } r -= I_G;
        if (r < I_D) { p0_transpose_item<0>(F.w_down, FF, D, (bf16*)(ws + WS_WD), scr, r, F.lane); continue; } r -= I_D;
        { const int g = r / I_P1; p0_transpose_item<0>(F.pool_w + (size_t)g * 65536, 256, 256, (bf16*)(ws + WS_WPOOL) + (size_t)g * 65536, scr, r % I_P1, F.lane); }
    }
    f32x4 gv[8];
#pragma unroll
    for (int j = 0; j < 8; ++j) gv[j] = ((const GAS f32x4*)F.g_pre)[F.lane + 64 * j];
    bf16* H = (bf16*)(ws + WS_H);
    for (int m = gw; m < M; m += NGW) {
        const GAS f32x4* xr = (const GAS f32x4*)(F.x + (size_t)m * D) + F.lane;
        f32x4 v[8]; float s = 0.f;
#pragma unroll
        for (int j = 0; j < 8; ++j) { v[j] = xr[64 * j]; s += (v[j].x * v[j].x + v[j].y * v[j].y) + (v[j].z * v[j].z + v[j].w * v[j].w); }
        const float rstd = 1.0f / sqrtf(wave_sum(s) * (1.0f / D) + EPS);
        GAS v2u* o8 = (GAS v2u*)(H + (size_t)m * D) + F.lane;
#pragma unroll
        for (int j = 0; j < 8; ++j) { const f32x4 y = v[j] * rstd * gv[j]; v2u w; w.x = pk2(y.x, y.y); w.y = pk2(y.z, y.w); o8[64 * j] = w; }
    }
}

__device__ __forceinline__ void unpack16(const bf16* p, float (&f)[16]) {
    const v4u a = *(const GAS v4u*)p, b = *((const GAS v4u*)p + 1);
    f[0] = bflo(a.x); f[1] = bfhi(a.x); f[2] = bflo(a.y); f[3] = bfhi(a.y); f[4] = bflo(a.z); f[5] = bfhi(a.z); f[6] = bflo(a.w); f[7] = bfhi(a.w);
    f[8] = bflo(b.x); f[9] = bfhi(b.x); f[10] = bflo(b.y); f[11] = bfhi(b.y); f[12] = bflo(b.z); f[13] = bfhi(b.z); f[14] = bflo(b.w); f[15] = bfhi(b.w);
}
__device__ __forceinline__ void pack16_store(bf16* p, const float (&f)[16]) {
    v4u a, b; a.x = pk2(f[0], f[1]); a.y = pk2(f[2], f[3]); a.z = pk2(f[4], f[5]); a.w = pk2(f[6], f[7]);
    b.x = pk2(f[8], f[9]); b.y = pk2(f[10], f[11]); b.z = pk2(f[12], f[13]); b.w = pk2(f[14], f[15]);
    *(GAS v4u*)p = a; *((GAS v4u*)p + 1) = b;
}
__device__ __forceinline__ void p2_mixer(Frame& F) {
    const int gw = F.vcu * NWAVES + F.wave, NGW = F.G * NWAVES, l = F.lane;
    const bf16* P = (const bf16*)(F.ws + WS_PROJ);
    bf16* MIX = (bf16*)(F.ws + WS_MIXED); bf16* PO = (bf16*)(F.ws + WS_POOLED);
    float w0[16], w1[16], w2[16];
#pragma unroll
    for (int i = 0; i < 16; ++i) { w0[i] = F.conv_w[0 * CW + 16 * l + i]; w1[i] = F.conv_w[1 * CW + 16 * l + i]; w2[i] = F.conv_w[2 * CW + 16 * l + i]; }
    const int wlen = 2 << (l >> 4);
    for (int chunk = gw; chunk < M / 8; chunk += NGW) {
        const int m0 = chunk * 8, t0 = m0 % SEQ;
        {
            float cu1[16], cu2[16];
#pragma unroll
            for (int i = 0; i < 16; ++i) { cu1[i] = 0.f; cu2[i] = 0.f; }
            if (t0 > 0) {
                float c[16], u[16];
                unpack16(P + (size_t)(m0 - 1) * NPROJ + CW + 16 * l, c); unpack16(P + (size_t)(m0 - 1) * NPROJ + 2 * CW + 16 * l, u);
#pragma unroll
                for (int i = 0; i < 16; ++i) cu1[i] = c[i] * u[i];
                unpack16(P + (size_t)(m0 - 2) * NPROJ + CW + 16 * l, c); unpack16(P + (size_t)(m0 - 2) * NPROJ + 2 * CW + 16 * l, u);
#pragma unroll
                for (int i = 0; i < 16; ++i) cu2[i] = c[i] * u[i];
            }
#pragma unroll 1
            for (int r = 0; r < 8; ++r) {
                const bf16* row = P + (size_t)(m0 + r) * NPROJ + 16 * l;
                float b[16], c[16], u[16], y[16];
                unpack16(row, b); unpack16(row + CW, c); unpack16(row + 2 * CW, u);
                float ss = 0.f;
#pragma unroll
                for (int i = 0; i < 16; ++i) { const float cu0 = c[i] * u[i]; y[i] = b[i] * (w0[i] * cu2[i] + w1[i] * cu1[i] + w2[i] * cu0); ss += y[i] * y[i]; cu2[i] = cu1[i]; cu1[i] = cu0; }
                ss += __shfl_xor(ss, 1); ss += __shfl_xor(ss, 2); ss += __shfl_xor(ss, 4);
                const float rstd = 1.0f / sqrtf(ss * (1.0f / 128.0f) + EPS);
#pragma unroll
                for (int i = 0; i < 16; ++i) y[i] *= rstd;
                pack16_store(MIX + (size_t)(m0 + r) * D + 16 * l, y);
            }
        }
        {
            const bf16* vcol = P + 3 * CW + 16 * l;
            float S[16];
#pragma unroll
            for (int i = 0; i < 16; ++i) S[i] = 0.f;
#pragma unroll 1
            for (int j = 1; j < 16; ++j) if (j < wlen && t0 - j >= 0) { float v[16]; unpack16(vcol + (size_t)(m0 - j) * NPROJ, v);
#pragma unroll
                for (int i = 0; i < 16; ++i) S[i] += v[i]; }
            bf16* orow = PO + ((size_t)(l >> 4) * M + m0) * 256 + 16 * (l & 15);
#pragma unroll 1
            for (int r = 0; r < 8; ++r) {
                const int t = t0 + r; float v[16], o[16]; unpack16(vcol + (size_t)(m0 + r) * NPROJ, v);
                const int cnt = (t + 1) < wlen ? (t + 1) : wlen; const float inv = 1.0f / (float)cnt;
#pragma unroll
                for (int i = 0; i < 16; ++i) { S[i] += v[i]; o[i] = S[i] * inv - v[i]; }
                pack16_store(orow + (size_t)r * 256, o);
                if (t - wlen + 1 >= 0) { float q[16]; unpack16(vcol + (size_t)(m0 + r - wlen + 1) * NPROJ, q);
#pragma unroll
                    for (int i = 0; i < 16; ++i) S[i] -= q[i]; }
            }
        }
    }
}

__device__ __forceinline__ void p5_resnorm(Frame& F) {
    const int gw = F.vcu * NWAVES + F.wave, NGW = F.G * NWAVES, l = F.lane;
    const float* MO = (const float*)(F.ws + WS_MIXOUT); const float* part = (const float*)(F.ws + WS_PART1); bf16* H = (bf16*)(F.ws + WS_H);
    f32x4 g1[8], g2[8];
#pragma unroll
    for (int j = 0; j < 8; ++j) { g1[j] = ((const GAS f32x4*)F.g_post)[l + 64 * j]; g2[j] = ((const GAS f32x4*)F.g_fpre)[l + 64 * j]; }
    for (int m = gw; m < M; m += NGW) {
        const float p = l < 32 ? part[(size_t)m * 32 + l] : 0.f;
        const float rstd1 = 1.0f / sqrtf(wave_sum(p) * (1.0f / D) + EPS);
        const GAS f32x4* xr = (const GAS f32x4*)(F.x + (size_t)m * D) + l; const GAS f32x4* mr = (const GAS f32x4*)(MO + (size_t)m * D) + l;
        GAS f32x4* orow = (GAS f32x4*)(F.out + (size_t)m * D) + l;
        f32x4 v[8]; float s = 0.f;
#pragma unroll
        for (int j = 0; j < 8; ++j) { v[j] = xr[64 * j] + mr[64 * j] * rstd1 * g1[j]; orow[64 * j] = v[j]; s += (v[j].x * v[j].x + v[j].y * v[j].y) + (v[j].z * v[j].z + v[j].w * v[j].w); }
        const float rstd2 = 1.0f / sqrtf(wave_sum(s) * (1.0f / D) + EPS);
        GAS v2u* o8 = (GAS v2u*)(H + (size_t)m * D) + l;
#pragma unroll
        for (int j = 0; j < 8; ++j) { const f32x4 y = v[j] * rstd2 * g2[j]; v2u w; w.x = pk2(y.x, y.y); w.y = pk2(y.z, y.w); o8[64 * j] = w; }
    }
}
__device__ __forceinline__ void p8_final(Frame& F) {
    const int gw = F.vcu * NWAVES + F.wave, NGW = F.G * NWAVES, l = F.lane;
    const float* FFO = (const float*)(F.ws + WS_FF); const float* part = (const float*)(F.ws + WS_PART2);
    f32x4 g3[8];
#pragma unroll
    for (int j = 0; j < 8; ++j) g3[j] = ((const GAS f32x4*)F.g_fpost)[l + 64 * j];
    for (int m = gw; m < M; m += NGW) {
        const float p = l < 32 ? part[(size_t)m * 32 + l] : 0.f;
        const float rstd = 1.0f / sqrtf(wave_sum(p) * (1.0f / D) + EPS);
        const GAS f32x4* fr = (const GAS f32x4*)(FFO + (size_t)m * D) + l; GAS f32x4* orow = (GAS f32x4*)(F.out + (size_t)m * D) + l;
#pragma unroll
        for (int j = 0; j < 8; ++j) orow[64 * j] = orow[64 * j] + fr[64 * j] * rstd * g3[j];
    }
}

struct Args { const float* in[13]; float* out; unsigned char* ws; int ph_lo, ph_hi; };
__global__ void __launch_bounds__(NWAVES * 64, 2) mk_fwd(Args args) {
    extern __shared__ __attribute__((aligned(16))) unsigned char lds[];
    Frame F;
    F.lds = (LAS unsigned char*)lds;
    F.tid = threadIdx.x; F.lane = F.tid & 63; F.wave = __builtin_amdgcn_readfirstlane(F.tid >> 6);
    F.G = gridDim.x; { const int bx = blockIdx.x; F.vcu = (F.G % 8 == 0) ? (bx % 8) * (F.G / 8) + bx / 8 : bx; }
    F.x = args.in[0]; F.g_pre = args.in[1]; F.w_in = args.in[2]; F.conv_w = args.in[3]; F.pool_w = args.in[4]; F.pool_scale = args.in[5]; F.w_out = args.in[6];
    F.g_post = args.in[7]; F.g_fpre = args.in[8]; F.w_gate = args.in[9]; F.w_up = args.in[10]; F.w_down = args.in[11]; F.g_fpost = args.in[12];
    F.out = args.out; F.ws = args.ws;
    unsigned char* ws = args.ws;
    const int lo = args.ph_lo, hi = args.ph_hi;
#ifdef ONLY_PHASE
#define IN(k) ((k) == ONLY_PHASE && lo <= (k) && (k) < hi)
#else
#define IN(k) (lo <= (k) && (k) < hi)
#endif
#if MK_MULTI
#define SEAM(k) do { } while (0)
#else
    cg::grid_group grid = cg::this_grid();
#define SEAM(k) do { if (IN(k) && IN((k) + 1)) grid.sync(); } while (0)
#endif
    typedef pg8::bf16_t bt;
    if (IN(0)) p0_prologue(F);
    SEAM(0);
    if (IN(1)) {
        pg8::Gemm g{(const bt*)(ws + WS_H), (const bt*)(ws + WS_WIN), M, NPROJ, D, 0}; pg8::StaticOrder S; S.init(M, NPROJ, F.G, (int)blockIdx.x);
        pg8::EpiBf16 E{(bt*)(ws + WS_PROJ), NPROJ};
        pg8::gemm_phase<pg8::EpiBf16, pg8::StaticOrder, true, true>(F.lds, g, S, E);
    }
    SEAM(1);
    if (IN(2)) p2_mixer(F);
    SEAM(2);
    if (IN(3)) {
        int kpool = 256; asm volatile("" : "+s"(kpool));
        pg8::Gemm g{(const bt*)(ws + WS_POOLED), (const bt*)(ws + WS_WPOOL), 4 * M, 256, kpool, 64}; pg8::StaticOrder S; S.init(4 * M, 256, F.G, (int)blockIdx.x);
        pg8::EpiPool E{(bt*)(ws + WS_MIXED), D, F.pool_scale, (LAS float*)(F.lds + EPI_SCR_OFF), EPS};
        pg8::gemm_phase<pg8::EpiPool, pg8::StaticOrder, true, true>(F.lds, g, S, E);
    }
    SEAM(3);
    if (IN(4)) {
        pg8::Gemm g{(const bt*)(ws + WS_MIXED), (const bt*)(ws + WS_WOUT), M, D, D, 0}; pg8::StaticOrder S; S.init(M, D, F.G, (int)blockIdx.x);
        pg8::EpiF32Stat E{(float*)(ws + WS_MIXOUT), D, (float*)(ws + WS_PART1)};
        pg8::gemm_phase<pg8::EpiF32Stat, pg8::StaticOrder, true, true>(F.lds, g, S, E);
    }
    SEAM(4);
    if (IN(5)) p5_resnorm(F);
    SEAM(5);
    if (IN(6)) {
        pg8::Gemm g{(const bt*)(ws + WS_H), (const bt*)(ws + WS_WGU), M, 2 * FF, D, 0}; pg8::StaticOrder S; S.init(M, 2 * FF, F.G, (int)blockIdx.x);
        pg8::EpiSwiGLU E{(bt*)(ws + WS_ACT), FF};
        pg8::gemm_phase<pg8::EpiSwiGLU, pg8::StaticOrder, true, true>(F.lds, g, S, E);
    }
    SEAM(6);
    if (IN(7)) {
        pg8::Gemm g{(const bt*)(ws + WS_ACT), (const bt*)(ws + WS_WD), M, D, FF, 0}; pg8::StaticOrder S; S.init(M, D, F.G, (int)blockIdx.x);
        pg8::EpiF32Stat E{(float*)(ws + WS_FF), D, (float*)(ws + WS_PART2)};
        pg8::gemm_phase<pg8::EpiF32Stat, pg8::StaticOrder, true, true>(F.lds, g, S, E);
    }
    SEAM(7);
    if (IN(8)) p8_final(F);
#undef IN
#undef SEAM
}

extern "C" void kernel_launch(void* const* d_in, const int* in_sizes, int n_in, void* d_out, int out_size, void* d_ws, size_t ws_size, hipStream_t stream) {
    static int grid = 0;
    if (grid == 0) {
        if (n_in != 13 || in_sizes[0] != M * D || out_size != M * D || ws_size < WS_END) { fprintf(stderr, "kernel_launch: shape/workspace mismatch (n_in %d, in0 %d, out %d, ws %zu, need %zu); nothing launched\n", n_in, n_in > 0 ? in_sizes[0] : -1, out_size, ws_size, (size_t)WS_END); grid = -1; return; }
        int dev = 0, cus = 0, per_cu = 0;
        if (hipGetDevice(&dev) != hipSuccess || hipDeviceGetAttribute(&cus, hipDeviceAttributeMultiprocessorCount, dev) != hipSuccess) { fprintf(stderr, "kernel_launch: device query failed\n"); grid = -1; return; }
        if (hipFuncSetAttribute((const void*)mk_fwd, hipFuncAttributeMaxDynamicSharedMemorySize, LDS_BYTES) != hipSuccess) { fprintf(stderr, "kernel_launch: hipFuncSetAttribute failed\n"); grid = -1; return; }
        if (hipOccupancyMaxActiveBlocksPerMultiprocessor(&per_cu, (const void*)mk_fwd, NWAVES * 64, LDS_BYTES) != hipSuccess || per_cu < 1) { fprintf(stderr, "kernel_launch: occupancy query says %d blocks per CU\n", per_cu); per_cu = 1; }
        (void)hipGetLastError();
        grid = cus;
    }
    if (grid < 0) return;
    Args a{};
    for (int i = 0; i < 13; ++i) a.in[i] = (const float*)d_in[i];
    a.out = (float*)d_out; a.ws = (unsigned char*)d_ws;
#if MK_MULTI
    for (int p = 0; p < NPHASE; ++p) { a.ph_lo = p; a.ph_hi = p + 1; hipLaunchKernelGGL(mk_fwd, dim3(grid), dim3(NWAVES * 64), LDS_BYTES, stream, a); }
#else
    a.ph_lo = 0; a.ph_hi = NPHASE;
    void* kargs[] = {&a};
    const hipError_t e = hipLaunchCooperativeKernel((const void*)mk_fwd, dim3(grid), dim3(NWAVES * 64), kargs, LDS_BYTES, stream);
    if (e != hipSuccess) fprintf(stderr, "kernel_launch: cooperative launch failed: %s (grid %d)\n", hipGetErrorString(e), grid);
#endif
}
```

```cpp
#include <hip/hip_runtime.h>
#include <cstdio>
#include <cstdint>
namespace pg8 {
#define PG8_LAS __attribute__((address_space(3)))
typedef unsigned short bf16_t;
typedef short bf16x8 __attribute__((ext_vector_type(8)));
typedef float f32x4 __attribute__((ext_vector_type(4)));
typedef unsigned u32x4 __attribute__((ext_vector_type(4)));
constexpr int BM = 256, BK = 64, HALF = 128, HTB = HALF * BK * 2  , STAGE_BYTES = 8 * HTB, NXCD = 8, WGM = 8;

__host__ __device__ __forceinline__ int lds_byte(int r, int c) { const int st = (r >> 4) * 2 + (c >> 5), rr = r & 15, cc = c & 31, ob = rr * 64 + cc * 2; return st * 1024 + (ob ^ (((ob >> 9) & 1) << 5)); }
__host__ __device__ __forceinline__ void stage_rc(int b, int& R, int& C) { const int st = b / 1024, sb = b % 1024, swz = sb ^ (((sb >> 9) & 1) << 5); R = (st >> 1) * 16 + swz / 64; C = (st & 1) * 32 + (swz % 64) / 2; }
__host__ __device__ __forceinline__ int perm32(int rho) { const int n = rho >> 4, i = rho & 15; return 8 * (i >> 2) + 4 * n + (i & 3); }

struct Unit { int pm, pn; };
struct Gemm { const bf16_t* A; const bf16_t* Bt; int M, N, K; int bdiv; };
__device__ __forceinline__ int btile(const Gemm& g, const Unit& u) { return u.pn + (g.bdiv ? (u.pm / g.bdiv) * (g.N / BM) : 0); }

struct StaticOrder {
    int nM, nN, nwg, G, c;
    __host__ __device__ void init(int M, int N, int G_, int c_) { nM = M / BM; nN = N / BM; nwg = nM * nN; G = G_; c = c_; }
    __host__ __device__ bool next(int i, Unit& u) const {
        const long L = (long)i * G + c; if (L >= nwg) return false;
        int wgid = (int)L; { const int q = nwg / NXCD, r = nwg % NXCD, xcd = wgid % NXCD, off = wgid / NXCD; wgid = (xcd < r ? xcd * (q + 1) : r * (q + 1) + (xcd - r) * q) + off; }
        const int nig = WGM * nN, gid = wgid / nig, fm = gid * WGM, gsz = (nM - fm) < WGM ? (nM - fm) : WGM;
        u.pm = fm + ((wgid % nig) % gsz); u.pn = (wgid % nig) / gsz; return true;
    }
    __device__ __forceinline__ void a_ready(const Unit&) const {}
    __device__ __forceinline__ void done(const Unit&) const {}
};

__device__ __forceinline__ unsigned cvt_pk_bf16(float lo, float hi) { unsigned r; asm volatile("v_cvt_pk_bf16_f32 %0, %1, %2" : "=v"(r) : "v"(lo), "v"(hi)); return r; }

struct EpiBf16 {
    static constexpr bool PERM = true, AFTER_DRAIN = false;
    bf16_t* O; int ldc;
    __device__ __forceinline__ void operator()(const f32x4 (&acc)[2][2][4][2], const Unit& u, int wr, int wc, int fr, int fq) const {
        const int row0 = u.pm * BM + wr * 64 + fr; const int col0 = u.pn * BM + wc * 32 + 8 * fq;
#pragma unroll
        for (int ai = 0; ai < 2; ++ai)
#pragma unroll
            for (int m = 0; m < 4; ++m) { bf16_t* rowp = O + (size_t)(row0 + ai * HALF + m * 16) * ldc + col0;
#pragma unroll
                for (int bj = 0; bj < 2; ++bj) { const f32x4 v0 = acc[ai][bj][m][0], v1 = acc[ai][bj][m][1];
                    u32x4 w; w.x = cvt_pk_bf16(v0[0], v0[1]); w.y = cvt_pk_bf16(v0[2], v0[3]); w.z = cvt_pk_bf16(v1[0], v1[1]); w.w = cvt_pk_bf16(v1[2], v1[3]);
                    *(u32x4*)(rowp + bj * HALF) = w; } }
    }
};

__device__ __forceinline__ float silu_mul(float g, float u) { const float e = __builtin_amdgcn_exp2f(g * -1.4426950408889634f); return g * __builtin_amdgcn_rcpf(1.0f + e) * u; }
struct EpiSwiGLU {
    static constexpr bool PERM = true, AFTER_DRAIN = false;
    bf16_t* O; int ldc;
    __device__ __forceinline__ void operator()(const f32x4 (&acc)[2][2][4][2], const Unit& u, int wr, int wc, int fr, int fq) const {
        const int row0 = u.pm * BM + wr * 64 + fr; const int col0 = u.pn * HALF + wc * 32 + 8 * fq;
#pragma unroll
        for (int ai = 0; ai < 2; ++ai)
#pragma unroll
            for (int m = 0; m < 4; ++m) { bf16_t* rowp = O + (size_t)(row0 + ai * HALF + m * 16) * ldc + col0;
                const f32x4 g0 = acc[ai][0][m][0], g1 = acc[ai][0][m][1], u0 = acc[ai][1][m][0], u1 = acc[ai][1][m][1];
                u32x4 w; w.x = cvt_pk_bf16(silu_mul(g0[0], u0[0]), silu_mul(g0[1], u0[1])); w.y = cvt_pk_bf16(silu_mul(g0[2], u0[2]), silu_mul(g0[3], u0[3]));
                w.z = cvt_pk_bf16(silu_mul(g1[0], u1[0]), silu_mul(g1[1], u1[1])); w.w = cvt_pk_bf16(silu_mul(g1[2], u1[2]), silu_mul(g1[3], u1[3]));
                *(u32x4*)rowp = w; }
    }
};

struct EpiF32Stat {
    static constexpr bool PERM = false, AFTER_DRAIN = false;
    float* O; int ldc; float* part;
    __device__ __forceinline__ void operator()(const f32x4 (&acc)[2][2][4][2], const Unit& u, int wr, int wc, int fr, int fq) const {
        const int col0 = u.pn * BM + wc * 32 + 4 * fq;
#pragma unroll
        for (int ai = 0; ai < 2; ++ai)
#pragma unroll
            for (int m = 0; m < 4; ++m) { const int r = u.pm * BM + ai * HALF + wr * 64 + m * 16 + fr; float* rowp = O + (size_t)r * ldc + col0; float s = 0.f;
#pragma unroll
                for (int bj = 0; bj < 2; ++bj)
#pragma unroll
                    for (int n = 0; n < 2; ++n) { const f32x4 v = acc[ai][bj][m][n]; *(f32x4*)(rowp + bj * HALF + n * 16) = v; s += (v[0] * v[0] + v[1] * v[1]) + (v[2] * v[2] + v[3] * v[3]); }
                s += __shfl_xor(s, 16); s += __shfl_xor(s, 32);
                if (fq == 0) part[(size_t)r * 32 + u.pn * 4 + wc] = s; }
    }
};

struct EpiPool {
    static constexpr bool PERM = true, AFTER_DRAIN = false;
    bf16_t* O; int ldc; const float* scale; PG8_LAS float* scr; float eps;
    __device__ __forceinline__ void operator()(const f32x4 (&acc)[2][2][4][2], const Unit& u, int wr, int wc, int fr, int fq) const {
        const int grp = u.pm >> 6, rb = u.pm & 63;
#pragma unroll
        for (int ai = 0; ai < 2; ++ai)
#pragma unroll
            for (int m = 0; m < 4; ++m) { float s = 0.f;
#pragma unroll
                for (int bj = 0; bj < 2; ++bj)
#pragma unroll
                    for (int n = 0; n < 2; ++n) { const f32x4 v = acc[ai][bj][m][n]; s += (v[0] * v[0] + v[1] * v[1]) + (v[2] * v[2] + v[3] * v[3]); }
                s += __shfl_xor(s, 16); s += __shfl_xor(s, 32);
                if (fq == 0) scr[(ai * HALF + wr * 64 + m * 16 + fr) * 4 + wc] = s;
                asm volatile("" ::: "memory"); }
        asm volatile("s_waitcnt lgkmcnt(0)" ::: "memory"); __builtin_amdgcn_s_barrier(); asm volatile("" ::: "memory");
        const int gc0 = grp * BM + wc * 32 + 8 * fq;
#pragma unroll
        for (int ai = 0; ai < 2; ++ai)
#pragma unroll
            for (int m = 0; m < 4; ++m) { const int rl = ai * HALF + wr * 64 + m * 16 + fr; const f32x4 p = *(const PG8_LAS f32x4*)(scr + rl * 4);
                const float rstd = __builtin_amdgcn_rsqf(((p[0] + p[1]) + (p[2] + p[3])) * (1.0f / 256.0f) + eps);
                bf16_t* rowp = O + (size_t)(rb * BM + rl) * ldc + 1024 + gc0;
#pragma unroll
                for (int bj = 0; bj < 2; ++bj) { const f32x4 s0 = *(const f32x4*)(scale + gc0 + bj * HALF), s1 = *(const f32x4*)(scale + gc0 + bj * HALF + 4);
                    const f32x4 v0 = acc[ai][bj][m][0] * rstd * s0, v1 = acc[ai][bj][m][1] * rstd * s1;
                    u32x4 w; w.x = cvt_pk_bf16(v0[0], v0[1]); w.y = cvt_pk_bf16(v0[2], v0[3]); w.z = cvt_pk_bf16(v1[0], v1[1]); w.w = cvt_pk_bf16(v1[2], v1[3]);
                    *(u32x4*)(rowp + bj * HALF) = w; }
                asm volatile("" ::: "memory"); }
        asm volatile("s_waitcnt lgkmcnt(0)" ::: "memory"); __builtin_amdgcn_s_barrier(); asm volatile("" ::: "memory");
    }
};

template <class Epi, class Sched, bool ALIGN_EPI = false, bool SP2 = false>
__device__ __forceinline__ void gemm_phase(PG8_LAS unsigned char* lds, const Gemm g, const Sched& S, const Epi& E) {
    const int tid = threadIdx.x, wid = __builtin_amdgcn_readfirstlane(tid >> 6), lane = tid & 63, wr = wid >> 2, wc = wid & 3, fr = lane & 15, fq = lane >> 4;
    const int K = g.K, nt = K / BK;
    unsigned voffA[2], voffB[2];
#pragma unroll
    for (int i = 0; i < 2; ++i) { int R, C; stage_rc(tid * 16 + i * 8192, R, C); const int Rb = Epi::PERM ? ((R & ~31) + perm32(R & 31)) : R;
        voffA[i] = (unsigned)(R * K + C) * 2u; voffB[i] = (unsigned)(Rb * K + C) * 2u; }
    const size_t kstep = (size_t)(BK * 2);
    const size_t hstep = (size_t)HALF * K * 2;
    const size_t tstep = 2 * hstep;
    const unsigned ldsw = (unsigned)wid * 1024u;
    const int aoff = lds_byte(wr * 64 + fr, fq * 8), boff = lds_byte(wc * 32 + fr, fq * 8);
#define PG8_SA(b, h) (((b) * 2 + (h)) * HTB)
#define PG8_SB(b, h) ((4 + (b) * 2 + (h)) * HTB)
#define PG8_STAGE(bufoff, gbase, voff) do { _Pragma("unroll") for (int _i = 0; _i < 2; ++_i) \
        __builtin_amdgcn_global_load_lds((const unsigned*)((const char*)(gbase) + (voff)[_i]), (PG8_LAS unsigned*)(lds + (bufoff) + ldsw + _i * 8192), 16, 0, 0); } while (0)
#define PG8_LDA(dst, b, h) do { _Pragma("unroll") for (int m = 0; m < 4; ++m) _Pragma("unroll") for (int k = 0; k < 2; ++k) dst[m][k] = *(const PG8_LAS bf16x8*)(lds + PG8_SA(b, h) + aoff + m * 2048 + k * 1024); } while (0)
#define PG8_LDB(dst, b, h) do { _Pragma("unroll") for (int n = 0; n < 2; ++n) _Pragma("unroll") for (int k = 0; k < 2; ++k) dst[n][k] = *(const PG8_LAS bf16x8*)(lds + PG8_SB(b, h) + boff + n * 2048 + k * 1024); } while (0)
#define PG8_MMA(ai, bj, At, Bt) do { __builtin_amdgcn_s_setprio(1); _Pragma("unroll") for (int m = 0; m < 4; ++m) _Pragma("unroll") for (int n = 0; n < 2; ++n) _Pragma("unroll") for (int k = 0; k < 2; ++k) \
        acc[ai][bj][m][n] = __builtin_amdgcn_mfma_f32_16x16x32_bf16(Bt[n][k], At[m][k], acc[ai][bj][m][n], 0, 0, 0); __builtin_amdgcn_s_setprio(0); } while (0)
#define PG8_WAIT_V(n) asm volatile("s_waitcnt vmcnt(" #n ")" ::: "memory")
#define PG8_WAIT_L(n) asm volatile("s_waitcnt lgkmcnt(" #n ")" ::: "memory")
#define PG8_BAR __builtin_amdgcn_s_barrier()
#define PG8_SCHED __builtin_amdgcn_sched_barrier(0)
    Unit cur, nxt; int ui = 0;
    if (!S.next(0, cur)) return;
    f32x4 acc[2][2][4][2];
#pragma unroll
    for (int a = 0; a < 2; ++a)
#pragma unroll
        for (int b = 0; b < 2; ++b)
#pragma unroll
            for (int m = 0; m < 4; ++m)
#pragma unroll
                for (int n = 0; n < 2; ++n) acc[a][b][m][n] = (f32x4){0.f, 0.f, 0.f, 0.f};
    bf16x8 At[4][2], B0[2][2], B1[2][2];
    const char* cA = (const char*)g.A + (size_t)cur.pm * tstep; const char* cB = (const char*)g.Bt + (size_t)btile(g, cur) * tstep;
    S.a_ready(cur);
    if constexpr (SP2) {
        PG8_STAGE(PG8_SB(0, 0), cB, voffB); PG8_STAGE(PG8_SB(0, 1), cB + hstep, voffB); PG8_STAGE(PG8_SA(0, 0), cA, voffA); PG8_STAGE(PG8_SA(0, 1), cA + hstep, voffA);
        if (wr == 1) PG8_BAR;
        PG8_WAIT_V(2); PG8_BAR;
        PG8_STAGE(PG8_SB(1, 0), cB + kstep, voffB); PG8_STAGE(PG8_SA(1, 0), cA + kstep, voffA); PG8_STAGE(PG8_SB(1, 1), cB + hstep + kstep, voffB);
        PG8_WAIT_V(6); PG8_BAR;
    } else {
        PG8_STAGE(PG8_SB(0, 0), cB, voffB); PG8_STAGE(PG8_SA(0, 0), cA, voffA); PG8_STAGE(PG8_SB(0, 1), cB + hstep, voffB); PG8_STAGE(PG8_SA(0, 1), cA + hstep, voffA);
        if (wr == 1) PG8_BAR;
        PG8_WAIT_V(4); PG8_BAR;
        PG8_STAGE(PG8_SB(1, 0), cB + kstep, voffB); PG8_STAGE(PG8_SA(1, 0), cA + kstep, voffA); PG8_STAGE(PG8_SB(1, 1), cB + hstep + kstep, voffB);
        PG8_WAIT_V(6); PG8_BAR;
    }
    for (;;) {
        const bool has_next = S.next(ui + 1, nxt);
        const char* nA = has_next ? (const char*)g.A + (size_t)nxt.pm * tstep : cA; const char* nB = has_next ? (const char*)g.Bt + (size_t)btile(g, nxt) * tstep : cB;
        for (int t = 0; t < nt; t += 2) {
            const bool last = (t == nt - 2);
            const char* a1 = cA + (size_t)(t + 1) * kstep;
            const char* a2 = last ? nA : cA + (size_t)(t + 2) * kstep; const char* b2 = last ? nB : cB + (size_t)(t + 2) * kstep;
            const char* a3 = a2 + kstep; const char* b3 = b2 + kstep;
            if (last && has_next) S.a_ready(nxt);
            if constexpr (SP2) {
            PG8_LDB(B0, 0, 0); PG8_LDB(B1, 0, 1); PG8_SCHED; PG8_LDA(At, 0, 0); PG8_STAGE(PG8_SA(1, 1), a1 + hstep, voffA);
            PG8_WAIT_V(8); PG8_WAIT_L(0); PG8_BAR; PG8_MMA(0, 0, At, B0); PG8_MMA(0, 1, At, B1); PG8_BAR; PG8_SCHED;
            PG8_LDA(At, 0, 1); PG8_STAGE(PG8_SB(0, 0), b2, voffB); PG8_STAGE(PG8_SB(0, 1), b2 + hstep, voffB); PG8_STAGE(PG8_SA(0, 0), a2, voffA);
            PG8_WAIT_V(8); PG8_WAIT_L(0); PG8_BAR; PG8_MMA(1, 0, At, B0); PG8_MMA(1, 1, At, B1); PG8_BAR; PG8_SCHED;
            PG8_LDB(B0, 1, 0); PG8_LDB(B1, 1, 1); PG8_SCHED; PG8_LDA(At, 1, 0); PG8_STAGE(PG8_SA(0, 1), a2 + hstep, voffA);
            PG8_WAIT_V(8); PG8_WAIT_L(0); PG8_BAR; PG8_MMA(0, 0, At, B0); PG8_MMA(0, 1, At, B1); PG8_BAR; PG8_SCHED;
            PG8_LDA(At, 1, 1); PG8_STAGE(PG8_SB(1, 0), b3, voffB); PG8_STAGE(PG8_SB(1, 1), b3 + hstep, voffB); PG8_STAGE(PG8_SA(1, 0), a3, voffA);
            PG8_WAIT_V(8); PG8_WAIT_L(0); PG8_BAR; PG8_MMA(1, 0, At, B0); PG8_MMA(1, 1, At, B1); PG8_BAR; PG8_SCHED;
            } else {
            PG8_LDB(B0, 0, 0); PG8_SCHED; PG8_LDA(At, 0, 0); PG8_STAGE(PG8_SA(1, 1), a1 + hstep, voffA);
            PG8_WAIT_L(8); PG8_BAR; PG8_WAIT_L(0); PG8_MMA(0, 0, At, B0); PG8_BAR; PG8_SCHED;
            PG8_LDB(B1, 0, 1); PG8_STAGE(PG8_SB(0, 0), b2, voffB);
            PG8_BAR; PG8_WAIT_L(0); PG8_MMA(0, 1, At, B1); PG8_BAR;
            PG8_LDA(At, 0, 1); PG8_STAGE(PG8_SA(0, 0), a2, voffA);
            PG8_BAR; PG8_WAIT_L(0); PG8_MMA(1, 0, At, B0); PG8_BAR; PG8_SCHED;
            PG8_STAGE(PG8_SB(0, 1), b2 + hstep, voffB);
            PG8_WAIT_V(6); PG8_BAR; PG8_MMA(1, 1, At, B1); PG8_BAR;
            PG8_LDB(B0, 1, 0); PG8_SCHED; PG8_LDA(At, 1, 0); PG8_STAGE(PG8_SA(0, 1), a2 + hstep, voffA);
            PG8_WAIT_L(8); PG8_BAR; PG8_WAIT_L(0); PG8_MMA(0, 0, At, B0); PG8_BAR; PG8_SCHED;
            PG8_LDB(B1, 1, 1); PG8_STAGE(PG8_SB(1, 0), b3, voffB);
            PG8_BAR; PG8_WAIT_L(0); PG8_MMA(0, 1, At, B1); PG8_BAR;
            PG8_LDA(At, 1, 1); PG8_STAGE(PG8_SA(1, 0), a3, voffA);
            PG8_BAR; PG8_WAIT_L(0); PG8_MMA(1, 0, At, B0); PG8_BAR; PG8_SCHED;
            PG8_STAGE(PG8_SB(1, 1), b3 + hstep, voffB);
            PG8_WAIT_V(6); PG8_BAR; PG8_MMA(1, 1, At, B1); PG8_BAR;
            }
        }
        if constexpr (ALIGN_EPI) { if (wr == 0) PG8_BAR; }
        if constexpr (!Epi::AFTER_DRAIN) { E(acc, cur, wr, wc, fr, fq); S.done(cur); }
        if (!has_next) break;
#pragma unroll
        for (int a = 0; a < 2; ++a)
#pragma unroll
            for (int b = 0; b < 2; ++b)
#pragma unroll
                for (int m = 0; m < 4; ++m)
#pragma unroll
                    for (int n = 0; n < 2; ++n) acc[a][b][m][n] = (f32x4){0.f, 0.f, 0.f, 0.f};
        cur = nxt; cA = nA; cB = nB; ++ui;
        if constexpr (ALIGN_EPI) { if (wr == 1) PG8_BAR; }
    }
    PG8_WAIT_V(0);
    if constexpr (!ALIGN_EPI) { if (wr == 0) PG8_BAR; }
    PG8_BAR;
    if constexpr (Epi::AFTER_DRAIN) { E.fused(acc, cur, wr, wc, fr, fq, lds, wid, lane); S.done(cur); }
#undef PG8_SA
#undef PG8_SB
#undef PG8_STAGE
#undef PG8_LDA
#undef PG8_LDB
#undef PG8_MMA
#undef PG8_WAIT_V
#undef PG8_WAIT_L
#undef PG8_BAR
#undef PG8_SCHED
}
}

#ifndef MK_MULTI
#define MK_MULTI 0
#endif
#ifndef REPEAT_MASK
#define REPEAT_MASK 0
#endif
#ifndef EXTRA_SYNCS
#define EXTRA_SYNCS 0
#endif
constexpr int NWAVES = 8;
constexpr int BATCH = 2, SEQ = 8192, D = 2048, CW = 1024, PW = 1024, NPROJ = 4096, FF = 5632;
constexpr int M = BATCH * SEQ;
constexpr float EPS = 1e-6f;
constexpr int NPHASE = 9;

constexpr size_t MiB = 1u << 20;
constexpr size_t WS_CTL = 0, CTL_ZERO_BYTES = 16384;
constexpr size_t WS_PART1 = 1 * MiB, WS_PART2 = 3 * MiB;
constexpr size_t WS_WD = 5 * MiB;
constexpr size_t WS_WIN = 27 * MiB;
constexpr size_t WS_WOUT = 43 * MiB;
constexpr size_t WS_WGU = 51 * MiB;
constexpr size_t WS_WPOOL = 95 * MiB;
constexpr size_t WS_H = 96 * MiB;
constexpr size_t WS_FF = 27 * MiB;
constexpr size_t WS_PROJ = 160 * MiB;
constexpr size_t WS_POOLED = 288 * MiB;
constexpr size_t WS_MIXED = 320 * MiB;
constexpr size_t WS_MIXOUT = 160 * MiB;
constexpr size_t WS_ACT = 160 * MiB;
constexpr size_t WS_END = 384 * MiB;
static_assert(WS_FF + (size_t)M * D * 4 <= WS_PROJ && WS_ACT + (size_t)M * FF * 2 <= WS_END && WS_WD + (size_t)D * FF * 2 <= WS_FF, "d_ws map");

constexpr int RING_BYTES = 131072, EPI_SCR_OFF = RING_BYTES, MISC_OFF = RING_BYTES + 4096, LDS_BYTES = 147456;

#define GAS __attribute__((address_space(1)))
#define LAS __attribute__((address_space(3)))
typedef unsigned short bf16;
typedef unsigned v4u __attribute__((ext_vector_type(4)));
typedef unsigned v2u __attribute__((ext_vector_type(2)));
typedef float f32x4 __attribute__((ext_vector_type(4)));
#define LDS_WAIT() asm volatile("s_waitcnt lgkmcnt(0)" ::: "memory")
__device__ __forceinline__ unsigned f2bf(float f) { unsigned u = __builtin_bit_cast(unsigned, f); return (u + 0x7fffu + ((u >> 16) & 1u)) >> 16; }
__device__ __forceinline__ unsigned pk2(float lo, float hi) { return f2bf(lo) | (f2bf(hi) << 16); }
__device__ __forceinline__ float bflo(unsigned w) { return __builtin_bit_cast(float, w << 16); }
__device__ __forceinline__ float bfhi(unsigned w) { return __builtin_bit_cast(float, w & 0xffff0000u); }
__device__ __forceinline__ float wave_sum(float v) {
#pragma unroll
    for (int o = 1; o < 64; o <<= 1) v += __shfl_xor(v, o);
    return v;
}

typedef GAS unsigned gu32;
#define RLX_AGENT __ATOMIC_RELAXED, __HIP_MEMORY_SCOPE_AGENT
#define XB_TMO      128
#define XB_XCNT(j)  (256  + 64 * (j))
#define XB_XSUB(j)  (1280 + 64 * (j))
#define XB_XGEN(j)  (2304 + 64 * (j))
#define XB_TOP      3328
#define XB_TOPGEN   3392
#define XCD_BAR_WORDS 3456
#define XB_SPIN_CAP (1u << 18)

__device__ __forceinline__ unsigned xb_ld(unsigned* p)              { return __hip_atomic_load(p, __ATOMIC_RELAXED, __HIP_MEMORY_SCOPE_AGENT); }
__device__ __forceinline__ unsigned xb_add(unsigned* p, unsigned v) { return __hip_atomic_fetch_add(p, v, __ATOMIC_RELAXED, __HIP_MEMORY_SCOPE_AGENT); }
__device__ __forceinline__ unsigned xb_xcc_id() { return (unsigned)__builtin_amdgcn_s_getreg((3 << 11) | 20) & 0xFu; }
#define XB_SPIN(cond, bar) do { unsigned _sp = 0; while (cond) { __builtin_amdgcn_s_sleep(1); \
    if ((++_sp & 255u) == 0u) { if (xb_ld(&(bar)[XB_TMO])) break; if (_sp > XB_SPIN_CAP) { atomicAdd(&(bar)[XB_TMO], 1u); break; } } } } while (0)

struct XcdBarrier {
    unsigned* bar; unsigned x;
    volatile LAS unsigned* st;
};

__device__ __forceinline__ XcdBarrier xcd_barrier_post(unsigned* bar, volatile LAS unsigned* st) {
    XcdBarrier b; b.bar = bar; b.x = xb_xcc_id(); b.st = st;
    if (threadIdx.x == 0) (void)xb_add(&bar[XB_XCNT(b.x)], 1u);
    return b;
}
__device__ __forceinline__ void xcd_barrier_complete(unsigned* bar, unsigned x, unsigned& nloc, unsigned& nx) {
    const unsigned G = gridDim.x * gridDim.y * gridDim.z;
    unsigned sum, cnt, mine, sp = 0u;
    for (;;) {
        sum = 0u; cnt = 0u; mine = 0u;
#pragma unroll
        for (unsigned j = 0; j < 16; ++j) { const unsigned c = xb_ld(&bar[XB_XCNT(j)]); sum += c; cnt += (c > 0u) ? 1u : 0u; mine = (j == x) ? c : mine; }
        if (sum == G) break;
        __builtin_amdgcn_s_sleep(1);
        if ((++sp & 255u) == 0u) { if (xb_ld(&bar[XB_TMO])) break; if (sp > XB_SPIN_CAP) { atomicAdd(&bar[XB_TMO], 1u); break; } }
    }
    nloc = mine > 0u ? mine : 1u; nx = cnt > 0u ? cnt : 1u;
}

__device__ __forceinline__ void xcd_barrier(const XcdBarrier& b) {
    asm volatile("s_waitcnt vmcnt(0)" ::: "memory");
    __syncthreads();
    if (threadIdx.x == 0) {
        unsigned* bar = b.bar;
        __builtin_amdgcn_s_waitcnt(0);
        unsigned nloc = b.st[0], nx = b.st[1];
        if (nloc == 0u) { xcd_barrier_complete(bar, b.x, nloc, nx); b.st[0] = nloc; b.st[1] = nx; }
        const unsigned old = xb_add(&bar[XB_XSUB(b.x)], 1u);
        const unsigned gen = old / nloc;
        if (old + 1u == (gen + 1u) * nloc) {
            __builtin_amdgcn_fence(__ATOMIC_RELEASE, "agent");
            asm volatile("s_waitcnt vmcnt(0)" ::: "memory");
            const unsigned og = xb_add(&bar[XB_TOP], 1u);
            const unsigned tg = og / nx;
            if (og + 1u == (tg + 1u) * nx) xb_add(&bar[XB_TOPGEN], 1u);
            else XB_SPIN(xb_ld(&bar[XB_TOPGEN]) == tg, bar);
            __builtin_amdgcn_fence(__ATOMIC_ACQUIRE, "agent");
            xb_add(&bar[XB_XGEN(b.x)], 1u);
            asm volatile("s_waitcnt vmcnt(0)" ::: "memory");
        } else {
            XB_SPIN(xb_ld(&bar[XB_XGEN(b.x)]) == gen, bar);
            __builtin_amdgcn_fence(__ATOMIC_ACQUIRE, "agent");
            asm volatile("s_waitcnt vmcnt(0)" ::: "memory");
        }
    }
    __syncthreads();
}

struct Frame {
    LAS unsigned char* lds;
    int tid, lane, wave, vcu, G;
    const float *x, *g_pre, *w_in, *conv_w, *pool_w, *pool_scale, *w_out, *g_post, *g_fpre, *w_gate, *w_up, *w_down, *g_fpost;
    float* out; unsigned char* ws;
};

template <int MODE>
__device__ __forceinline__ void p0_transpose_item(const float* W, int K, int N, bf16* WT, LAS float* scr, int item, int lane) {
    const int nblk = N / 32, kb = item / nblk, nb = item % nblk, k0 = 64 * kb, n0 = 32 * nb;
    const int drow0 = MODE == 0 ? n0 : ((n0 >> 7) * 256 + (n0 & 127) + (MODE == 2 ? 128 : 0));
#pragma unroll 8
    for (int i = 0; i < 32; ++i) { const int kk = 2 * i + (lane >> 5); scr[kk * 33 + (lane & 31)] = W[(size_t)(k0 + kk) * N + n0 + (lane & 31)]; }
    LDS_WAIT(); asm volatile("" ::: "memory");
    const int c = lane & 7;
#pragma unroll
    for (int j = 0; j < 4; ++j) { const int n = (lane >> 3) + 8 * j; const LAS float* s = scr + (8 * c) * 33 + n;
        v4u o; o.x = pk2(s[0 * 33], s[1 * 33]); o.y = pk2(s[2 * 33], s[3 * 33]); o.z = pk2(s[4 * 33], s[5 * 33]); o.w = pk2(s[6 * 33], s[7 * 33]);
        *(GAS v4u*)(WT + (size_t)(drow0 + n) * K + k0 + 8 * c) = o; }
    LDS_WAIT(); asm volatile("" ::: "memory");
}

__device__ __forceinline__ void p0_prologue(Frame& F) {
    LAS float* scr = (LAS float*)(F.lds + F.wave * 16384);
    const int gw = F.vcu * NWAVES + F.wave, NGW = F.G * NWAVES;
    unsigned char* ws = F.ws;
    constexpr int I_IN = (D / 64) * (NPROJ / 32), I_OUT = (D / 64) * (D / 32), I_G = (D / 64) * (FF / 32), I_D = (FF / 64) * (D / 32), I_P1 = (256 / 64) * (256 / 32), I_P = 4 * I_P1;
    constexpr int NITEMS = I_IN + I_OUT + 2 * I_G + I_D + I_P;
    for (int it = gw; it < NITEMS; it += NGW) {
        int r = it;
        if (r < I_IN) { p0_transpose_item<0>(F.w_in, D, NPROJ, (bf16*)(ws + WS_WIN), scr, r, F.lane); continue; } r -= I_IN;
        if (r < I_OUT) { p0_transpose_item<0>(F.w_out, D, D, (bf16*)(ws + WS_WOUT), scr, r, F.lane); continue; } r -= I_OUT;
        if (r < I_G) { p0_transpose_item<1>(F.w_gate, D, FF, (bf16*)(ws + WS_WGU), scr, r, F.lane); continue; } r -= I_G;
        if (r < I_G) { p0_transpose_item<2>(F.w_up, D, FF, (bf16*)(ws + WS_WGU), scr, r, F.lane); continue; } r -= I_G;
        if (r < I_D) { p0_transpose_item<0>(F.w_down, FF, D, (bf16*)(ws + WS_WD), scr, r, F.lane); continue; } r -= I_D;
        { const int g = r / I_P1; p0_transpose_item<0>(F.pool_w + (size_t)g * 65536, 256, 256, (bf16*)(ws + WS_WPOOL) + (size_t)g * 65536, scr, r % I_P1, F.lane); }
    }
    f32x4 gv[8];
#pragma unroll
    for (int j = 0; j < 8; ++j) gv[j] = ((const GAS f32x4*)F.g_pre)[F.lane + 64 * j];
    bf16* H = (bf16*)(ws + WS_H);
    for (int m = gw; m < M; m += NGW) {
        const GAS f32x4* xr = (const GAS f32x4*)(F.x + (size_t)m * D) + F.lane;
        f32x4 v[8]; float s = 0.f;
#pragma unroll
        for (int j = 0; j < 8; ++j) { v[j] = xr[64 * j]; s += (v[j].x * v[j].x + v[j].y * v[j].y) + (v[j].z * v[j].z + v[j].w * v[j].w); }
        const float rstd = 1.0f / sqrtf(wave_sum(s) * (1.0f / D) + EPS);
        GAS v2u* o8 = (GAS v2u*)(H + (size_t)m * D) + F.lane;
#pragma unroll
        for (int j = 0; j < 8; ++j) { const f32x4 y = v[j] * rstd * gv[j]; v2u w; w.x = pk2(y.x, y.y); w.y = pk2(y.z, y.w); o8[64 * j] = w; }
    }
}

__device__ __forceinline__ void unpack16(const bf16* p, float (&f)[16]) {
    const v4u a = *(const GAS v4u*)p, b = *((const GAS v4u*)p + 1);
    f[0] = bflo(a.x); f[1] = bfhi(a.x); f[2] = bflo(a.y); f[3] = bfhi(a.y); f[4] = bflo(a.z); f[5] = bfhi(a.z); f[6] = bflo(a.w); f[7] = bfhi(a.w);
    f[8] = bflo(b.x); f[9] = bfhi(b.x); f[10] = bflo(b.y); f[11] = bfhi(b.y); f[12] = bflo(b.z); f[13] = bfhi(b.z); f[14] = bflo(b.w); f[15] = bfhi(b.w);
}
__device__ __forceinline__ void pack16_store(bf16* p, const float (&f)[16]) {
    v4u a, b; a.x = pk2(f[0], f[1]); a.y = pk2(f[2], f[3]); a.z = pk2(f[4], f[5]); a.w = pk2(f[6], f[7]);
    b.x = pk2(f[8], f[9]); b.y = pk2(f[10], f[11]); b.z = pk2(f[12], f[13]); b.w = pk2(f[14], f[15]);
    *(GAS v4u*)p = a; *((GAS v4u*)p + 1) = b;
}
__device__ __forceinline__ void p2_mixer(Frame& F) {
    const int gw = F.vcu * NWAVES + F.wave, NGW = F.G * NWAVES, l = F.lane;
    const bf16* P = (const bf16*)(F.ws + WS_PROJ);
    bf16* MIX = (bf16*)(F.ws + WS_MIXED); bf16* PO = (bf16*)(F.ws + WS_POOLED);
    float w0[16], w1[16], w2[16];
#pragma unroll
    for (int i = 0; i < 16; ++i) { w0[i] = F.conv_w[0 * CW + 16 * l + i]; w1[i] = F.conv_w[1 * CW + 16 * l + i]; w2[i] = F.conv_w[2 * CW + 16 * l + i]; }
    const int wlen = 2 << (l >> 4);
    for (int chunk = gw; chunk < M / 8; chunk += NGW) {
        const int m0 = chunk * 8, t0 = m0 % SEQ;
        {
            float cu1[16], cu2[16];
#pragma unroll
            for (int i = 0; i < 16; ++i) { cu1[i] = 0.f; cu2[i] = 0.f; }
            if (t0 > 0) {
                float c[16], u[16];
                unpack16(P + (size_t)(m0 - 1) * NPROJ + CW + 16 * l, c); unpack16(P + (size_t)(m0 - 1) * NPROJ + 2 * CW + 16 * l, u);
#pragma unroll
                for (int i = 0; i < 16; ++i) cu1[i] = c[i] * u[i];
                unpack16(P + (size_t)(m0 - 2) * NPROJ + CW + 16 * l, c); unpack16(P + (size_t)(m0 - 2) * NPROJ + 2 * CW + 16 * l, u);
#pragma unroll
                for (int i = 0; i < 16; ++i) cu2[i] = c[i] * u[i];
            }
#pragma unroll 1
            for (int r = 0; r < 8; ++r) {
                const bf16* row = P + (size_t)(m0 + r) * NPROJ + 16 * l;
                float b[16], c[16], u[16], y[16];
                unpack16(row, b); unpack16(row + CW, c); unpack16(row + 2 * CW, u);
                float ss = 0.f;
#pragma unroll
                for (int i = 0; i < 16; ++i) { const float cu0 = c[i] * u[i]; y[i] = b[i] * (w0[i] * cu2[i] + w1[i] * cu1[i] + w2[i] * cu0); ss += y[i] * y[i]; cu2[i] = cu1[i]; cu1[i] = cu0; }
                ss += __shfl_xor(ss, 1); ss += __shfl_xor(ss, 2); ss += __shfl_xor(ss, 4);
                const float rstd = 1.0f / sqrtf(ss * (1.0f / 128.0f) + EPS);
#pragma unroll
                for (int i = 0; i < 16; ++i) y[i] *= rstd;
                pack16_store(MIX + (size_t)(m0 + r) * D + 16 * l, y);
            }
        }
        {
            const bf16* vcol = P + 3 * CW + 16 * l;
            float S[16];
#pragma unroll
            for (int i = 0; i < 16; ++i) S[i] = 0.f;
#pragma unroll 1
            for (int j = 1; j < 16; ++j) if (j < wlen && t0 - j >= 0) { float v[16]; unpack16(vcol + (size_t)(m0 - j) * NPROJ, v);
#pragma unroll
                for (int i = 0; i < 16; ++i) S[i] += v[i]; }
            bf16* orow = PO + ((size_t)(l >> 4) * M + m0) * 256 + 16 * (l & 15);
#pragma unroll 1
            for (int r = 0; r < 8; ++r) {
                const int t = t0 + r; float v[16], o[16]; unpack16(vcol + (size_t)(m0 + r) * NPROJ, v);
                const int cnt = (t + 1) < wlen ? (t + 1) : wlen; const float inv = 1.0f / (float)cnt;
#pragma unroll
                for (int i = 0; i < 16; ++i) { S[i] += v[i]; o[i] = S[i] * inv - v[i]; }
                pack16_store(orow + (size_t)r * 256, o);
                if (t - wlen + 1 >= 0) { float q[16]; unpack16(vcol + (size_t)(m0 + r - wlen + 1) * NPROJ, q);
#pragma unroll
                    for (int i = 0; i < 16; ++i) S[i] -= q[i]; }
            }
        }
    }
}

__device__ __forceinline__ void p5_resnorm(Frame& F) {
    const int gw = F.vcu * NWAVES + F.wave, NGW = F.G * NWAVES, l = F.lane;
    const float* MO = (const float*)(F.ws + WS_MIXOUT); const float* part = (const float*)(F.ws + WS_PART1); bf16* H = (bf16*)(F.ws + WS_H);
    f32x4 g1[8], g2[8];
#pragma unroll
    for (int j = 0; j < 8; ++j) { g1[j] = ((const GAS f32x4*)F.g_post)[l + 64 * j]; g2[j] = ((const GAS f32x4*)F.g_fpre)[l + 64 * j]; }
    for (int m = gw; m < M; m += NGW) {
        const float p = l < 32 ? part[(size_t)m * 32 + l] : 0.f;
        const float rstd1 = 1.0f / sqrtf(wave_sum(p) * (1.0f / D) + EPS);
        const GAS f32x4* xr = (const GAS f32x4*)(F.x + (size_t)m * D) + l; const GAS f32x4* mr = (const GAS f32x4*)(MO + (size_t)m * D) + l;
        GAS f32x4* orow = (GAS f32x4*)(F.out + (size_t)m * D) + l;
        f32x4 v[8]; float s = 0.f;
#pragma unroll
        for (int j = 0; j < 8; ++j) { v[j] = xr[64 * j] + mr[64 * j] * rstd1 * g1[j]; orow[64 * j] = v[j]; s += (v[j].x * v[j].x + v[j].y * v[j].y) + (v[j].z * v[j].z + v[j].w * v[j].w); }
        const float rstd2 = 1.0f / sqrtf(wave_sum(s) * (1.0f / D) + EPS);
        GAS v2u* o8 = (GAS v2u*)(H + (size_t)m * D) + l;
#pragma unroll
        for (int j = 0; j < 8; ++j) { const f32x4 y = v[j] * rstd2 * g2[j]; v2u w; w.x = pk2(y.x, y.y); w.y = pk2(y.z, y.w); o8[64 * j] = w; }
    }
}
__device__ __forceinline__ void p8_final(Frame& F) {
    const int gw = F.vcu * NWAVES + F.wave, NGW = F.G * NWAVES, l = F.lane;
    const float* FFO = (const float*)(F.ws + WS_FF); const float* part = (const float*)(F.ws + WS_PART2);
    f32x4 g3[8];
#pragma unroll
    for (int j = 0; j < 8; ++j) g3[j] = ((const GAS f32x4*)F.g_fpost)[l + 64 * j];
    for (int m = gw; m < M; m += NGW) {
        const float p = l < 32 ? part[(size_t)m * 32 + l] : 0.f;
        const float rstd = 1.0f / sqrtf(wave_sum(p) * (1.0f / D) + EPS);
        const GAS f32x4* fr = (const GAS f32x4*)(FFO + (size_t)m * D) + l; GAS f32x4* orow = (GAS f32x4*)(F.out + (size_t)m * D) + l;
#pragma unroll
        for (int j = 0; j < 8; ++j) orow[64 * j] = orow[64 * j] + fr[64 * j] * rstd * g3[j];
    }
}

struct Args { const float* in[13]; float* out; unsigned char* ws; int ph_lo, ph_hi; };
__global__ void __launch_bounds__(NWAVES * 64, 2) mk_fwd(Args args) {
    extern __shared__ __attribute__((aligned(16))) unsigned char lds[];
    Frame F;
    F.lds = (LAS unsigned char*)lds;
    F.tid = threadIdx.x; F.lane = F.tid & 63; F.wave = __builtin_amdgcn_readfirstlane(F.tid >> 6);
    F.G = gridDim.x; { const int bx = blockIdx.x; F.vcu = (F.G % 8 == 0) ? (bx % 8) * (F.G / 8) + bx / 8 : bx; }
    F.x = args.in[0]; F.g_pre = args.in[1]; F.w_in = args.in[2]; F.conv_w = args.in[3]; F.pool_w = args.in[4]; F.pool_scale = args.in[5]; F.w_out = args.in[6];
    F.g_post = args.in[7]; F.g_fpre = args.in[8]; F.w_gate = args.in[9]; F.w_up = args.in[10]; F.w_down = args.in[11]; F.g_fpost = args.in[12];
    F.out = args.out; F.ws = args.ws;
    unsigned char* ws = args.ws;
    const int lo = args.ph_lo, hi = args.ph_hi;
#ifdef ONLY_PHASE
#define IN(k) ((k) == ONLY_PHASE && lo <= (k) && (k) < hi)
#else
#define IN(k) (lo <= (k) && (k) < hi)
#endif
#if MK_MULTI
#define SEAM(k) do { } while (0)
#else
    volatile LAS unsigned* MISC = (volatile LAS unsigned*)(F.lds + MISC_OFF);
    if (F.tid < 64) MISC[F.tid] = 0u;
    __syncthreads();
    const XcdBarrier bar = xcd_barrier_post((unsigned*)(ws + WS_CTL), MISC + 8);
#define GRID_SYNC() xcd_barrier(bar)
#define SEAM(k) do { if (IN(k) && IN((k) + 1)) GRID_SYNC(); } while (0)
#endif
#if MK_MULTI
#define REP(k) for (int rep_ = 0; rep_ < 1; ++rep_)
#else
#define REP(k) for (int rep_ = 0; rep_ < 1 + ((REPEAT_MASK >> (k)) & 1); ++rep_, (rep_ < 1 + ((REPEAT_MASK >> (k)) & 1) ? GRID_SYNC() : (void)0))
#endif
    typedef pg8::bf16_t bt;
    if (IN(0)) REP(0) p0_prologue(F);
#if !MK_MULTI
    for (int e_ = 0; e_ < EXTRA_SYNCS; ++e_) GRID_SYNC();
#endif
    SEAM(0);
    if (IN(1)) REP(1) {
        pg8::Gemm g{(const bt*)(ws + WS_H), (const bt*)(ws + WS_WIN), M, NPROJ, D, 0}; pg8::StaticOrder S; S.init(M, NPROJ, F.G, (int)blockIdx.x);
        pg8::EpiBf16 E{(bt*)(ws + WS_PROJ), NPROJ};
        pg8::gemm_phase<pg8::EpiBf16, pg8::StaticOrder, true, true>(F.lds, g, S, E);
    }
    SEAM(1);
    if (IN(2)) REP(2) p2_mixer(F);
    SEAM(2);
    if (IN(3)) REP(3) {
        int kpool = 256; asm volatile("" : "+s"(kpool));
        pg8::Gemm g{(const bt*)(ws + WS_POOLED), (const bt*)(ws + WS_WPOOL), 4 * M, 256, kpool, 64}; pg8::StaticOrder S; S.init(4 * M, 256, F.G, (int)blockIdx.x);
        pg8::EpiPool E{(bt*)(ws + WS_MIXED), D, F.pool_scale, (LAS float*)(F.lds + EPI_SCR_OFF), EPS};
        pg8::gemm_phase<pg8::EpiPool, pg8::StaticOrder, true, true>(F.lds, g, S, E);
    }
    SEAM(3);
    if (IN(4)) REP(4) {
        pg8::Gemm g{(const bt*)(ws + WS_MIXED), (const bt*)(ws + WS_WOUT), M, D, D, 0}; pg8::StaticOrder S; S.init(M, D, F.G, (int)blockIdx.x);
        pg8::EpiF32Stat E{(float*)(ws + WS_MIXOUT), D, (float*)(ws + WS_PART1)};
        pg8::gemm_phase<pg8::EpiF32Stat, pg8::StaticOrder, true, true>(F.lds, g, S, E);
    }
    SEAM(4);
    if (IN(5)) REP(5) p5_resnorm(F);
    SEAM(5);
    if (IN(6)) REP(6) {
        pg8::Gemm g{(const bt*)(ws + WS_H), (const bt*)(ws + WS_WGU), M, 2 * FF, D, 0}; pg8::StaticOrder S; S.init(M, 2 * FF, F.G, (int)blockIdx.x);
        pg8::EpiSwiGLU E{(bt*)(ws + WS_ACT), FF};
        pg8::gemm_phase<pg8::EpiSwiGLU, pg8::StaticOrder, true, true>(F.lds, g, S, E);
    }
    SEAM(6);
    if (IN(7)) REP(7) {
        pg8::Gemm g{(const bt*)(ws + WS_ACT), (const bt*)(ws + WS_WD), M, D, FF, 0}; pg8::StaticOrder S; S.init(M, D, F.G, (int)blockIdx.x);
        pg8::EpiF32Stat E{(float*)(ws + WS_FF), D, (float*)(ws + WS_PART2)};
        pg8::gemm_phase<pg8::EpiF32Stat, pg8::StaticOrder, true, true>(F.lds, g, S, E);
    }
    SEAM(7);
    if (IN(8)) p8_final(F);
#undef IN
#undef SEAM
#undef REP
}

extern "C" void kernel_launch(void* const* d_in, const int* in_sizes, int n_in, void* d_out, int out_size, void* d_ws, size_t ws_size, hipStream_t stream) {
    static int grid = 0;
    if (grid == 0) {
        if (n_in != 13 || in_sizes[0] != M * D || out_size != M * D || ws_size < WS_END) { fprintf(stderr, "kernel_launch: shape/workspace mismatch (n_in %d, in0 %d, out %d, ws %zu, need %zu); nothing launched\n", n_in, n_in > 0 ? in_sizes[0] : -1, out_size, ws_size, (size_t)WS_END); grid = -1; return; }
        int dev = 0, cus = 0, per_cu = 0;
        if (hipGetDevice(&dev) != hipSuccess || hipDeviceGetAttribute(&cus, hipDeviceAttributeMultiprocessorCount, dev) != hipSuccess) { fprintf(stderr, "kernel_launch: device query failed\n"); grid = -1; return; }
        if (hipFuncSetAttribute((const void*)mk_fwd, hipFuncAttributeMaxDynamicSharedMemorySize, LDS_BYTES) != hipSuccess) { fprintf(stderr, "kernel_launch: hipFuncSetAttribute failed\n"); grid = -1; return; }
        if (hipOccupancyMaxActiveBlocksPerMultiprocessor(&per_cu, (const void*)mk_fwd, NWAVES * 64, LDS_BYTES) != hipSuccess || per_cu < 1) { fprintf(stderr, "kernel_launch: occupancy query says %d blocks per CU\n", per_cu); per_cu = 1; }
        (void)hipGetLastError();
        grid = cus;
    }
    if (grid < 0) return;
    Args a{};
    for (int i = 0; i < 13; ++i) a.in[i] = (const float*)d_in[i];
    a.out = (float*)d_out; a.ws = (unsigned char*)d_ws;
#if MK_MULTI
    for (int p = 0; p < NPHASE; ++p) { a.ph_lo = p; a.ph_hi = p + 1; hipLaunchKernelGGL(mk_fwd, dim3(grid), dim3(NWAVES * 64), LDS_BYTES, stream, a); }
#else
    a.ph_lo = 0; a.ph_hi = NPHASE;
    if (hipMemsetAsync((char*)d_ws + WS_CTL, 0, CTL_ZERO_BYTES, stream) != hipSuccess) { fprintf(stderr, "kernel_launch: hipMemsetAsync failed\n"); return; }
    hipLaunchKernelGGL(mk_fwd, dim3(grid), dim3(NWAVES * 64), LDS_BYTES, stream, a);
    const hipError_t e = hipPeekAtLastError();
    if (e != hipSuccess) fprintf(stderr, "kernel_launch: launch failed: %s (grid %d)\n", hipGetErrorString(e), grid);
#endif
}
```

```cpp
#include <hip/hip_runtime.h>
#include <cstdio>
#include <cstdint>
namespace pg8 {
#define PG8_LAS __attribute__((address_space(3)))
typedef unsigned short bf16_t;
typedef short bf16x8 __attribute__((ext_vector_type(8)));
typedef float f32x4 __attribute__((ext_vector_type(4)));
typedef unsigned u32x4 __attribute__((ext_vector_type(4)));
constexpr int BM = 256, BK = 64, HALF = 128, HTB = HALF * BK * 2  , STAGE_BYTES = 8 * HTB, NXCD = 8, WGM = 8;

__host__ __device__ __forceinline__ int lds_byte(int r, int c) { const int st = (r >> 4) * 2 + (c >> 5), rr = r & 15, cc = c & 31, ob = rr * 64 + cc * 2; return st * 1024 + (ob ^ (((ob >> 9) & 1) << 5)); }
__host__ __device__ __forceinline__ void stage_rc(int b, int& R, int& C) { const int st = b / 1024, sb = b % 1024, swz = sb ^ (((sb >> 9) & 1) << 5); R = (st >> 1) * 16 + swz / 64; C = (st & 1) * 32 + (swz % 64) / 2; }
__host__ __device__ __forceinline__ int perm32(int rho) { const int n = rho >> 4, i = rho & 15; return 8 * (i >> 2) + 4 * n + (i & 3); }

struct Unit { int pm, pn; };
struct Gemm { const bf16_t* A; const bf16_t* Bt; int M, N, K; int bdiv; };
__device__ __forceinline__ int btile(const Gemm& g, const Unit& u) { return u.pn + (g.bdiv ? (u.pm / g.bdiv) * (g.N / BM) : 0); }

struct StaticOrder {
    int nM, nN, nwg, G, c;
    __host__ __device__ void init(int M, int N, int G_, int c_) { nM = M / BM; nN = N / BM; nwg = nM * nN; G = G_; c = c_; }
    __host__ __device__ bool next(int i, Unit& u) const {
        const long L = (long)i * G + c; if (L >= nwg) return false;
        int wgid = (int)L; { const int q = nwg / NXCD, r = nwg % NXCD, xcd = wgid % NXCD, off = wgid / NXCD; wgid = (xcd < r ? xcd * (q + 1) : r * (q + 1) + (xcd - r) * q) + off; }
        const int nig = WGM * nN, gid = wgid / nig, fm = gid * WGM, gsz = (nM - fm) < WGM ? (nM - fm) : WGM;
        u.pm = fm + ((wgid % nig) % gsz); u.pn = (wgid % nig) / gsz; return true;
    }
    __device__ __forceinline__ void a_ready(const Unit&) const {}
    __device__ __forceinline__ void done(const Unit&) const {}
};

__device__ __forceinline__ unsigned cvt_pk_bf16(float lo, float hi) { unsigned r; asm volatile("v_cvt_pk_bf16_f32 %0, %1, %2" : "=v"(r) : "v"(lo), "v"(hi)); return r; }

struct EpiBf16 {
    static constexpr bool PERM = true, AFTER_DRAIN = false;
    bf16_t* O; int ldc;
    __device__ __forceinline__ void operator()(const f32x4 (&acc)[2][2][4][2], const Unit& u, int wr, int wc, int fr, int fq) const {
        const int row0 = u.pm * BM + wr * 64 + fr; const int col0 = u.pn * BM + wc * 32 + 8 * fq;
#pragma unroll
        for (int ai = 0; ai < 2; ++ai)
#pragma unroll
            for (int m = 0; m < 4; ++m) { bf16_t* rowp = O + (size_t)(row0 + ai * HALF + m * 16) * ldc + col0;
#pragma unroll
                for (int bj = 0; bj < 2; ++bj) { const f32x4 v0 = acc[ai][bj][m][0], v1 = acc[ai][bj][m][1];
                    u32x4 w; w.x = cvt_pk_bf16(v0[0], v0[1]); w.y = cvt_pk_bf16(v0[2], v0[3]); w.z = cvt_pk_bf16(v1[0], v1[1]); w.w = cvt_pk_bf16(v1[2], v1[3]);
                    *(u32x4*)(rowp + bj * HALF) = w; } }
    }
};

__device__ __forceinline__ float silu_mul(float g, float u) { const float e = __builtin_amdgcn_exp2f(g * -1.4426950408889634f); return g * __builtin_amdgcn_rcpf(1.0f + e) * u; }
struct EpiSwiGLU {
    static constexpr bool PERM = true, AFTER_DRAIN = false;
    bf16_t* O; int ldc;
    __device__ __forceinline__ void operator()(const f32x4 (&acc)[2][2][4][2], const Unit& u, int wr, int wc, int fr, int fq) const {
        const int row0 = u.pm * BM + wr * 64 + fr; const int col0 = u.pn * HALF + wc * 32 + 8 * fq;
#pragma unroll
        for (int ai = 0; ai < 2; ++ai)
#pragma unroll
            for (int m = 0; m < 4; ++m) { bf16_t* rowp = O + (size_t)(row0 + ai * HALF + m * 16) * ldc + col0;
                const f32x4 g0 = acc[ai][0][m][0], g1 = acc[ai][0][m][1], u0 = acc[ai][1][m][0], u1 = acc[ai][1][m][1];
                u32x4 w; w.x = cvt_pk_bf16(silu_mul(g0[0], u0[0]), silu_mul(g0[1], u0[1])); w.y = cvt_pk_bf16(silu_mul(g0[2], u0[2]), silu_mul(g0[3], u0[3]));
                w.z = cvt_pk_bf16(silu_mul(g1[0], u1[0]), silu_mul(g1[1], u1[1])); w.w = cvt_pk_bf16(silu_mul(g1[2], u1[2]), silu_mul(g1[3], u1[3]));
                *(u32x4*)rowp = w; }
    }
};

struct EpiBf16Stat {
    static constexpr bool PERM = true, AFTER_DRAIN = false;
    bf16_t* O; int ldc; float* part;
    __device__ __forceinline__ void operator()(const f32x4 (&acc)[2][2][4][2], const Unit& u, int wr, int wc, int fr, int fq) const {
        const int col0 = u.pn * BM + wc * 32 + 8 * fq;
#pragma unroll
        for (int ai = 0; ai < 2; ++ai)
#pragma unroll
            for (int m = 0; m < 4; ++m) { const int r = u.pm * BM + ai * HALF + wr * 64 + m * 16 + fr; bf16_t* rowp = O + (size_t)r * ldc + col0; float s = 0.f;
#pragma unroll
                for (int bj = 0; bj < 2; ++bj) { const f32x4 v0 = acc[ai][bj][m][0], v1 = acc[ai][bj][m][1];
                    s += ((v0[0] * v0[0] + v0[1] * v0[1]) + (v0[2] * v0[2] + v0[3] * v0[3])) + ((v1[0] * v1[0] + v1[1] * v1[1]) + (v1[2] * v1[2] + v1[3] * v1[3]));
                    u32x4 w; w.x = cvt_pk_bf16(v0[0], v0[1]); w.y = cvt_pk_bf16(v0[2], v0[3]); w.z = cvt_pk_bf16(v1[0], v1[1]); w.w = cvt_pk_bf16(v1[2], v1[3]);
                    *(u32x4*)(rowp + bj * HALF) = w; }
                s += __shfl_xor(s, 16); s += __shfl_xor(s, 32);
                if (fq == 0) part[(size_t)r * 32 + u.pn * 4 + wc] = s; }
    }
};

struct EpiPool {
    static constexpr bool PERM = true, AFTER_DRAIN = false;
    bf16_t* O; int ldc; const float* scale; PG8_LAS float* scr; float eps;
    __device__ __forceinline__ void operator()(const f32x4 (&acc)[2][2][4][2], const Unit& u, int wr, int wc, int fr, int fq) const {
        const int grp = u.pm >> 6, rb = u.pm & 63;
#pragma unroll
        for (int ai = 0; ai < 2; ++ai)
#pragma unroll
            for (int m = 0; m < 4; ++m) { float s = 0.f;
#pragma unroll
                for (int bj = 0; bj < 2; ++bj)
#pragma unroll
                    for (int n = 0; n < 2; ++n) { const f32x4 v = acc[ai][bj][m][n]; s += (v[0] * v[0] + v[1] * v[1]) + (v[2] * v[2] + v[3] * v[3]); }
                s += __shfl_xor(s, 16); s += __shfl_xor(s, 32);
                if (fq == 0) scr[(ai * HALF + wr * 64 + m * 16 + fr) * 4 + wc] = s;
                asm volatile("" ::: "memory"); }
        asm volatile("s_waitcnt lgkmcnt(0)" ::: "memory"); __builtin_amdgcn_s_barrier(); asm volatile("" ::: "memory");
        const int gc0 = grp * BM + wc * 32 + 8 * fq;
#pragma unroll
        for (int ai = 0; ai < 2; ++ai)
#pragma unroll
            for (int m = 0; m < 4; ++m) { const int rl = ai * HALF + wr * 64 + m * 16 + fr; const f32x4 p = *(const PG8_LAS f32x4*)(scr + rl * 4);
                const float rstd = __builtin_amdgcn_rsqf(((p[0] + p[1]) + (p[2] + p[3])) * (1.0f / 256.0f) + eps);
                bf16_t* rowp = O + (size_t)(rb * BM + rl) * ldc + 1024 + gc0;
#pragma unroll
                for (int bj = 0; bj < 2; ++bj) { const f32x4 s0 = *(const f32x4*)(scale + gc0 + bj * HALF), s1 = *(const f32x4*)(scale + gc0 + bj * HALF + 4);
                    const f32x4 v0 = acc[ai][bj][m][0] * rstd * s0, v1 = acc[ai][bj][m][1] * rstd * s1;
                    u32x4 w; w.x = cvt_pk_bf16(v0[0], v0[1]); w.y = cvt_pk_bf16(v0[2], v0[3]); w.z = cvt_pk_bf16(v1[0], v1[1]); w.w = cvt_pk_bf16(v1[2], v1[3]);
                    *(u32x4*)(rowp + bj * HALF) = w; }
                asm volatile("" ::: "memory"); }
        asm volatile("s_waitcnt lgkmcnt(0)" ::: "memory"); __builtin_amdgcn_s_barrier(); asm volatile("" ::: "memory");
    }
};

template <class Epi, class Sched, bool ALIGN_EPI = false, bool SP2 = false>
__device__ __forceinline__ void gemm_phase(PG8_LAS unsigned char* lds, const Gemm g, const Sched& S, const Epi& E) {
    const int tid = threadIdx.x, wid = __builtin_amdgcn_readfirstlane(tid >> 6), lane = tid & 63, wr = wid >> 2, wc = wid & 3, fr = lane & 15, fq = lane >> 4;
    const int K = g.K, nt = K / BK;
    unsigned voffA[2], voffB[2];
#pragma unroll
    for (int i = 0; i < 2; ++i) { int R, C; stage_rc(tid * 16 + i * 8192, R, C); const int Rb = Epi::PERM ? ((R & ~31) + perm32(R & 31)) : R;
        voffA[i] = (unsigned)(R * K + C) * 2u; voffB[i] = (unsigned)(Rb * K + C) * 2u; }
    const size_t kstep = (size_t)(BK * 2);
    const size_t hstep = (size_t)HALF * K * 2;
    const size_t tstep = 2 * hstep;
    const unsigned ldsw = (unsigned)wid * 1024u;
    const int aoff = lds_byte(wr * 64 + fr, fq * 8), boff = lds_byte(wc * 32 + fr, fq * 8);
#define PG8_SA(b, h) (((b) * 2 + (h)) * HTB)
#define PG8_SB(b, h) ((4 + (b) * 2 + (h)) * HTB)
#define PG8_STAGE(bufoff, gbase, voff) do { _Pragma("unroll") for (int _i = 0; _i < 2; ++_i) \
        __builtin_amdgcn_global_load_lds((const unsigned*)((const char*)(gbase) + (voff)[_i]), (PG8_LAS unsigned*)(lds + (bufoff) + ldsw + _i * 8192), 16, 0, 0); } while (0)
#define PG8_LDA(dst, b, h) do { _Pragma("unroll") for (int m = 0; m < 4; ++m) _Pragma("unroll") for (int k = 0; k < 2; ++k) dst[m][k] = *(const PG8_LAS bf16x8*)(lds + PG8_SA(b, h) + aoff + m * 2048 + k * 1024); } while (0)
#define PG8_LDB(dst, b, h) do { _Pragma("unroll") for (int n = 0; n < 2; ++n) _Pragma("unroll") for (int k = 0; k < 2; ++k) dst[n][k] = *(const PG8_LAS bf16x8*)(lds + PG8_SB(b, h) + boff + n * 2048 + k * 1024); } while (0)
#define PG8_MMA(ai, bj, At, Bt) do { __builtin_amdgcn_s_setprio(1); _Pragma("unroll") for (int m = 0; m < 4; ++m) _Pragma("unroll") for (int n = 0; n < 2; ++n) _Pragma("unroll") for (int k = 0; k < 2; ++k) \
        acc[ai][bj][m][n] = __builtin_amdgcn_mfma_f32_16x16x32_bf16(Bt[n][k], At[m][k], acc[ai][bj][m][n], 0, 0, 0); __builtin_amdgcn_s_setprio(0); } while (0)
#define PG8_WAIT_V(n) asm volatile("s_waitcnt vmcnt(" #n ")" ::: "memory")
#define PG8_WAIT_L(n) asm volatile("s_waitcnt lgkmcnt(" #n ")" ::: "memory")
#define PG8_BAR __builtin_amdgcn_s_barrier()
#define PG8_SCHED __builtin_amdgcn_sched_barrier(0)
    Unit cur, nxt; int ui = 0;
    if (!S.next(0, cur)) return;
    f32x4 acc[2][2][4][2];
#pragma unroll
    for (int a = 0; a < 2; ++a)
#pragma unroll
        for (int b = 0; b < 2; ++b)
#pragma unroll
            for (int m = 0; m < 4; ++m)
#pragma unroll
                for (int n = 0; n < 2; ++n) acc[a][b][m][n] = (f32x4){0.f, 0.f, 0.f, 0.f};
    bf16x8 At[4][2], B0[2][2], B1[2][2];
    const char* cA = (const char*)g.A + (size_t)cur.pm * tstep; const char* cB = (const char*)g.Bt + (size_t)btile(g, cur) * tstep;
    S.a_ready(cur);
    if constexpr (SP2) {
        PG8_STAGE(PG8_SB(0, 0), cB, voffB); PG8_STAGE(PG8_SB(0, 1), cB + hstep, voffB); PG8_STAGE(PG8_SA(0, 0), cA, voffA); PG8_STAGE(PG8_SA(0, 1), cA + hstep, voffA);
        if (wr == 1) PG8_BAR;
        PG8_WAIT_V(2); PG8_BAR;
        PG8_STAGE(PG8_SB(1, 0), cB + kstep, voffB); PG8_STAGE(PG8_SA(1, 0), cA + kstep, voffA); PG8_STAGE(PG8_SB(1, 1), cB + hstep + kstep, voffB);
        PG8_WAIT_V(6); PG8_BAR;
    } else {
        PG8_STAGE(PG8_SB(0, 0), cB, voffB); PG8_STAGE(PG8_SA(0, 0), cA, voffA); PG8_STAGE(PG8_SB(0, 1), cB + hstep, voffB); PG8_STAGE(PG8_SA(0, 1), cA + hstep, voffA);
        if (wr == 1) PG8_BAR;
        PG8_WAIT_V(4); PG8_BAR;
        PG8_STAGE(PG8_SB(1, 0), cB + kstep, voffB); PG8_STAGE(PG8_SA(1, 0), cA + kstep, voffA); PG8_STAGE(PG8_SB(1, 1), cB + hstep + kstep, voffB);
        PG8_WAIT_V(6); PG8_BAR;
    }
    for (;;) {
        const bool has_next = S.next(ui + 1, nxt);
        const char* nA = has_next ? (const char*)g.A + (size_t)nxt.pm * tstep : cA; const char* nB = has_next ? (const char*)g.Bt + (size_t)btile(g, nxt) * tstep : cB;
        for (int t = 0; t < nt; t += 2) {
            const bool last = (t == nt - 2);
            const char* a1 = cA + (size_t)(t + 1) * kstep;
            const char* a2 = last ? nA : cA + (size_t)(t + 2) * kstep; const char* b2 = last ? nB : cB + (size_t)(t + 2) * kstep;
            const char* a3 = a2 + kstep; const char* b3 = b2 + kstep;
            if (last && has_next) S.a_ready(nxt);
            if constexpr (SP2) {
            PG8_LDB(B0, 0, 0); PG8_LDB(B1, 0, 1); PG8_SCHED; PG8_LDA(At, 0, 0); PG8_STAGE(PG8_SA(1, 1), a1 + hstep, voffA);
            PG8_WAIT_V(8); PG8_WAIT_L(0); PG8_BAR; PG8_MMA(0, 0, At, B0); PG8_MMA(0, 1, At, B1); PG8_BAR; PG8_SCHED;
            PG8_LDA(At, 0, 1); PG8_STAGE(PG8_SB(0, 0), b2, voffB); PG8_STAGE(PG8_SB(0, 1), b2 + hstep, voffB); PG8_STAGE(PG8_SA(0, 0), a2, voffA);
            PG8_WAIT_V(8); PG8_WAIT_L(0); PG8_BAR; PG8_MMA(1, 0, At, B0); PG8_MMA(1, 1, At, B1); PG8_BAR; PG8_SCHED;
            PG8_LDB(B0, 1, 0); PG8_LDB(B1, 1, 1); PG8_SCHED; PG8_LDA(At, 1, 0); PG8_STAGE(PG8_SA(0, 1), a2 + hstep, voffA);
            PG8_WAIT_V(8); PG8_WAIT_L(0); PG8_BAR; PG8_MMA(0, 0, At, B0); PG8_MMA(0, 1, At, B1); PG8_BAR; PG8_SCHED;
            PG8_LDA(At, 1, 1); PG8_STAGE(PG8_SB(1, 0), b3, voffB); PG8_STAGE(PG8_SB(1, 1), b3 + hstep, voffB); PG8_STAGE(PG8_SA(1, 0), a3, voffA);
            PG8_WAIT_V(8); PG8_WAIT_L(0); PG8_BAR; PG8_MMA(1, 0, At, B0); PG8_MMA(1, 1, At, B1); PG8_BAR; PG8_SCHED;
            } else {
            PG8_LDB(B0, 0, 0); PG8_SCHED; PG8_LDA(At, 0, 0); PG8_STAGE(PG8_SA(1, 1), a1 + hstep, voffA);
            PG8_WAIT_L(8); PG8_BAR; PG8_WAIT_L(0); PG8_MMA(0, 0, At, B0); PG8_BAR; PG8_SCHED;
            PG8_LDB(B1, 0, 1); PG8_STAGE(PG8_SB(0, 0), b2, voffB);
            PG8_BAR; PG8_WAIT_L(0); PG8_MMA(0, 1, At, B1); PG8_BAR;
            PG8_LDA(At, 0, 1); PG8_STAGE(PG8_SA(0, 0), a2, voffA);
            PG8_BAR; PG8_WAIT_L(0); PG8_MMA(1, 0, At, B0); PG8_BAR; PG8_SCHED;
            PG8_STAGE(PG8_SB(0, 1), b2 + hstep, voffB);
            PG8_WAIT_V(6); PG8_BAR; PG8_MMA(1, 1, At, B1); PG8_BAR;
            PG8_LDB(B0, 1, 0); PG8_SCHED; PG8_LDA(At, 1, 0); PG8_STAGE(PG8_SA(0, 1), a2 + hstep, voffA);
            PG8_WAIT_L(8); PG8_BAR; PG8_WAIT_L(0); PG8_MMA(0, 0, At, B0); PG8_BAR; PG8_SCHED;
            PG8_LDB(B1, 1, 1); PG8_STAGE(PG8_SB(1, 0), b3, voffB);
            PG8_BAR; PG8_WAIT_L(0); PG8_MMA(0, 1, At, B1); PG8_BAR;
            PG8_LDA(At, 1, 1); PG8_STAGE(PG8_SA(1, 0), a3, voffA);
            PG8_BAR; PG8_WAIT_L(0); PG8_MMA(1, 0, At, B0); PG8_BAR; PG8_SCHED;
            PG8_STAGE(PG8_SB(1, 1), b3 + hstep, voffB);
            PG8_WAIT_V(6); PG8_BAR; PG8_MMA(1, 1, At, B1); PG8_BAR;
            }
        }
        if constexpr (ALIGN_EPI) { if (wr == 0) PG8_BAR; }
        if constexpr (!Epi::AFTER_DRAIN) { E(acc, cur, wr, wc, fr, fq); S.done(cur); }
        if (!has_next) break;
#pragma unroll
        for (int a = 0; a < 2; ++a)
#pragma unroll
            for (int b = 0; b < 2; ++b)
#pragma unroll
                for (int m = 0; m < 4; ++m)
#pragma unroll
                    for (int n = 0; n < 2; ++n) acc[a][b][m][n] = (f32x4){0.f, 0.f, 0.f, 0.f};
        cur = nxt; cA = nA; cB = nB; ++ui;
        if constexpr (ALIGN_EPI) { if (wr == 1) PG8_BAR; }
    }
    PG8_WAIT_V(0);
    if constexpr (!ALIGN_EPI) { if (wr == 0) PG8_BAR; }
    PG8_BAR;
    if constexpr (Epi::AFTER_DRAIN) { E.fused(acc, cur, wr, wc, fr, fq, lds, wid, lane); S.done(cur); }
#undef PG8_SA
#undef PG8_SB
#undef PG8_STAGE
#undef PG8_LDA
#undef PG8_LDB
#undef PG8_MMA
#undef PG8_WAIT_V
#undef PG8_WAIT_L
#undef PG8_BAR
#undef PG8_SCHED
}
}

#ifndef MK_MULTI
#define MK_MULTI 0
#endif
#ifndef REPEAT_MASK
#define REPEAT_MASK 0
#endif
#ifndef EXTRA_SYNCS
#define EXTRA_SYNCS 0
#endif
constexpr int NWAVES = 8;
constexpr int BATCH = 2, SEQ = 8192, D = 2048, CW = 1024, PW = 1024, NPROJ = 4096, FF = 5632;
constexpr int M = BATCH * SEQ;
constexpr float EPS = 1e-6f;
constexpr int NPHASE = 9;

constexpr size_t MiB = 1u << 20;
constexpr size_t WS_CTL = 0, CTL_ZERO_BYTES = 16384;
constexpr size_t WS_PART1 = 1 * MiB, WS_PART2 = 3 * MiB;
constexpr size_t WS_WD = 5 * MiB;
constexpr size_t WS_WIN = 27 * MiB;
constexpr size_t WS_WOUT = 43 * MiB;
constexpr size_t WS_WGU = 51 * MiB;
constexpr size_t WS_WPOOL = 95 * MiB;
constexpr size_t WS_H = 96 * MiB;
constexpr size_t WS_FF = 27 * MiB;
constexpr size_t WS_PROJ = 160 * MiB;
constexpr size_t WS_POOLED = 288 * MiB;
constexpr size_t WS_MIXED = 320 * MiB;
constexpr size_t WS_MIXOUT = 384 * MiB;
constexpr size_t WS_ACT = 160 * MiB;
constexpr size_t WS_END = 448 * MiB;
static_assert(WS_FF + (size_t)M * D * 2 <= WS_WPOOL && WS_ACT + (size_t)M * FF * 2 <= WS_MIXOUT && WS_MIXOUT + (size_t)M * D * 2 <= WS_END && WS_WD + (size_t)D * FF * 2 <= WS_FF, "d_ws map");

constexpr int RING_BYTES = 131072, EPI_SCR_OFF = RING_BYTES, MISC_OFF = RING_BYTES + 4096, LDS_BYTES = 147456;

#define GAS __attribute__((address_space(1)))
#define LAS __attribute__((address_space(3)))
typedef unsigned short bf16;
typedef unsigned v4u __attribute__((ext_vector_type(4)));
typedef unsigned v2u __attribute__((ext_vector_type(2)));
typedef float f32x4 __attribute__((ext_vector_type(4)));
#define LDS_WAIT() asm volatile("s_waitcnt lgkmcnt(0)" ::: "memory")
__device__ __forceinline__ unsigned f2bf(float f) { unsigned u = __builtin_bit_cast(unsigned, f); return (u + 0x7fffu + ((u >> 16) & 1u)) >> 16; }
__device__ __forceinline__ unsigned pk2(float lo, float hi) { return f2bf(lo) | (f2bf(hi) << 16); }
__device__ __forceinline__ float bflo(unsigned w) { return __builtin_bit_cast(float, w << 16); }
__device__ __forceinline__ float bfhi(unsigned w) { return __builtin_bit_cast(float, w & 0xffff0000u); }
__device__ __forceinline__ float wave_sum(float v) {
#pragma unroll
    for (int o = 1; o < 64; o <<= 1) v += __shfl_xor(v, o);
    return v;
}

typedef GAS unsigned gu32;
#define RLX_AGENT __ATOMIC_RELAXED, __HIP_MEMORY_SCOPE_AGENT
#define XB_TMO      128
#define XB_XCNT(j)  (256  + 64 * (j))
#define XB_XSUB(j)  (1280 + 64 * (j))
#define XB_XGEN(j)  (2304 + 64 * (j))
#define XB_TOP      3328
#define XB_TOPGEN   3392
#define XCD_BAR_WORDS 3456
#define XB_SPIN_CAP (1u << 18)

__device__ __forceinline__ unsigned xb_ld(unsigned* p)              { return __hip_atomic_load(p, __ATOMIC_RELAXED, __HIP_MEMORY_SCOPE_AGENT); }
__device__ __forceinline__ unsigned xb_add(unsigned* p, unsigned v) { return __hip_atomic_fetch_add(p, v, __ATOMIC_RELAXED, __HIP_MEMORY_SCOPE_AGENT); }
__device__ __forceinline__ unsigned xb_xcc_id() { return (unsigned)__builtin_amdgcn_s_getreg((3 << 11) | 20) & 0xFu; }
#define XB_SPIN(cond, bar) do { unsigned _sp = 0; while (cond) { __builtin_amdgcn_s_sleep(1); \
    if ((++_sp & 255u) == 0u) { if (xb_ld(&(bar)[XB_TMO])) break; if (_sp > XB_SPIN_CAP) { atomicAdd(&(bar)[XB_TMO], 1u); break; } } } } while (0)

struct XcdBarrier {
    unsigned* bar; unsigned x;
    volatile LAS unsigned* st;
};

__device__ __forceinline__ XcdBarrier xcd_barrier_post(unsigned* bar, volatile LAS unsigned* st) {
    XcdBarrier b; b.bar = bar; b.x = xb_xcc_id(); b.st = st;
    if (threadIdx.x == 0) (void)xb_add(&bar[XB_XCNT(b.x)], 1u);
    return b;
}
__device__ __forceinline__ void xcd_barrier_complete(unsigned* bar, unsigned x, unsigned& nloc, unsigned& nx) {
    const unsigned G = gridDim.x * gridDim.y * gridDim.z;
    unsigned sum, cnt, mine, sp = 0u;
    for (;;) {
        sum = 0u; cnt = 0u; mine = 0u;
#pragma unroll
        for (unsigned j = 0; j < 16; ++j) { const unsigned c = xb_ld(&bar[XB_XCNT(j)]); sum += c; cnt += (c > 0u) ? 1u : 0u; mine = (j == x) ? c : mine; }
        if (sum == G) break;
        __builtin_amdgcn_s_sleep(1);
        if ((++sp & 255u) == 0u) { if (xb_ld(&bar[XB_TMO])) break; if (sp > XB_SPIN_CAP) { atomicAdd(&bar[XB_TMO], 1u); break; } }
    }
    nloc = mine > 0u ? mine : 1u; nx = cnt > 0u ? cnt : 1u;
}

__device__ __forceinline__ void xcd_barrier(const XcdBarrier& b) {
    asm volatile("s_waitcnt vmcnt(0)" ::: "memory");
    __syncthreads();
    if (threadIdx.x == 0) {
        unsigned* bar = b.bar;
        __builtin_amdgcn_s_waitcnt(0);
        unsigned nloc = b.st[0], nx = b.st[1];
        if (nloc == 0u) { xcd_barrier_complete(bar, b.x, nloc, nx); b.st[0] = nloc; b.st[1] = nx; }
        const unsigned old = xb_add(&bar[XB_XSUB(b.x)], 1u);
        const unsigned gen = old / nloc;
        if (old + 1u == (gen + 1u) * nloc) {
            __builtin_amdgcn_fence(__ATOMIC_RELEASE, "agent");
            asm volatile("s_waitcnt vmcnt(0)" ::: "memory");
            const unsigned og = xb_add(&bar[XB_TOP], 1u);
            const unsigned tg = og / nx;
            if (og + 1u == (tg + 1u) * nx) xb_add(&bar[XB_TOPGEN], 1u);
            else XB_SPIN(xb_ld(&bar[XB_TOPGEN]) == tg, bar);
            __builtin_amdgcn_fence(__ATOMIC_ACQUIRE, "agent");
            xb_add(&bar[XB_XGEN(b.x)], 1u);
            asm volatile("s_waitcnt vmcnt(0)" ::: "memory");
        } else {
            XB_SPIN(xb_ld(&bar[XB_XGEN(b.x)]) == gen, bar);
            __builtin_amdgcn_fence(__ATOMIC_ACQUIRE, "agent");
            asm volatile("s_waitcnt vmcnt(0)" ::: "memory");
        }
    }
    __syncthreads();
}

struct Frame {
    LAS unsigned char* lds;
    int tid, lane, wave, vcu, G;
    const float *x, *g_pre, *w_in, *conv_w, *pool_w, *pool_scale, *w_out, *g_post, *g_fpre, *w_gate, *w_up, *w_down, *g_fpost;
    float* out; unsigned char* ws;
};

template <int MODE>
__device__ __forceinline__ void p0_transpose_item(const float* W, int K, int N, bf16* WT, LAS float* scr, int item, int lane) {
    const int nblk = N / 32, kb = item / nblk, nb = item % nblk, k0 = 64 * kb, n0 = 32 * nb;
    const int drow0 = MODE == 0 ? n0 : ((n0 >> 7) * 256 + (n0 & 127) + (MODE == 2 ? 128 : 0));
#pragma unroll 8
    for (int i = 0; i < 32; ++i) { const int kk = 2 * i + (lane >> 5); scr[kk * 33 + (lane & 31)] = W[(size_t)(k0 + kk) * N + n0 + (lane & 31)]; }
    LDS_WAIT(); asm volatile("" ::: "memory");
    const int c = lane & 7;
#pragma unroll
    for (int j = 0; j < 4; ++j) { const int n = (lane >> 3) + 8 * j; const LAS float* s = scr + (8 * c) * 33 + n;
        v4u o; o.x = pk2(s[0 * 33], s[1 * 33]); o.y = pk2(s[2 * 33], s[3 * 33]); o.z = pk2(s[4 * 33], s[5 * 33]); o.w = pk2(s[6 * 33], s[7 * 33]);
        *(GAS v4u*)(WT + (size_t)(drow0 + n) * K + k0 + 8 * c) = o; }
    LDS_WAIT(); asm volatile("" ::: "memory");
}

__device__ __forceinline__ void p0_prologue(Frame& F) {
    LAS float* scr = (LAS float*)(F.lds + F.wave * 16384);
    const int gw = F.vcu * NWAVES + F.wave, NGW = F.G * NWAVES;
    unsigned char* ws = F.ws;
    constexpr int I_IN = (D / 64) * (NPROJ / 32), I_OUT = (D / 64) * (D / 32), I_G = (D / 64) * (FF / 32), I_D = (FF / 64) * (D / 32), I_P1 = (256 / 64) * (256 / 32), I_P = 4 * I_P1;
    constexpr int NITEMS = I_IN + I_OUT + 2 * I_G + I_D + I_P;
    for (int it = gw; it < NITEMS; it += NGW) {
        int r = it;
        if (r < I_IN) { p0_transpose_item<0>(F.w_in, D, NPROJ, (bf16*)(ws + WS_WIN), scr, r, F.lane); continue; } r -= I_IN;
        if (r < I_OUT) { p0_transpose_item<0>(F.w_out, D, D, (bf16*)(ws + WS_WOUT), scr, r, F.lane); continue; } r -= I_OUT;
        if (r < I_G) { p0_transpose_item<1>(F.w_gate, D, FF, (bf16*)(ws + WS_WGU), scr, r, F.lane); continue; } r -= I_G;
        if (r < I_G) { p0_transpose_item<2>(F.w_up, D, FF, (bf16*)(ws + WS_WGU), scr, r, F.lane); continue; } r -= I_G;
        if (r < I_D) { p0_transpose_item<0>(F.w_down, FF, D, (bf16*)(ws + WS_WD), scr, r, F.lane); continue; } r -= I_D;
        { const int g = r / I_P1; p0_transpose_item<0>(F.pool_w + (size_t)g * 65536, 256, 256, (bf16*)(ws + WS_WPOOL) + (size_t)g * 65536, scr, r % I_P1, F.lane); }
    }
    f32x4 gv[8];
#pragma unroll
    for (int j = 0; j < 8; ++j) gv[j] = ((const GAS f32x4*)F.g_pre)[F.lane + 64 * j];
    bf16* H = (bf16*)(ws + WS_H);
    for (int m = gw; m < M; m += NGW) {
        const GAS f32x4* xr = (const GAS f32x4*)(F.x + (size_t)m * D) + F.lane;
        f32x4 v[8]; float s = 0.f;
#pragma unroll
        for (int j = 0; j < 8; ++j) { v[j] = xr[64 * j]; s += (v[j].x * v[j].x + v[j].y * v[j].y) + (v[j].z * v[j].z + v[j].w * v[j].w); }
        const float rstd = 1.0f / sqrtf(wave_sum(s) * (1.0f / D) + EPS);
        GAS v2u* o8 = (GAS v2u*)(H + (size_t)m * D) + F.lane;
#pragma unroll
        for (int j = 0; j < 8; ++j) { const f32x4 y = v[j] * rstd * gv[j]; v2u w; w.x = pk2(y.x, y.y); w.y = pk2(y.z, y.w); o8[64 * j] = w; }
    }
}

__device__ __forceinline__ void unpack16(const bf16* p, float (&f)[16]) {
    const v4u a = *(const GAS v4u*)p, b = *((const GAS v4u*)p + 1);
    f[0] = bflo(a.x); f[1] = bfhi(a.x); f[2] = bflo(a.y); f[3] = bfhi(a.y); f[4] = bflo(a.z); f[5] = bfhi(a.z); f[6] = bflo(a.w); f[7] = bfhi(a.w);
    f[8] = bflo(b.x); f[9] = bfhi(b.x); f[10] = bflo(b.y); f[11] = bfhi(b.y); f[12] = bflo(b.z); f[13] = bfhi(b.z); f[14] = bflo(b.w); f[15] = bfhi(b.w);
}
__device__ __forceinline__ void pack16_store(bf16* p, const float (&f)[16]) {
    v4u a, b; a.x = pk2(f[0], f[1]); a.y = pk2(f[2], f[3]); a.z = pk2(f[4], f[5]); a.w = pk2(f[6], f[7]);
    b.x = pk2(f[8], f[9]); b.y = pk2(f[10], f[11]); b.z = pk2(f[12], f[13]); b.w = pk2(f[14], f[15]);
    *(GAS v4u*)p = a; *((GAS v4u*)p + 1) = b;
}
__device__ __forceinline__ void p2_mixer(Frame& F) {
    const int gw = F.vcu * NWAVES + F.wave, NGW = F.G * NWAVES, l = F.lane;
    const bf16* P = (const bf16*)(F.ws + WS_PROJ);
    bf16* MIX = (bf16*)(F.ws + WS_MIXED); bf16* PO = (bf16*)(F.ws + WS_POOLED);
    float w0[16], w1[16], w2[16];
#pragma unroll
    for (int i = 0; i < 16; ++i) { w0[i] = F.conv_w[0 * CW + 16 * l + i]; w1[i] = F.conv_w[1 * CW + 16 * l + i]; w2[i] = F.conv_w[2 * CW + 16 * l + i]; }
    const int wlen = 2 << (l >> 4);
    for (int chunk = gw; chunk < M / 8; chunk += NGW) {
        const int m0 = chunk * 8, t0 = m0 % SEQ;
        {
            float cu1[16], cu2[16];
#pragma unroll
            for (int i = 0; i < 16; ++i) { cu1[i] = 0.f; cu2[i] = 0.f; }
            if (t0 > 0) {
                float c[16], u[16];
                unpack16(P + (size_t)(m0 - 1) * NPROJ + CW + 16 * l, c); unpack16(P + (size_t)(m0 - 1) * NPROJ + 2 * CW + 16 * l, u);
#pragma unroll
                for (int i = 0; i < 16; ++i) cu1[i] = c[i] * u[i];
                unpack16(P + (size_t)(m0 - 2) * NPROJ + CW + 16 * l, c); unpack16(P + (size_t)(m0 - 2) * NPROJ + 2 * CW + 16 * l, u);
#pragma unroll
                for (int i = 0; i < 16; ++i) cu2[i] = c[i] * u[i];
            }
#pragma unroll 1
            for (int r = 0; r < 8; ++r) {
                const bf16* row = P + (size_t)(m0 + r) * NPROJ + 16 * l;
                float b[16], c[16], u[16], y[16];
                unpack16(row, b); unpack16(row + CW, c); unpack16(row + 2 * CW, u);
                float ss = 0.f;
#pragma unroll
                for (int i = 0; i < 16; ++i) { const float cu0 = c[i] * u[i]; y[i] = b[i] * (w0[i] * cu2[i] + w1[i] * cu1[i] + w2[i] * cu0); ss += y[i] * y[i]; cu2[i] = cu1[i]; cu1[i] = cu0; }
                ss += __shfl_xor(ss, 1); ss += __shfl_xor(ss, 2); ss += __shfl_xor(ss, 4);
                const float rstd = 1.0f / sqrtf(ss * (1.0f / 128.0f) + EPS);
#pragma unroll
                for (int i = 0; i < 16; ++i) y[i] *= rstd;
                pack16_store(MIX + (size_t)(m0 + r) * D + 16 * l, y);
            }
        }
        {
            const bf16* vcol = P + 3 * CW + 16 * l;
            float S[16];
#pragma unroll
            for (int i = 0; i < 16; ++i) S[i] = 0.f;
#pragma unroll 1
            for (int j = 1; j < 16; ++j) if (j < wlen && t0 - j >= 0) { float v[16]; unpack16(vcol + (size_t)(m0 - j) * NPROJ, v);
#pragma unroll
                for (int i = 0; i < 16; ++i) S[i] += v[i]; }
            bf16* orow = PO + ((size_t)(l >> 4) * M + m0) * 256 + 16 * (l & 15);
#pragma unroll 1
            for (int r = 0; r < 8; ++r) {
                const int t = t0 + r; float v[16], o[16]; unpack16(vcol + (size_t)(m0 + r) * NPROJ, v);
                const int cnt = (t + 1) < wlen ? (t + 1) : wlen; const float inv = 1.0f / (float)cnt;
#pragma unroll
                for (int i = 0; i < 16; ++i) { S[i] += v[i]; o[i] = S[i] * inv - v[i]; }
                pack16_store(orow + (size_t)r * 256, o);
                if (t - wlen + 1 >= 0) { float q[16]; unpack16(vcol + (size_t)(m0 + r - wlen + 1) * NPROJ, q);
#pragma unroll
                    for (int i = 0; i < 16; ++i) S[i] -= q[i]; }
            }
        }
    }
}

__device__ __forceinline__ void ld8(const float* p, f32x4& a, f32x4& b) { a = *(const GAS f32x4*)p; b = *((const GAS f32x4*)p + 1); }
__device__ __forceinline__ void bf8(const bf16* p, f32x4& a, f32x4& b) { const v4u w = *(const GAS v4u*)p; a = (f32x4){bflo(w.x), bfhi(w.x), bflo(w.y), bfhi(w.y)}; b = (f32x4){bflo(w.z), bfhi(w.z), bflo(w.w), bfhi(w.w)}; }
__device__ __forceinline__ float sq4(const f32x4 v) { return (v.x * v.x + v.y * v.y) + (v.z * v.z + v.w * v.w); }
__device__ __forceinline__ void p5_resnorm(Frame& F) {
    const int gw = F.vcu * NWAVES + F.wave, NGW = F.G * NWAVES, l = F.lane;
    const bf16* MO = (const bf16*)(F.ws + WS_MIXOUT); const float* part = (const float*)(F.ws + WS_PART1); bf16* H = (bf16*)(F.ws + WS_H);
    f32x4 g1[4][2], g2[4][2];
#pragma unroll
    for (int j = 0; j < 4; ++j) { ld8(F.g_post + 8 * l + 512 * j, g1[j][0], g1[j][1]); ld8(F.g_fpre + 8 * l + 512 * j, g2[j][0], g2[j][1]); }
    for (int m = gw; m < M; m += NGW) {
        const float p = l < 32 ? part[(size_t)m * 32 + l] : 0.f;
        const float rstd1 = 1.0f / sqrtf(wave_sum(p) * (1.0f / D) + EPS);
        const float* xr = F.x + (size_t)m * D + 8 * l; const bf16* mr = MO + (size_t)m * D + 8 * l;
        f32x4 v[4][2]; float s = 0.f;
#pragma unroll
        for (int j = 0; j < 4; ++j) { f32x4 x0, x1, m0, m1; ld8(xr + 512 * j, x0, x1); bf8(mr + 512 * j, m0, m1);
            v[j][0] = x0 + m0 * rstd1 * g1[j][0]; v[j][1] = x1 + m1 * rstd1 * g1[j][1]; s += sq4(v[j][0]) + sq4(v[j][1]); }
        const float rstd2 = 1.0f / sqrtf(wave_sum(s) * (1.0f / D) + EPS);
        bf16* hr = H + (size_t)m * D + 8 * l;
#pragma unroll
        for (int j = 0; j < 4; ++j) { const f32x4 y0 = v[j][0] * rstd2 * g2[j][0], y1 = v[j][1] * rstd2 * g2[j][1];
            v4u w; w.x = pk2(y0.x, y0.y); w.y = pk2(y0.z, y0.w); w.z = pk2(y1.x, y1.y); w.w = pk2(y1.z, y1.w); *(GAS v4u*)(hr + 512 * j) = w; }
    }
}
__device__ __forceinline__ void p8_final(Frame& F) {
    const int gw = F.vcu * NWAVES + F.wave, NGW = F.G * NWAVES, l = F.lane;
    const bf16* MO = (const bf16*)(F.ws + WS_MIXOUT); const bf16* FFO = (const bf16*)(F.ws + WS_FF);
    const float* part1 = (const float*)(F.ws + WS_PART1); const float* part2 = (const float*)(F.ws + WS_PART2);
    f32x4 g1[4][2], g3[4][2];
#pragma unroll
    for (int j = 0; j < 4; ++j) { ld8(F.g_post + 8 * l + 512 * j, g1[j][0], g1[j][1]); ld8(F.g_fpost + 8 * l + 512 * j, g3[j][0], g3[j][1]); }
    for (int m = gw; m < M; m += NGW) {
        const float p1 = l < 32 ? part1[(size_t)m * 32 + l] : 0.f, p2 = l < 32 ? part2[(size_t)m * 32 + l] : 0.f;
        const float rstd1 = 1.0f / sqrtf(wave_sum(p1) * (1.0f / D) + EPS), rstd2 = 1.0f / sqrtf(wave_sum(p2) * (1.0f / D) + EPS);
        const float* xr = F.x + (size_t)m * D + 8 * l; const bf16* mr = MO + (size_t)m * D + 8 * l; const bf16* fr = FFO + (size_t)m * D + 8 * l;
        float* orow = F.out + (size_t)m * D + 8 * l;
#pragma unroll
        for (int j = 0; j < 4; ++j) { f32x4 x0, x1, m0, m1, f0, f1; ld8(xr + 512 * j, x0, x1); bf8(mr + 512 * j, m0, m1); bf8(fr + 512 * j, f0, f1);
            *(GAS f32x4*)(orow + 512 * j) = x0 + m0 * rstd1 * g1[j][0] + f0 * rstd2 * g3[j][0]; *((GAS f32x4*)(orow + 512 * j) + 1) = x1 + m1 * rstd1 * g1[j][1] + f1 * rstd2 * g3[j][1]; }
    }
}

__device__ __forceinline__ int opaque_int(int v) { asm volatile("" : "+s"(v)); return v; }
struct Args { const float* in[13]; float* out; unsigned char* ws; int ph_lo, ph_hi; };
__global__ void __launch_bounds__(NWAVES * 64, 2) mk_fwd(Args args) {
    extern __shared__ __attribute__((aligned(16))) unsigned char lds[];
    Frame F;
    F.lds = (LAS unsigned char*)lds;
    F.tid = threadIdx.x; F.lane = F.tid & 63; F.wave = __builtin_amdgcn_readfirstlane(F.tid >> 6);
    F.G = gridDim.x; { const int bx = blockIdx.x; F.vcu = (F.G % 8 == 0) ? (bx % 8) * (F.G / 8) + bx / 8 : bx; }
    F.x = args.in[0]; F.g_pre = args.in[1]; F.w_in = args.in[2]; F.conv_w = args.in[3]; F.pool_w = args.in[4]; F.pool_scale = args.in[5]; F.w_out = args.in[6];
    F.g_post = args.in[7]; F.g_fpre = args.in[8]; F.w_gate = args.in[9]; F.w_up = args.in[10]; F.w_down = args.in[11]; F.g_fpost = args.in[12];
    F.out = args.out; F.ws = args.ws;
    unsigned char* ws = args.ws;
    const int lo = args.ph_lo, hi = args.ph_hi;
#ifdef ONLY_PHASE
#define IN(k) ((k) == ONLY_PHASE && lo <= (k) && (k) < hi)
#else
#define IN(k) (lo <= (k) && (k) < hi)
#endif
#if MK_MULTI
#define SEAM(k) do { } while (0)
#else
    volatile LAS unsigned* MISC = (volatile LAS unsigned*)(F.lds + MISC_OFF);
    if (F.tid < 64) MISC[F.tid] = 0u;
    __syncthreads();
    const XcdBarrier bar = xcd_barrier_post((unsigned*)(ws + WS_CTL), MISC + 8);
#define GRID_SYNC() xcd_barrier(bar)
#define SEAM(k) do { if (IN(k) && IN((k) + 1)) GRID_SYNC(); } while (0)
#endif
#if MK_MULTI
#define REP(k) for (int rep_ = 0; rep_ < 1; ++rep_)
#else
#define REP(k) for (int rep_ = 0, nrep_ = (((REPEAT_MASK >> (k)) & 1) ? opaque_int(2) : 1); rep_ < nrep_; ++rep_, (rep_ < nrep_ ? GRID_SYNC() : (void)0))
#endif
    typedef pg8::bf16_t bt;
    if (IN(0)) REP(0) p0_prologue(F);
#if !MK_MULTI
    for (int e_ = 0; e_ < EXTRA_SYNCS; ++e_) GRID_SYNC();
#endif
    SEAM(0);
    if (IN(1)) REP(1) {
        pg8::Gemm g{(const bt*)(ws + WS_H), (const bt*)(ws + WS_WIN), M, NPROJ, D, 0}; pg8::StaticOrder S; S.init(M, NPROJ, F.G, (int)blockIdx.x);
        pg8::EpiBf16 E{(bt*)(ws + WS_PROJ), NPROJ};
        pg8::gemm_phase<pg8::EpiBf16, pg8::StaticOrder, true, true>(F.lds, g, S, E);
    }
    SEAM(1);
    if (IN(2)) REP(2) p2_mixer(F);
    SEAM(2);
    if (IN(3)) REP(3) {
        int kpool = 256; asm volatile("" : "+s"(kpool));
        pg8::Gemm g{(const bt*)(ws + WS_POOLED), (const bt*)(ws + WS_WPOOL), 4 * M, 256, kpool, 64}; pg8::StaticOrder S; S.init(4 * M, 256, F.G, (int)blockIdx.x);
        pg8::EpiPool E{(bt*)(ws + WS_MIXED), D, F.pool_scale, (LAS float*)(F.lds + EPI_SCR_OFF), EPS};
        pg8::gemm_phase<pg8::EpiPool, pg8::StaticOrder, true, true>(F.lds, g, S, E);
    }
    SEAM(3);
    if (IN(4)) REP(4) {
        pg8::Gemm g{(const bt*)(ws + WS_MIXED), (const bt*)(ws + WS_WOUT), M, D, D, 0}; pg8::StaticOrder S; S.init(M, D, F.G, (int)blockIdx.x);
        pg8::EpiBf16Stat E{(bt*)(ws + WS_MIXOUT), D, (float*)(ws + WS_PART1)};
        pg8::gemm_phase<pg8::EpiBf16Stat, pg8::StaticOrder, true, true>(F.lds, g, S, E);
    }
    SEAM(4);
    if (IN(5)) REP(5) p5_resnorm(F);
    SEAM(5);
    if (IN(6)) REP(6) {
        pg8::Gemm g{(const bt*)(ws + WS_H), (const bt*)(ws + WS_WGU), M, 2 * FF, D, 0}; pg8::StaticOrder S; S.init(M, 2 * FF, F.G, (int)blockIdx.x);
        pg8::EpiSwiGLU E{(bt*)(ws + WS_ACT), FF};
        pg8::gemm_phase<pg8::EpiSwiGLU, pg8::StaticOrder, true, true>(F.lds, g, S, E);
    }
    SEAM(6);
    if (IN(7)) REP(7) {
        pg8::Gemm g{(const bt*)(ws + WS_ACT), (const bt*)(ws + WS_WD), M, D, FF, 0}; pg8::StaticOrder S; S.init(M, D, F.G, (int)blockIdx.x);
        pg8::EpiBf16Stat E{(bt*)(ws + WS_FF), D, (float*)(ws + WS_PART2)};
        pg8::gemm_phase<pg8::EpiBf16Stat, pg8::StaticOrder, true, true>(F.lds, g, S, E);
    }
    SEAM(7);
    if (IN(8)) p8_final(F);
#undef IN
#undef SEAM
#undef REP
}

extern "C" void kernel_launch(void* const* d_in, const int* in_sizes, int n_in, void* d_out, int out_size, void* d_ws, size_t ws_size, hipStream_t stream) {
    static int grid = 0;
    if (grid == 0) {
        if (n_in != 13 || in_sizes[0] != M * D || out_size != M * D || ws_size < WS_END) { fprintf(stderr, "kernel_launch: shape/workspace mismatch (n_in %d, in0 %d, out %d, ws %zu, need %zu); nothing launched\n", n_in, n_in > 0 ? in_sizes[0] : -1, out_size, ws_size, (size_t)WS_END); grid = -1; return; }
        int dev = 0, cus = 0, per_cu = 0;
        if (hipGetDevice(&dev) != hipSuccess || hipDeviceGetAttribute(&cus, hipDeviceAttributeMultiprocessorCount, dev) != hipSuccess) { fprintf(stderr, "kernel_launch: device query failed\n"); grid = -1; return; }
        if (hipFuncSetAttribute((const void*)mk_fwd, hipFuncAttributeMaxDynamicSharedMemorySize, LDS_BYTES) != hipSuccess) { fprintf(stderr, "kernel_launch: hipFuncSetAttribute failed\n"); grid = -1; return; }
        if (hipOccupancyMaxActiveBlocksPerMultiprocessor(&per_cu, (const void*)mk_fwd, NWAVES * 64, LDS_BYTES) != hipSuccess || per_cu < 1) { fprintf(stderr, "kernel_launch: occupancy query says %d blocks per CU\n", per_cu); per_cu = 1; }
        (void)hipGetLastError();
        grid = cus;
    }
    if (grid < 0) return;
    Args a{};
    for (int i = 0; i < 13; ++i) a.in[i] = (const float*)d_in[i];
    a.out = (float*)d_out; a.ws = (unsigned char*)d_ws;
#if MK_MULTI
    for (int p = 0; p < NPHASE; ++p) { a.ph_lo = p; a.ph_hi = p + 1; hipLaunchKernelGGL(mk_fwd, dim3(grid), dim3(NWAVES * 64), LDS_BYTES, stream, a); }
#else
    a.ph_lo = 0; a.ph_hi = NPHASE;
    if (hipMemsetAsync((char*)d_ws + WS_CTL, 0, CTL_ZERO_BYTES, stream) != hipSuccess) { fprintf(stderr, "kernel_launch: hipMemsetAsync failed\n"); return; }
    hipLaunchKernelGGL(mk_fwd, dim3(grid), dim3(NWAVES * 64), LDS_BYTES, stream, a);
    const hipError_t e = hipPeekAtLastError();
    if (e != hipSuccess) fprintf(stderr, "kernel_launch: launch failed: %s (grid %d)\n", hipGetErrorString(e), grid);
#endif
}
```

```cpp
#include <hip/hip_runtime.h>
#include <cstdio>
#include <cstdint>
namespace pg8 {
#define PG8_LAS __attribute__((address_space(3)))
typedef unsigned short bf16_t;
typedef short bf16x8 __attribute__((ext_vector_type(8)));
typedef float f32x4 __attribute__((ext_vector_type(4)));
typedef unsigned u32x4 __attribute__((ext_vector_type(4)));
constexpr int BM = 256, BK = 64, HALF = 128, HTB = HALF * BK * 2  , STAGE_BYTES = 8 * HTB, NXCD = 8, WGM = 8;

__host__ __device__ __forceinline__ int lds_byte(int r, int c) { const int st = (r >> 4) * 2 + (c >> 5), rr = r & 15, cc = c & 31, ob = rr * 64 + cc * 2; return st * 1024 + (ob ^ (((ob >> 9) & 1) << 5)); }
__host__ __device__ __forceinline__ void stage_rc(int b, int& R, int& C) { const int st = b / 1024, sb = b % 1024, swz = sb ^ (((sb >> 9) & 1) << 5); R = (st >> 1) * 16 + swz / 64; C = (st & 1) * 32 + (swz % 64) / 2; }
__host__ __device__ __forceinline__ int perm32(int rho) { const int n = rho >> 4, i = rho & 15; return 8 * (i >> 2) + 4 * n + (i & 3); }

struct Unit { int pm, pn; };
struct Gemm { const bf16_t* A; const bf16_t* Bt; int M, N, K; int bdiv; };
__device__ __forceinline__ int btile(const Gemm& g, const Unit& u) { return u.pn + (g.bdiv ? (u.pm / g.bdiv) * (g.N / BM) : 0); }

struct StaticOrder {
    int nM, nN, nwg, G, c, nxcd;
    __host__ __device__ void init(int M, int N, int G_, int c_, int nxcd_) { nM = M / BM; nN = N / BM; nwg = nM * nN; G = G_; c = c_; nxcd = nxcd_; }
    __host__ __device__ bool next(int i, Unit& u) const {
        const long L = (long)i * G + c; if (L >= nwg) return false;
        int wgid = (int)L; { const int q = nwg / nxcd, r = nwg % nxcd, xcd = wgid % nxcd, off = wgid / nxcd; wgid = (xcd < r ? xcd * (q + 1) : r * (q + 1) + (xcd - r) * q) + off; }
        const int nig = WGM * nN, gid = wgid / nig, fm = gid * WGM, gsz = (nM - fm) < WGM ? (nM - fm) : WGM;
        u.pm = fm + ((wgid % nig) % gsz); u.pn = (wgid % nig) / gsz; return true;
    }
    __device__ __forceinline__ void a_ready(const Unit&) const {}
    __device__ __forceinline__ void done(const Unit&) const {}
};

__device__ __forceinline__ unsigned cvt_pk_bf16(float lo, float hi) { unsigned r; asm volatile("v_cvt_pk_bf16_f32 %0, %1, %2" : "=v"(r) : "v"(lo), "v"(hi)); return r; }

struct EpiBf16 {
    static constexpr bool PERM = true, AFTER_DRAIN = false;
    bf16_t* O; int ldc;
    __device__ __forceinline__ void operator()(const f32x4 (&acc)[2][2][4][2], const Unit& u, int wr, int wc, int fr, int fq) const {
        const int row0 = u.pm * BM + wr * 64 + fr; const int col0 = u.pn * BM + wc * 32 + 8 * fq;
#pragma unroll
        for (int ai = 0; ai < 2; ++ai)
#pragma unroll
            for (int m = 0; m < 4; ++m) { bf16_t* rowp = O + (size_t)(row0 + ai * HALF + m * 16) * ldc + col0;
#pragma unroll
                for (int bj = 0; bj < 2; ++bj) { const f32x4 v0 = acc[ai][bj][m][0], v1 = acc[ai][bj][m][1];
                    u32x4 w; w.x = cvt_pk_bf16(v0[0], v0[1]); w.y = cvt_pk_bf16(v0[2], v0[3]); w.z = cvt_pk_bf16(v1[0], v1[1]); w.w = cvt_pk_bf16(v1[2], v1[3]);
                    *(u32x4*)(rowp + bj * HALF) = w; } }
    }
};

__device__ __forceinline__ float silu_mul(float g, float u) { const float e = __builtin_amdgcn_exp2f(g * -1.4426950408889634f); return g * __builtin_amdgcn_rcpf(1.0f + e) * u; }
struct EpiSwiGLU {
    static constexpr bool PERM = true, AFTER_DRAIN = false;
    bf16_t* O; int ldc;
    __device__ __forceinline__ void operator()(const f32x4 (&acc)[2][2][4][2], const Unit& u, int wr, int wc, int fr, int fq) const {
        const int row0 = u.pm * BM + wr * 64 + fr; const int col0 = u.pn * HALF + wc * 32 + 8 * fq;
#pragma unroll
        for (int ai = 0; ai < 2; ++ai)
#pragma unroll
            for (int m = 0; m < 4; ++m) { bf16_t* rowp = O + (size_t)(row0 + ai * HALF + m * 16) * ldc + col0;
                const f32x4 g0 = acc[ai][0][m][0], g1 = acc[ai][0][m][1], u0 = acc[ai][1][m][0], u1 = acc[ai][1][m][1];
                u32x4 w; w.x = cvt_pk_bf16(silu_mul(g0[0], u0[0]), silu_mul(g0[1], u0[1])); w.y = cvt_pk_bf16(silu_mul(g0[2], u0[2]), silu_mul(g0[3], u0[3]));
                w.z = cvt_pk_bf16(silu_mul(g1[0], u1[0]), silu_mul(g1[1], u1[1])); w.w = cvt_pk_bf16(silu_mul(g1[2], u1[2]), silu_mul(g1[3], u1[3]));
                *(u32x4*)rowp = w; }
    }
};

struct EpiBf16Stat {
    static constexpr bool PERM = true, AFTER_DRAIN = false;
    bf16_t* O; int ldc; float* part;
    __device__ __forceinline__ void operator()(const f32x4 (&acc)[2][2][4][2], const Unit& u, int wr, int wc, int fr, int fq) const {
        const int col0 = u.pn * BM + wc * 32 + 8 * fq;
#pragma unroll
        for (int ai = 0; ai < 2; ++ai)
#pragma unroll
            for (int m = 0; m < 4; ++m) { const int r = u.pm * BM + ai * HALF + wr * 64 + m * 16 + fr; bf16_t* rowp = O + (size_t)r * ldc + col0; float s = 0.f;
#pragma unroll
                for (int bj = 0; bj < 2; ++bj) { const f32x4 v0 = acc[ai][bj][m][0], v1 = acc[ai][bj][m][1];
                    s += ((v0[0] * v0[0] + v0[1] * v0[1]) + (v0[2] * v0[2] + v0[3] * v0[3])) + ((v1[0] * v1[0] + v1[1] * v1[1]) + (v1[2] * v1[2] + v1[3] * v1[3]));
                    u32x4 w; w.x = cvt_pk_bf16(v0[0], v0[1]); w.y = cvt_pk_bf16(v0[2], v0[3]); w.z = cvt_pk_bf16(v1[0], v1[1]); w.w = cvt_pk_bf16(v1[2], v1[3]);
                    *(u32x4*)(rowp + bj * HALF) = w; }
                s += __shfl_xor(s, 16); s += __shfl_xor(s, 32);
                if (fq == 0) part[(size_t)r * 32 + u.pn * 4 + wc] = s; }
    }
};

struct EpiPool {
    static constexpr bool PERM = true, AFTER_DRAIN = true;
    bf16_t* O; int ldc; const float* scale; PG8_LAS float* scr; float eps; int sh;
    __device__ __forceinline__ void fused(const f32x4 (&acc)[2][2][4][2], const Unit& u, int wr, int wc, int fr, int fq, PG8_LAS unsigned char*, int, int) const {
        const int grp = u.pm >> sh, rb = u.pm & ((1 << sh) - 1);
#pragma unroll
        for (int ai = 0; ai < 2; ++ai)
#pragma unroll
            for (int m = 0; m < 4; ++m) { float s = 0.f;
#pragma unroll
                for (int bj = 0; bj < 2; ++bj)
#pragma unroll
                    for (int n = 0; n < 2; ++n) { const f32x4 v = acc[ai][bj][m][n]; s += (v[0] * v[0] + v[1] * v[1]) + (v[2] * v[2] + v[3] * v[3]); }
                s += __shfl_xor(s, 16); s += __shfl_xor(s, 32);
                if (fq == 0) scr[(ai * HALF + wr * 64 + m * 16 + fr) * 4 + wc] = s;
                asm volatile("" ::: "memory"); }
        asm volatile("s_waitcnt lgkmcnt(0)" ::: "memory"); __builtin_amdgcn_s_barrier(); asm volatile("" ::: "memory");
        const int gc0 = grp * BM + wc * 32 + 8 * fq;
#pragma unroll
        for (int ai = 0; ai < 2; ++ai)
#pragma unroll
            for (int m = 0; m < 4; ++m) { const int rl = ai * HALF + wr * 64 + m * 16 + fr; const f32x4 p = *(const PG8_LAS f32x4*)(scr + rl * 4);
                const float rstd = __builtin_amdgcn_rsqf(((p[0] + p[1]) + (p[2] + p[3])) * (1.0f / 256.0f) + eps);
                bf16_t* rowp = O + (size_t)(rb * BM + rl) * ldc + 1024 + gc0;
#pragma unroll
                for (int bj = 0; bj < 2; ++bj) { const f32x4 s0 = *(const f32x4*)(scale + gc0 + bj * HALF), s1 = *(const f32x4*)(scale + gc0 + bj * HALF + 4);
                    const f32x4 v0 = acc[ai][bj][m][0] * rstd * s0, v1 = acc[ai][bj][m][1] * rstd * s1;
                    u32x4 w; w.x = cvt_pk_bf16(v0[0], v0[1]); w.y = cvt_pk_bf16(v0[2], v0[3]); w.z = cvt_pk_bf16(v1[0], v1[1]); w.w = cvt_pk_bf16(v1[2], v1[3]);
                    *(u32x4*)(rowp + bj * HALF) = w; }
                asm volatile("" ::: "memory"); }
        asm volatile("s_waitcnt lgkmcnt(0)" ::: "memory"); __builtin_amdgcn_s_barrier(); asm volatile("" ::: "memory");
    }
};

template <class Epi, class Sched, bool ALIGN_EPI = false, bool SP2 = false>
__device__ __forceinline__ void gemm_phase(PG8_LAS unsigned char* lds, const Gemm g, const Sched& S, const Epi& E) {
    const int tid = threadIdx.x, wid = __builtin_amdgcn_readfirstlane(tid >> 6), lane = tid & 63, wr = wid >> 2, wc = wid & 3, fr = lane & 15, fq = lane >> 4;
    const int K = g.K, nt = K / BK;
    unsigned voffA[2], voffB[2];
#pragma unroll
    for (int i = 0; i < 2; ++i) { int R, C; stage_rc(tid * 16 + i * 8192, R, C); const int Rb = Epi::PERM ? ((R & ~31) + perm32(R & 31)) : R;
        voffA[i] = (unsigned)(R * K + C) * 2u; voffB[i] = (unsigned)(Rb * K + C) * 2u; }
    const size_t kstep = (size_t)(BK * 2);
    const size_t hstep = (size_t)HALF * K * 2;
    const size_t tstep = 2 * hstep;
    const unsigned ldsw = (unsigned)wid * 1024u;
    const int aoff = lds_byte(wr * 64 + fr, fq * 8), boff = lds_byte(wc * 32 + fr, fq * 8);
#define PG8_SA(b, h) (((b) * 2 + (h)) * HTB)
#define PG8_SB(b, h) ((4 + (b) * 2 + (h)) * HTB)
#define PG8_STAGE(bufoff, gbase, voff) do { _Pragma("unroll") for (int _i = 0; _i < 2; ++_i) \
        __builtin_amdgcn_global_load_lds((const unsigned*)((const char*)(gbase) + (voff)[_i]), (PG8_LAS unsigned*)(lds + (bufoff) + ldsw + _i * 8192), 16, 0, 0); } while (0)
#define PG8_LDA(dst, b, h) do { _Pragma("unroll") for (int m = 0; m < 4; ++m) _Pragma("unroll") for (int k = 0; k < 2; ++k) dst[m][k] = *(const PG8_LAS bf16x8*)(lds + PG8_SA(b, h) + aoff + m * 2048 + k * 1024); } while (0)
#define PG8_LDB(dst, b, h) do { _Pragma("unroll") for (int n = 0; n < 2; ++n) _Pragma("unroll") for (int k = 0; k < 2; ++k) dst[n][k] = *(const PG8_LAS bf16x8*)(lds + PG8_SB(b, h) + boff + n * 2048 + k * 1024); } while (0)
#define PG8_MMA(ai, bj, At, Bt) do { __builtin_amdgcn_s_setprio(1); _Pragma("unroll") for (int m = 0; m < 4; ++m) _Pragma("unroll") for (int n = 0; n < 2; ++n) _Pragma("unroll") for (int k = 0; k < 2; ++k) \
        acc[ai][bj][m][n] = __builtin_amdgcn_mfma_f32_16x16x32_bf16(Bt[n][k], At[m][k], acc[ai][bj][m][n], 0, 0, 0); __builtin_amdgcn_s_setprio(0); } while (0)
#define PG8_WAIT_V(n) asm volatile("s_waitcnt vmcnt(" #n ")" ::: "memory")
#define PG8_WAIT_L(n) asm volatile("s_waitcnt lgkmcnt(" #n ")" ::: "memory")
#define PG8_BAR __builtin_amdgcn_s_barrier()
#define PG8_SCHED __builtin_amdgcn_sched_barrier(0)
    Unit cur, nxt; int ui = 0;
    if (!S.next(0, cur)) return;
    f32x4 acc[2][2][4][2];
#pragma unroll
    for (int a = 0; a < 2; ++a)
#pragma unroll
        for (int b = 0; b < 2; ++b)
#pragma unroll
            for (int m = 0; m < 4; ++m)
#pragma unroll
                for (int n = 0; n < 2; ++n) acc[a][b][m][n] = (f32x4){0.f, 0.f, 0.f, 0.f};
    bf16x8 At[4][2], B0[2][2], B1[2][2];
    const char* cA = (const char*)g.A + (size_t)cur.pm * tstep; const char* cB = (const char*)g.Bt + (size_t)btile(g, cur) * tstep;
    S.a_ready(cur);
    if constexpr (SP2) {
        PG8_STAGE(PG8_SB(0, 0), cB, voffB); PG8_STAGE(PG8_SB(0, 1), cB + hstep, voffB); PG8_STAGE(PG8_SA(0, 0), cA, voffA); PG8_STAGE(PG8_SA(0, 1), cA + hstep, voffA);
        if (wr == 1) PG8_BAR;
        PG8_WAIT_V(2); PG8_BAR;
        PG8_STAGE(PG8_SB(1, 0), cB + kstep, voffB); PG8_STAGE(PG8_SA(1, 0), cA + kstep, voffA); PG8_STAGE(PG8_SB(1, 1), cB + hstep + kstep, voffB);
        PG8_WAIT_V(6); PG8_BAR;
    } else {
        PG8_STAGE(PG8_SB(0, 0), cB, voffB); PG8_STAGE(PG8_SA(0, 0), cA, voffA); PG8_STAGE(PG8_SB(0, 1), cB + hstep, voffB); PG8_STAGE(PG8_SA(0, 1), cA + hstep, voffA);
        if (wr == 1) PG8_BAR;
        PG8_WAIT_V(4); PG8_BAR;
        PG8_STAGE(PG8_SB(1, 0), cB + kstep, voffB); PG8_STAGE(PG8_SA(1, 0), cA + kstep, voffA); PG8_STAGE(PG8_SB(1, 1), cB + hstep + kstep, voffB);
        PG8_WAIT_V(6); PG8_BAR;
    }
    for (;;) {
        const bool has_next = S.next(ui + 1, nxt);
        const char* nA = has_next ? (const char*)g.A + (size_t)nxt.pm * tstep : cA; const char* nB = has_next ? (const char*)g.Bt + (size_t)btile(g, nxt) * tstep : cB;
        for (int t = 0; t < nt; t += 2) {
            const bool last = (t == nt - 2);
            const char* a1 = cA + (size_t)(t + 1) * kstep;
            const char* a2 = last ? nA : cA + (size_t)(t + 2) * kstep; const char* b2 = last ? nB : cB + (size_t)(t + 2) * kstep;
            const char* a3 = a2 + kstep; const char* b3 = b2 + kstep;
            if (last && has_next) S.a_ready(nxt);
            if constexpr (SP2) {
            PG8_LDB(B0, 0, 0); PG8_LDB(B1, 0, 1); PG8_SCHED; PG8_LDA(At, 0, 0); PG8_STAGE(PG8_SA(1, 1), a1 + hstep, voffA);
            PG8_WAIT_V(8); PG8_WAIT_L(0); PG8_BAR; PG8_MMA(0, 0, At, B0); PG8_MMA(0, 1, At, B1); PG8_BAR; PG8_SCHED;
            PG8_LDA(At, 0, 1); PG8_STAGE(PG8_SB(0, 0), b2, voffB); PG8_STAGE(PG8_SB(0, 1), b2 + hstep, voffB); PG8_STAGE(PG8_SA(0, 0), a2, voffA);
            PG8_WAIT_V(8); PG8_WAIT_L(0); PG8_BAR; PG8_MMA(1, 0, At, B0); PG8_MMA(1, 1, At, B1); PG8_BAR; PG8_SCHED;
            PG8_LDB(B0, 1, 0); PG8_LDB(B1, 1, 1); PG8_SCHED; PG8_LDA(At, 1, 0); PG8_STAGE(PG8_SA(0, 1), a2 + hstep, voffA);
            PG8_WAIT_V(8); PG8_WAIT_L(0); PG8_BAR; PG8_MMA(0, 0, At, B0); PG8_MMA(0, 1, At, B1); PG8_BAR; PG8_SCHED;
            PG8_LDA(At, 1, 1); PG8_STAGE(PG8_SB(1, 0), b3, voffB); PG8_STAGE(PG8_SB(1, 1), b3 + hstep, voffB); PG8_STAGE(PG8_SA(1, 0), a3, voffA);
            PG8_WAIT_V(8); PG8_WAIT_L(0); PG8_BAR; PG8_MMA(1, 0, At, B0); PG8_MMA(1, 1, At, B1); PG8_BAR; PG8_SCHED;
            } else {
            PG8_LDB(B0, 0, 0); PG8_SCHED; PG8_LDA(At, 0, 0); PG8_STAGE(PG8_SA(1, 1), a1 + hstep, voffA);
            PG8_WAIT_L(8); PG8_BAR; PG8_WAIT_L(0); PG8_MMA(0, 0, At, B0); PG8_BAR; PG8_SCHED;
            PG8_LDB(B1, 0, 1); PG8_STAGE(PG8_SB(0, 0), b2, voffB);
            PG8_BAR; PG8_WAIT_L(0); PG8_MMA(0, 1, At, B1); PG8_BAR;
            PG8_LDA(At, 0, 1); PG8_STAGE(PG8_SA(0, 0), a2, voffA);
            PG8_BAR; PG8_WAIT_L(0); PG8_MMA(1, 0, At, B0); PG8_BAR; PG8_SCHED;
            PG8_STAGE(PG8_SB(0, 1), b2 + hstep, voffB);
            PG8_WAIT_V(6); PG8_BAR; PG8_MMA(1, 1, At, B1); PG8_BAR;
            PG8_LDB(B0, 1, 0); PG8_SCHED; PG8_LDA(At, 1, 0); PG8_STAGE(PG8_SA(0, 1), a2 + hstep, voffA);
            PG8_WAIT_L(8); PG8_BAR; PG8_WAIT_L(0); PG8_MMA(0, 0, At, B0); PG8_BAR; PG8_SCHED;
            PG8_LDB(B1, 1, 1); PG8_STAGE(PG8_SB(1, 0), b3, voffB);
            PG8_BAR; PG8_WAIT_L(0); PG8_MMA(0, 1, At, B1); PG8_BAR;
            PG8_LDA(At, 1, 1); PG8_STAGE(PG8_SA(1, 0), a3, voffA);
            PG8_BAR; PG8_WAIT_L(0); PG8_MMA(1, 0, At, B0); PG8_BAR; PG8_SCHED;
            PG8_STAGE(PG8_SB(1, 1), b3 + hstep, voffB);
            PG8_WAIT_V(6); PG8_BAR; PG8_MMA(1, 1, At, B1); PG8_BAR;
            }
        }
        if constexpr (ALIGN_EPI) { if (wr == 0) PG8_BAR; }
        if constexpr (!Epi::AFTER_DRAIN) { E(acc, cur, wr, wc, fr, fq); S.done(cur); }
        if (!has_next) break;
#pragma unroll
        for (int a = 0; a < 2; ++a)
#pragma unroll
            for (int b = 0; b < 2; ++b)
#pragma unroll
                for (int m = 0; m < 4; ++m)
#pragma unroll
                    for (int n = 0; n < 2; ++n) acc[a][b][m][n] = (f32x4){0.f, 0.f, 0.f, 0.f};
        cur = nxt; cA = nA; cB = nB; ++ui;
        if constexpr (ALIGN_EPI) { if (wr == 1) PG8_BAR; }
    }
    PG8_WAIT_V(0);
    if constexpr (!ALIGN_EPI) { if (wr == 0) PG8_BAR; }
    PG8_BAR;
    if constexpr (Epi::AFTER_DRAIN) { E.fused(acc, cur, wr, wc, fr, fq, lds, wid, lane); S.done(cur); }
#undef PG8_SA
#undef PG8_SB
#undef PG8_STAGE
#undef PG8_LDA
#undef PG8_LDB
#undef PG8_MMA
#undef PG8_WAIT_V
#undef PG8_WAIT_L
#undef PG8_BAR
#undef PG8_SCHED
}
}

constexpr int NWAVES = 8;
constexpr int BATCH = 2, SEQ = 8192, D = 2048, CW = 1024, PW = 1024, NPROJ = 4096, FF = 5632;
constexpr int M = BATCH * SEQ;
constexpr float EPS = 1e-6f;
constexpr int NGRP = 2, GW = 128, MG = SEQ;

constexpr size_t MiB = 1u << 20;
constexpr size_t WS_CTL = 0, CTL_ZERO_BYTES = 32768;
constexpr int CW_FLAG = 8192 - 128;
constexpr size_t WS_PART1 = 1 * MiB, WS_PART2 = 3 * MiB;
constexpr size_t WS_WD = 5 * MiB;
constexpr size_t WS_WIN = 27 * MiB;
constexpr size_t WS_WOUT = 43 * MiB;
constexpr size_t WS_WGU = 51 * MiB;
constexpr size_t WS_WPOOL = 95 * MiB;
constexpr size_t WS_H = 96 * MiB;
constexpr size_t WS_FF = 27 * MiB;
constexpr size_t WS_PROJ = 160 * MiB;
constexpr size_t WS_POOLED = 288 * MiB;
constexpr size_t WS_MIXED = 320 * MiB;
constexpr size_t WS_MIXOUT = 384 * MiB;
constexpr size_t WS_ACT = 160 * MiB;
constexpr size_t WS_END = 448 * MiB;
static_assert(WS_FF + (size_t)M * D * 2 <= WS_WPOOL && WS_ACT + (size_t)M * FF * 2 <= WS_MIXOUT && WS_MIXOUT + (size_t)M * D * 2 <= WS_END && WS_WD + (size_t)D * FF * 2 <= WS_FF, "d_ws map");

constexpr int RING_BYTES = 131072, EPI_SCR_OFF = RING_BYTES, MISC_OFF = RING_BYTES + 4096, LDS_BYTES = 147456;

#define GAS __attribute__((address_space(1)))
#define LAS __attribute__((address_space(3)))
typedef unsigned short bf16;
typedef unsigned v4u __attribute__((ext_vector_type(4)));
typedef unsigned v2u __attribute__((ext_vector_type(2)));
typedef float f32x4 __attribute__((ext_vector_type(4)));
#define LDS_WAIT() asm volatile("s_waitcnt lgkmcnt(0)" ::: "memory")
__device__ __forceinline__ unsigned f2bf(float f) { unsigned u = __builtin_bit_cast(unsigned, f); return (u + 0x7fffu + ((u >> 16) & 1u)) >> 16; }
__device__ __forceinline__ unsigned pk2(float lo, float hi) { return f2bf(lo) | (f2bf(hi) << 16); }
__device__ __forceinline__ float bflo(unsigned w) { return __builtin_bit_cast(float, w << 16); }
__device__ __forceinline__ float bfhi(unsigned w) { return __builtin_bit_cast(float, w & 0xffff0000u); }
__device__ __forceinline__ float wave_sum(float v) {
#pragma unroll
    for (int o = 1; o < 64; o <<= 1) v += __shfl_xor(v, o);
    return v;
}

typedef GAS unsigned gu32;
#define RLX_AGENT __ATOMIC_RELAXED, __HIP_MEMORY_SCOPE_AGENT
#define XB_TMO      128
#define XB_XCNT(j)  (256  + 64 * (j))
#define XB_XSUB(j)  (1280 + 64 * (j))
#define XB_XGEN(j)  (2304 + 64 * (j))
#define XB_TOP      3328
#define XB_TOPGEN   3392
#define XCD_BAR_WORDS 3456
#define XB_SPIN_CAP (1u << 18)

__device__ __forceinline__ unsigned xb_ld(unsigned* p)              { return __hip_atomic_load(p, __ATOMIC_RELAXED, __HIP_MEMORY_SCOPE_AGENT); }
__device__ __forceinline__ unsigned xb_add(unsigned* p, unsigned v) { return __hip_atomic_fetch_add(p, v, __ATOMIC_RELAXED, __HIP_MEMORY_SCOPE_AGENT); }
__device__ __forceinline__ unsigned xb_xcc_id() { return (unsigned)__builtin_amdgcn_s_getreg((3 << 11) | 20) & 0xFu; }
#define XB_SPIN(cond, bar) do { unsigned _sp = 0; while (cond) { __builtin_amdgcn_s_sleep(1); \
    if ((++_sp & 255u) == 0u) { if (xb_ld(&(bar)[XB_TMO])) break; if (_sp > XB_SPIN_CAP) { atomicAdd(&(bar)[XB_TMO], 1u); break; } } } } while (0)

struct XcdBarrier {
    unsigned* bar; unsigned x; unsigned G;
    volatile LAS unsigned* st;
};

__device__ __forceinline__ XcdBarrier xcd_barrier_post(unsigned* bar, volatile LAS unsigned* st, unsigned G) {
    XcdBarrier b; b.bar = bar; b.x = xb_xcc_id(); b.st = st; b.G = G;
    if (threadIdx.x == 0) (void)xb_add(&bar[XB_XCNT(b.x)], 1u);
    return b;
}
__device__ __forceinline__ void xcd_barrier_complete(unsigned* bar, unsigned x, unsigned G, unsigned& nloc, unsigned& nx) {
    unsigned sum, cnt, mine, sp = 0u;
    for (;;) {
        sum = 0u; cnt = 0u; mine = 0u;
#pragma unroll
        for (unsigned j = 0; j < 16; ++j) { const unsigned c = xb_ld(&bar[XB_XCNT(j)]); sum += c; cnt += (c > 0u) ? 1u : 0u; mine = (j == x) ? c : mine; }
        if (sum == G) break;
        __builtin_amdgcn_s_sleep(1);
        if ((++sp & 255u) == 0u) { if (xb_ld(&bar[XB_TMO])) break; if (sp > XB_SPIN_CAP) { atomicAdd(&bar[XB_TMO], 1u); break; } }
    }
    nloc = mine > 0u ? mine : 1u; nx = cnt > 0u ? cnt : 1u;
}

__device__ __forceinline__ void xcd_barrier(const XcdBarrier& b) {
    asm volatile("s_waitcnt vmcnt(0)" ::: "memory");
    __syncthreads();
    if (threadIdx.x == 0) {
        unsigned* bar = b.bar;
        __builtin_amdgcn_s_waitcnt(0);
        unsigned nloc = b.st[0], nx = b.st[1];
        if (nloc == 0u) { xcd_barrier_complete(bar, b.x, b.G, nloc, nx); b.st[0] = nloc; b.st[1] = nx; }
        const unsigned old = xb_add(&bar[XB_XSUB(b.x)], 1u);
        const unsigned gen = old / nloc;
        if (old + 1u == (gen + 1u) * nloc) {
            __builtin_amdgcn_fence(__ATOMIC_RELEASE, "agent");
            asm volatile("s_waitcnt vmcnt(0)" ::: "memory");
            const unsigned og = xb_add(&bar[XB_TOP], 1u);
            const unsigned tg = og / nx;
            if (og + 1u == (tg + 1u) * nx) xb_add(&bar[XB_TOPGEN], 1u);
            else XB_SPIN(xb_ld(&bar[XB_TOPGEN]) == tg, bar);
            __builtin_amdgcn_fence(__ATOMIC_ACQUIRE, "agent");
            xb_add(&bar[XB_XGEN(b.x)], 1u);
            asm volatile("s_waitcnt vmcnt(0)" ::: "memory");
        } else {
            XB_SPIN(xb_ld(&bar[XB_XGEN(b.x)]) == gen, bar);
            __builtin_amdgcn_fence(__ATOMIC_ACQUIRE, "agent");
            asm volatile("s_waitcnt vmcnt(0)" ::: "memory");
        }
    }
    __syncthreads();
}

struct Frame {
    LAS unsigned char* lds;
    int tid, lane, wave;
    int grp, c, row0;
    const float *x, *g_pre, *w_in, *conv_w, *pool_w, *pool_scale, *w_out, *g_post, *g_fpre, *w_gate, *w_up, *w_down, *g_fpost;
    float* out; unsigned char* ws;
};

template <int MODE>
__device__ __forceinline__ void p0_transpose_item(const float* W, int K, int N, bf16* WT, LAS float* scr, int item, int lane) {
    const int nblk = N / 32, kb = item / nblk, nb = item % nblk, k0 = 64 * kb, n0 = 32 * nb;
    const int drow0 = MODE == 0 ? n0 : ((n0 >> 7) * 256 + (n0 & 127) + (MODE == 2 ? 128 : 0));
#pragma unroll 8
    for (int i = 0; i < 32; ++i) { const int kk = 2 * i + (lane >> 5); scr[kk * 33 + (lane & 31)] = W[(size_t)(k0 + kk) * N + n0 + (lane & 31)]; }
    LDS_WAIT(); asm volatile("" ::: "memory");
    const int c = lane & 7;
#pragma unroll
    for (int j = 0; j < 4; ++j) { const int n = (lane >> 3) + 8 * j; const LAS float* s = scr + (8 * c) * 33 + n;
        v4u o; o.x = pk2(s[0 * 33], s[1 * 33]); o.y = pk2(s[2 * 33], s[3 * 33]); o.z = pk2(s[4 * 33], s[5 * 33]); o.w = pk2(s[6 * 33], s[7 * 33]);
        *(GAS v4u*)(WT + (size_t)(drow0 + n) * K + k0 + 8 * c) = o; }
    LDS_WAIT(); asm volatile("" ::: "memory");
}

__device__ __forceinline__ void p0_win(Frame& F) {
    LAS float* scr = (LAS float*)(F.lds + F.wave * 16384);
    const int gw = F.c * NWAVES + F.wave, NGW = GW * NWAVES;
    constexpr int I_IN = (D / 64) * (NPROJ / 32);
    for (int it = gw; it < I_IN; it += NGW) p0_transpose_item<0>(F.w_in, D, NPROJ, (bf16*)(F.ws + WS_WIN), scr, it, F.lane);
}
__device__ __forceinline__ void p0_wrest(Frame& F) {
    LAS float* scr = (LAS float*)(F.lds + F.wave * 16384);
    const int gw = F.c * NWAVES + F.wave, NGW = GW * NWAVES;
    unsigned char* ws = F.ws;
    constexpr int I_OUT = (D / 64) * (D / 32), I_G = (D / 64) * (FF / 32), I_D = (FF / 64) * (D / 32), I_P1 = (256 / 64) * (256 / 32), I_P = 4 * I_P1;
    constexpr int NITEMS = I_OUT + 2 * I_G + I_D + I_P;
    for (int it = gw; it < NITEMS; it += NGW) {
        int r = it;
        if (r < I_P) { const int g = r / I_P1; p0_transpose_item<0>(F.pool_w + (size_t)g * 65536, 256, 256, (bf16*)(ws + WS_WPOOL) + (size_t)g * 65536, scr, r % I_P1, F.lane); continue; } r -= I_P;
        if (r < I_OUT) { p0_transpose_item<0>(F.w_out, D, D, (bf16*)(ws + WS_WOUT), scr, r, F.lane); continue; } r -= I_OUT;
        if (r < I_G) { p0_transpose_item<1>(F.w_gate, D, FF, (bf16*)(ws + WS_WGU), scr, r, F.lane); continue; } r -= I_G;
        if (r < I_G) { p0_transpose_item<2>(F.w_up, D, FF, (bf16*)(ws + WS_WGU), scr, r, F.lane); continue; } r -= I_G;
        p0_transpose_item<0>(F.w_down, FF, D, (bf16*)(ws + WS_WD), scr, r, F.lane);
    }
}
__device__ __forceinline__ void p0_hrows(Frame& F) {
    const int gw = F.c * NWAVES + F.wave, NGW = GW * NWAVES;
    f32x4 gv[8];
#pragma unroll
    for (int j = 0; j < 8; ++j) gv[j] = ((const GAS f32x4*)F.g_pre)[F.lane + 64 * j];
    bf16* H = (bf16*)(F.ws + WS_H);
    for (int mm = gw; mm < MG; mm += NGW) {
        const int m = F.row0 + mm;
        const GAS f32x4* xr = (const GAS f32x4*)(F.x + (size_t)m * D) + F.lane;
        f32x4 v[8]; float s = 0.f;
#pragma unroll
        for (int j = 0; j < 8; ++j) { v[j] = xr[64 * j]; s += (v[j].x * v[j].x + v[j].y * v[j].y) + (v[j].z * v[j].z + v[j].w * v[j].w); }
        const float rstd = 1.0f / sqrtf(wave_sum(s) * (1.0f / D) + EPS);
        GAS v2u* o8 = (GAS v2u*)(H + (size_t)m * D) + F.lane;
#pragma unroll
        for (int j = 0; j < 8; ++j) { const f32x4 y = v[j] * rstd * gv[j]; v2u w; w.x = pk2(y.x, y.y); w.y = pk2(y.z, y.w); o8[64 * j] = w; }
    }
}

__device__ __forceinline__ void unpack16(const bf16* p, float (&f)[16]) {
    const v4u a = *(const GAS v4u*)p, b = *((const GAS v4u*)p + 1);
    f[0] = bflo(a.x); f[1] = bfhi(a.x); f[2] = bflo(a.y); f[3] = bfhi(a.y); f[4] = bflo(a.z); f[5] = bfhi(a.z); f[6] = bflo(a.w); f[7] = bfhi(a.w);
    f[8] = bflo(b.x); f[9] = bfhi(b.x); f[10] = bflo(b.y); f[11] = bfhi(b.y); f[12] = bflo(b.z); f[13] = bfhi(b.z); f[14] = bflo(b.w); f[15] = bfhi(b.w);
}
__device__ __forceinline__ void pack16_store(bf16* p, const float (&f)[16]) {
    v4u a, b; a.x = pk2(f[0], f[1]); a.y = pk2(f[2], f[3]); a.z = pk2(f[4], f[5]); a.w = pk2(f[6], f[7]);
    b.x = pk2(f[8], f[9]); b.y = pk2(f[10], f[11]); b.z = pk2(f[12], f[13]); b.w = pk2(f[14], f[15]);
    *(GAS v4u*)p = a; *((GAS v4u*)p + 1) = b;
}
__device__ __forceinline__ void p2_mixer(Frame& F) {
    const int gw = F.c * NWAVES + F.wave, NGW = GW * NWAVES, l = F.lane;
    const bf16* P = (const bf16*)(F.ws + WS_PROJ);
    bf16* MIX = (bf16*)(F.ws + WS_MIXED); bf16* PO = (bf16*)(F.ws + WS_POOLED) + (size_t)F.grp * 4 * MG * 256;
    float w0[16], w1[16], w2[16];
#pragma unroll
    for (int i = 0; i < 16; ++i) { w0[i] = F.conv_w[0 * CW + 16 * l + i]; w1[i] = F.conv_w[1 * CW + 16 * l + i]; w2[i] = F.conv_w[2 * CW + 16 * l + i]; }
    const int wlen = 2 << (l >> 4);
    for (int chunk = gw; chunk < MG / 8; chunk += NGW) {
        const int t0 = chunk * 8, m0 = F.row0 + t0;
        {
            float cu1[16], cu2[16];
#pragma unroll
            for (int i = 0; i < 16; ++i) { cu1[i] = 0.f; cu2[i] = 0.f; }
            if (t0 > 0) {
                float c[16], u[16];
                unpack16(P + (size_t)(m0 - 1) * NPROJ + CW + 16 * l, c); unpack16(P + (size_t)(m0 - 1) * NPROJ + 2 * CW + 16 * l, u);
#pragma unroll
                for (int i = 0; i < 16; ++i) cu1[i] = c[i] * u[i];
                unpack16(P + (size_t)(m0 - 2) * NPROJ + CW + 16 * l, c); unpack16(P + (size_t)(m0 - 2) * NPROJ + 2 * CW + 16 * l, u);
#pragma unroll
                for (int i = 0; i < 16; ++i) cu2[i] = c[i] * u[i];
            }
#pragma unroll 1
            for (int r = 0; r < 8; ++r) {
                const bf16* row = P + (size_t)(m0 + r) * NPROJ + 16 * l;
                float b[16], c[16], u[16], y[16];
                unpack16(row, b); unpack16(row + CW, c); unpack16(row + 2 * CW, u);
                float ss = 0.f;
#pragma unroll
                for (int i = 0; i < 16; ++i) { const float cu0 = c[i] * u[i]; y[i] = b[i] * (w0[i] * cu2[i] + w1[i] * cu1[i] + w2[i] * cu0); ss += y[i] * y[i]; cu2[i] = cu1[i]; cu1[i] = cu0; }
                ss += __shfl_xor(ss, 1); ss += __shfl_xor(ss, 2); ss += __shfl_xor(ss, 4);
                const float rstd = 1.0f / sqrtf(ss * (1.0f / 128.0f) + EPS);
#pragma unroll
                for (int i = 0; i < 16; ++i) y[i] *= rstd;
                pack16_store(MIX + (size_t)(m0 + r) * D + 16 * l, y);
            }
        }
        {
            const bf16* vcol = P + 3 * CW + 16 * l;
            float S[16];
#pragma unroll
            for (int i = 0; i < 16; ++i) S[i] = 0.f;
#pragma unroll 1
            for (int j = 1; j < 16; ++j) if (j < wlen && t0 - j >= 0) { float v[16]; unpack16(vcol + (size_t)(m0 - j) * NPROJ, v);
#pragma unroll
                for (int i = 0; i < 16; ++i) S[i] += v[i]; }
            bf16* orow = PO + ((size_t)(l >> 4) * MG + t0) * 256 + 16 * (l & 15);
#pragma unroll 1
            for (int r = 0; r < 8; ++r) {
                const int t = t0 + r; float v[16], o[16]; unpack16(vcol + (size_t)(m0 + r) * NPROJ, v);
                const int cnt = (t + 1) < wlen ? (t + 1) : wlen; const float inv = 1.0f / (float)cnt;
#pragma unroll
                for (int i = 0; i < 16; ++i) { S[i] += v[i]; o[i] = S[i] * inv - v[i]; }
                pack16_store(orow + (size_t)r * 256, o);
                if (t - wlen + 1 >= 0) { float q[16]; unpack16(vcol + (size_t)(m0 + r - wlen + 1) * NPROJ, q);
#pragma unroll
                    for (int i = 0; i < 16; ++i) S[i] -= q[i]; }
            }
        }
    }
}

__device__ __forceinline__ void ld8(const float* p, f32x4& a, f32x4& b) { a = *(const GAS f32x4*)p; b = *((const GAS f32x4*)p + 1); }
__device__ __forceinline__ void bf8(const bf16* p, f32x4& a, f32x4& b) { const v4u w = *(const GAS v4u*)p; a = (f32x4){bflo(w.x), bfhi(w.x), bflo(w.y), bfhi(w.y)}; b = (f32x4){bflo(w.z), bfhi(w.z), bflo(w.w), bfhi(w.w)}; }
__device__ __forceinline__ float sq4(const f32x4 v) { return (v.x * v.x + v.y * v.y) + (v.z * v.z + v.w * v.w); }
__device__ __forceinline__ void p5_resnorm(Frame& F) {
    const int gw = F.c * NWAVES + F.wave, NGW = GW * NWAVES, l = F.lane;
    const bf16* MO = (const bf16*)(F.ws + WS_MIXOUT); const float* part = (const float*)(F.ws + WS_PART1); bf16* H = (bf16*)(F.ws + WS_H);
    f32x4 g1[4][2], g2[4][2];
#pragma unroll
    for (int j = 0; j < 4; ++j) { ld8(F.g_post + 8 * l + 512 * j, g1[j][0], g1[j][1]); ld8(F.g_fpre + 8 * l + 512 * j, g2[j][0], g2[j][1]); }
    for (int mm = gw; mm < MG; mm += NGW) {
        const int m = F.row0 + mm;
        const float p = l < 32 ? part[(size_t)m * 32 + l] : 0.f;
        const float rstd1 = 1.0f / sqrtf(wave_sum(p) * (1.0f / D) + EPS);
        const float* xr = F.x + (size_t)m * D + 8 * l; const bf16* mr = MO + (size_t)m * D + 8 * l;
        f32x4 v[4][2]; float s = 0.f;
#pragma unroll
        for (int j = 0; j < 4; ++j) { f32x4 x0, x1, m0, m1; ld8(xr + 512 * j, x0, x1); bf8(mr + 512 * j, m0, m1);
            v[j][0] = x0 + m0 * rstd1 * g1[j][0]; v[j][1] = x1 + m1 * rstd1 * g1[j][1]; s += sq4(v[j][0]) + sq4(v[j][1]); }
        const float rstd2 = 1.0f / sqrtf(wave_sum(s) * (1.0f / D) + EPS);
        bf16* hr = H + (size_t)m * D + 8 * l;
#pragma unroll
        for (int j = 0; j < 4; ++j) { const f32x4 y0 = v[j][0] * rstd2 * g2[j][0], y1 = v[j][1] * rstd2 * g2[j][1];
            v4u w; w.x = pk2(y0.x, y0.y); w.y = pk2(y0.z, y0.w); w.z = pk2(y1.x, y1.y); w.w = pk2(y1.z, y1.w); *(GAS v4u*)(hr + 512 * j) = w; }
    }
}
__device__ __forceinline__ void p8_final(Frame& F) {
    const int gw = F.c * NWAVES + F.wave, NGW = GW * NWAVES, l = F.lane;
    const bf16* MO = (const bf16*)(F.ws + WS_MIXOUT); const bf16* FFO = (const bf16*)(F.ws + WS_FF);
    const float* part1 = (const float*)(F.ws + WS_PART1); const float* part2 = (const float*)(F.ws + WS_PART2);
    f32x4 g1[4][2], g3[4][2];
#pragma unroll
    for (int j = 0; j < 4; ++j) { ld8(F.g_post + 8 * l + 512 * j, g1[j][0], g1[j][1]); ld8(F.g_fpost + 8 * l + 512 * j, g3[j][0], g3[j][1]); }
    for (int mm = gw; mm < MG; mm += NGW) {
        const int m = F.row0 + mm;
        const float p1 = l < 32 ? part1[(size_t)m * 32 + l] : 0.f, p2 = l < 32 ? part2[(size_t)m * 32 + l] : 0.f;
        const float rstd1 = 1.0f / sqrtf(wave_sum(p1) * (1.0f / D) + EPS), rstd2 = 1.0f / sqrtf(wave_sum(p2) * (1.0f / D) + EPS);
        const float* xr = F.x + (size_t)m * D + 8 * l; const bf16* mr = MO + (size_t)m * D + 8 * l; const bf16* fr = FFO + (size_t)m * D + 8 * l;
        float* orow = F.out + (size_t)m * D + 8 * l;
#pragma unroll
        for (int j = 0; j < 4; ++j) { f32x4 x0, x1, m0, m1, f0, f1; ld8(xr + 512 * j, x0, x1); bf8(mr + 512 * j, m0, m1); bf8(fr + 512 * j, f0, f1);
            *(GAS f32x4*)(orow + 512 * j) = x0 + m0 * rstd1 * g1[j][0] + f0 * rstd2 * g3[j][0]; *((GAS f32x4*)(orow + 512 * j) + 1) = x1 + m1 * rstd1 * g1[j][1] + f1 * rstd2 * g3[j][1]; }
    }
}

__device__ __forceinline__ void flag_set(unsigned* flag) { __hip_atomic_store(flag, 1u, __ATOMIC_RELAXED, __HIP_MEMORY_SCOPE_AGENT); }
__device__ __forceinline__ void flag_wait(unsigned* flag, unsigned* tmo) {
    if (threadIdx.x == 0) {
        unsigned sp = 0u;
        while (xb_ld(flag) == 0u) { __builtin_amdgcn_s_sleep(2); if ((++sp & 255u) == 0u) { if (xb_ld(tmo)) break; if (sp > XB_SPIN_CAP) { atomicAdd(tmo, 1u); break; } } }
        __builtin_amdgcn_fence(__ATOMIC_ACQUIRE, "agent");
        asm volatile("s_waitcnt vmcnt(0)" ::: "memory");
    }
    __syncthreads();
}

struct Args { const float* in[13]; float* out; unsigned char* ws; };
__global__ void __launch_bounds__(NWAVES * 64, 2) mk_fwd(Args args) {
    extern __shared__ __attribute__((aligned(16))) unsigned char lds[];
    Frame F;
    F.lds = (LAS unsigned char*)lds;
    F.tid = threadIdx.x; F.lane = F.tid & 63; F.wave = __builtin_amdgcn_readfirstlane(F.tid >> 6);
    { const int bx = blockIdx.x; F.grp = (bx & 7) >> 2; F.c = (bx >> 3) * 4 + (bx & 3); F.row0 = F.grp * MG; }
    F.x = args.in[0]; F.g_pre = args.in[1]; F.w_in = args.in[2]; F.conv_w = args.in[3]; F.pool_w = args.in[4]; F.pool_scale = args.in[5]; F.w_out = args.in[6];
    F.g_post = args.in[7]; F.g_fpre = args.in[8]; F.w_gate = args.in[9]; F.w_up = args.in[10]; F.w_down = args.in[11]; F.g_fpost = args.in[12];
    F.out = args.out; F.ws = args.ws;
    unsigned char* ws = args.ws;
    unsigned* ctl = (unsigned*)(ws + WS_CTL);
    volatile LAS unsigned* MISC = (volatile LAS unsigned*)(F.lds + MISC_OFF);
    if (F.tid < 64) MISC[F.tid] = 0u;
    __syncthreads();
    const XcdBarrier bar = xcd_barrier_post(ctl + 4096 * F.grp, MISC + 8, (unsigned)GW);
    unsigned* flagA = ctl + CW_FLAG; unsigned* flagB = ctl + CW_FLAG + 64; unsigned* tmo = ctl + 4096 * F.grp + XB_TMO;
#define BAR() xcd_barrier(bar)
    typedef pg8::bf16_t bt;
    const size_t r0 = (size_t)F.row0;
    if (F.grp == 0) { p0_win(F); p0_hrows(F); BAR(); if (F.c == 0 && F.tid == 0) flag_set(flagA); }
    else { p0_wrest(F); BAR(); if (F.c == 0 && F.tid == 0) flag_set(flagB); p0_hrows(F); BAR(); flag_wait(flagA, tmo); }
#ifndef PHMASK
#define PHMASK 0x1ff
#endif
    if (PHMASK & 2) {
        pg8::Gemm g{(const bt*)(ws + WS_H) + r0 * D, (const bt*)(ws + WS_WIN), MG, NPROJ, D, 0}; pg8::StaticOrder S; S.init(MG, NPROJ, GW, F.c, 4);
        pg8::EpiBf16 E{(bt*)(ws + WS_PROJ) + r0 * NPROJ, NPROJ};
        pg8::gemm_phase<pg8::EpiBf16, pg8::StaticOrder, true, true>(F.lds, g, S, E);
    }
    BAR();
    if (PHMASK & 4) p2_mixer(F);
    BAR();
    if (F.grp == 0) flag_wait(flagB, tmo);
    if (PHMASK & 8) {
        int kpool = 256; asm volatile("" : "+s"(kpool));
        pg8::Gemm g{(const bt*)(ws + WS_POOLED) + (size_t)F.grp * 4 * MG * 256, (const bt*)(ws + WS_WPOOL), 4 * MG, 256, kpool, MG / 256}; pg8::StaticOrder S; S.init(4 * MG, 256, GW, F.c, 4);
        pg8::EpiPool E{(bt*)(ws + WS_MIXED) + r0 * D, D, F.pool_scale, (LAS float*)(F.lds + EPI_SCR_OFF), EPS, 5};
        pg8::gemm_phase<pg8::EpiPool, pg8::StaticOrder, false, true>(F.lds, g, S, E);
    }
    BAR();
    if (PHMASK & 16) {
        pg8::Gemm g{(const bt*)(ws + WS_MIXED) + r0 * D, (const bt*)(ws + WS_WOUT), MG, D, D, 0}; pg8::StaticOrder S; S.init(MG, D, GW, F.c, 4);
        pg8::EpiBf16Stat E{(bt*)(ws + WS_MIXOUT) + r0 * D, D, (float*)(ws + WS_PART1) + r0 * 32};
        pg8::gemm_phase<pg8::EpiBf16Stat, pg8::StaticOrder, true, true>(F.lds, g, S, E);
    }
    BAR();
    if (PHMASK & 32) p5_resnorm(F);
    BAR();
    if (PHMASK & 64) {
        pg8::Gemm g{(const bt*)(ws + WS_H) + r0 * D, (const bt*)(ws + WS_WGU), MG, 2 * FF, D, 0}; pg8::StaticOrder S; S.init(MG, 2 * FF, GW, F.c, 4);
        pg8::EpiSwiGLU E{(bt*)(ws + WS_ACT) + r0 * FF, FF};
        pg8::gemm_phase<pg8::EpiSwiGLU, pg8::StaticOrder, true, true>(F.lds, g, S, E);
    }
    BAR();
    if (PHMASK & 128) {
        pg8::Gemm g{(const bt*)(ws + WS_ACT) + r0 * FF, (const bt*)(ws + WS_WD), MG, D, FF, 0}; pg8::StaticOrder S; S.init(MG, D, GW, F.c, 4);
        pg8::EpiBf16Stat E{(bt*)(ws + WS_FF) + r0 * D, D, (float*)(ws + WS_PART2) + r0 * 32};
        pg8::gemm_phase<pg8::EpiBf16Stat, pg8::StaticOrder, true, true>(F.lds, g, S, E);
    }
    BAR();
    if (PHMASK & 256) p8_final(F);
#undef BAR
}

extern "C" void kernel_launch(void* const* d_in, const int* in_sizes, int n_in, void* d_out, int out_size, void* d_ws, size_t ws_size, hipStream_t stream) {
    static int grid = 0;
    if (grid == 0) {
        if (n_in != 13 || in_sizes[0] != M * D || out_size != M * D || ws_size < WS_END) { fprintf(stderr, "kernel_launch: shape/workspace mismatch (n_in %d, in0 %d, out %d, ws %zu, need %zu); nothing launched\n", n_in, n_in > 0 ? in_sizes[0] : -1, out_size, ws_size, (size_t)WS_END); grid = -1; return; }
        int dev = 0, cus = 0, per_cu = 0;
        if (hipGetDevice(&dev) != hipSuccess || hipDeviceGetAttribute(&cus, hipDeviceAttributeMultiprocessorCount, dev) != hipSuccess) { fprintf(stderr, "kernel_launch: device query failed\n"); grid = -1; return; }
        if (hipFuncSetAttribute((const void*)mk_fwd, hipFuncAttributeMaxDynamicSharedMemorySize, LDS_BYTES) != hipSuccess) { fprintf(stderr, "kernel_launch: hipFuncSetAttribute failed\n"); grid = -1; return; }
        if (hipOccupancyMaxActiveBlocksPerMultiprocessor(&per_cu, (const void*)mk_fwd, NWAVES * 64, LDS_BYTES) != hipSuccess || per_cu < 1) { fprintf(stderr, "kernel_launch: occupancy query says %d blocks per CU\n", per_cu); per_cu = 1; }
        (void)hipGetLastError();
        if (cus * per_cu < NGRP * GW) { fprintf(stderr, "kernel_launch: needs %d co-resident workgroups, the device holds %d; nothing launched\n", NGRP * GW, cus * per_cu); grid = -1; return; }
        grid = NGRP * GW;
    }
    if (grid < 0) return;
    Args a{};
    for (int i = 0; i < 13; ++i) a.in[i] = (const float*)d_in[i];
    a.out = (float*)d_out; a.ws = (unsigned char*)d_ws;
    if (hipMemsetAsync((char*)d_ws + WS_CTL, 0, CTL_ZERO_BYTES, stream) != hipSuccess) { fprintf(stderr, "kernel_launch: hipMemsetAsync failed\n"); return; }
    hipLaunchKernelGGL(mk_fwd, dim3(grid), dim3(NWAVES * 64), LDS_BYTES, stream, a);
    const hipError_t e = hipPeekAtLastError();
    if (e != hipSuccess) fprintf(stderr, "kernel_launch: launch failed: %s (grid %d)\n", hipGetErrorString(e), grid);
}
```

```cpp
#include <hip/hip_runtime.h>
#include <cstdio>
#include <cstdint>
namespace pg8 {
#define PG8_LAS __attribute__((address_space(3)))
typedef unsigned short bf16_t;
typedef short bf16x8 __attribute__((ext_vector_type(8)));
typedef float f32x4 __attribute__((ext_vector_type(4)));
typedef unsigned u32x4 __attribute__((ext_vector_type(4)));
constexpr int BM = 256, BK = 64, HALF = 128, HTB = HALF * BK * 2  , STAGE_BYTES = 8 * HTB, NXCD = 8, WGM = 8;

__host__ __device__ __forceinline__ int lds_byte(int r, int c) { const int st = (r >> 4) * 2 + (c >> 5), rr = r & 15, cc = c & 31, ob = rr * 64 + cc * 2; return st * 1024 + (ob ^ (((ob >> 9) & 1) << 5)); }
__host__ __device__ __forceinline__ void stage_rc(int b, int& R, int& C) { const int st = b / 1024, sb = b % 1024, swz = sb ^ (((sb >> 9) & 1) << 5); R = (st >> 1) * 16 + swz / 64; C = (st & 1) * 32 + (swz % 64) / 2; }
__host__ __device__ __forceinline__ int perm32(int rho) { const int n = rho >> 4, i = rho & 15; return 8 * (i >> 2) + 4 * n + (i & 3); }

struct Unit { int pm, pn; };
struct Gemm { const bf16_t* A; const bf16_t* Bt; int M, N, K; int bdiv; };
__device__ __forceinline__ int btile(const Gemm& g, const Unit& u) { return u.pn + (g.bdiv ? (u.pm / g.bdiv) * (g.N / BM) : 0); }

struct StaticOrder {
    int nM, nN, nwg, G, c, nxcd, wgm;
    __host__ __device__ void init(int M, int N, int G_, int c_, int nxcd_, int wgm_ = WGM) { nM = M / BM; nN = N / BM; nwg = nM * nN; G = G_; c = c_; nxcd = nxcd_; wgm = wgm_; }
    __host__ __device__ bool next(int i, Unit& u) const {
        const long L = (long)i * G + c; if (L >= nwg) return false;
        int wgid = (int)L; { const int q = nwg / nxcd, r = nwg % nxcd, xcd = wgid % nxcd, off = wgid / nxcd; wgid = (xcd < r ? xcd * (q + 1) : r * (q + 1) + (xcd - r) * q) + off; }
        const int nig = wgm * nN, gid = wgid / nig, fm = gid * wgm, gsz = (nM - fm) < wgm ? (nM - fm) : wgm;
        u.pm = fm + ((wgid % nig) % gsz); u.pn = (wgid % nig) / gsz; return true;
    }
    __device__ __forceinline__ void a_ready(const Unit&) const {}
    __device__ __forceinline__ void done(const Unit&) const {}
};

__device__ __forceinline__ unsigned cvt_pk_bf16(float lo, float hi) { unsigned r; asm volatile("v_cvt_pk_bf16_f32 %0, %1, %2" : "=v"(r) : "v"(lo), "v"(hi)); return r; }

struct EpiBf16 {
    static constexpr bool PERM = true, AFTER_DRAIN = false;
    bf16_t* O; int ldc;
    __device__ __forceinline__ void operator()(const f32x4 (&acc)[2][2][4][2], const Unit& u, int wr, int wc, int fr, int fq) const {
        const int row0 = u.pm * BM + wr * 64 + fr; const int col0 = u.pn * BM + wc * 32 + 8 * fq;
#pragma unroll
        for (int ai = 0; ai < 2; ++ai)
#pragma unroll
            for (int m = 0; m < 4; ++m) { bf16_t* rowp = O + (size_t)(row0 + ai * HALF + m * 16) * ldc + col0;
#pragma unroll
                for (int bj = 0; bj < 2; ++bj) { const f32x4 v0 = acc[ai][bj][m][0], v1 = acc[ai][bj][m][1];
                    u32x4 w; w.x = cvt_pk_bf16(v0[0], v0[1]); w.y = cvt_pk_bf16(v0[2], v0[3]); w.z = cvt_pk_bf16(v1[0], v1[1]); w.w = cvt_pk_bf16(v1[2], v1[3]);
                    __builtin_nontemporal_store(w, (u32x4*)(rowp + bj * HALF)); } }
    }
};

__device__ __forceinline__ float silu_mul(float g, float u) { const float e = __builtin_amdgcn_exp2f(g * -1.4426950408889634f); return g * __builtin_amdgcn_rcpf(1.0f + e) * u; }
struct EpiSwiGLU {
    static constexpr bool PERM = true, AFTER_DRAIN = false;
    bf16_t* O; int ldc;
    __device__ __forceinline__ void operator()(const f32x4 (&acc)[2][2][4][2], const Unit& u, int wr, int wc, int fr, int fq) const {
        const int row0 = u.pm * BM + wr * 64 + fr; const int col0 = u.pn * HALF + wc * 32 + 8 * fq;
#pragma unroll
        for (int ai = 0; ai < 2; ++ai)
#pragma unroll
            for (int m = 0; m < 4; ++m) { bf16_t* rowp = O + (size_t)(row0 + ai * HALF + m * 16) * ldc + col0;
                const f32x4 g0 = acc[ai][0][m][0], g1 = acc[ai][0][m][1], u0 = acc[ai][1][m][0], u1 = acc[ai][1][m][1];
                u32x4 w; w.x = cvt_pk_bf16(silu_mul(g0[0], u0[0]), silu_mul(g0[1], u0[1])); w.y = cvt_pk_bf16(silu_mul(g0[2], u0[2]), silu_mul(g0[3], u0[3]));
                w.z = cvt_pk_bf16(silu_mul(g1[0], u1[0]), silu_mul(g1[1], u1[1])); w.w = cvt_pk_bf16(silu_mul(g1[2], u1[2]), silu_mul(g1[3], u1[3]));
                __builtin_nontemporal_store(w, (u32x4*)rowp); }
    }
};

struct EpiBf16Stat {
    static constexpr bool PERM = true, AFTER_DRAIN = false;
    bf16_t* O; int ldc; float* part;
    __device__ __forceinline__ void operator()(const f32x4 (&acc)[2][2][4][2], const Unit& u, int wr, int wc, int fr, int fq) const {
        const int col0 = u.pn * BM + wc * 32 + 8 * fq;
#pragma unroll
        for (int ai = 0; ai < 2; ++ai)
#pragma unroll
            for (int m = 0; m < 4; ++m) { const int r = u.pm * BM + ai * HALF + wr * 64 + m * 16 + fr; bf16_t* rowp = O + (size_t)r * ldc + col0; float s = 0.f;
#pragma unroll
                for (int bj = 0; bj < 2; ++bj) { const f32x4 v0 = acc[ai][bj][m][0], v1 = acc[ai][bj][m][1];
                    s += ((v0[0] * v0[0] + v0[1] * v0[1]) + (v0[2] * v0[2] + v0[3] * v0[3])) + ((v1[0] * v1[0] + v1[1] * v1[1]) + (v1[2] * v1[2] + v1[3] * v1[3]));
                    u32x4 w; w.x = cvt_pk_bf16(v0[0], v0[1]); w.y = cvt_pk_bf16(v0[2], v0[3]); w.z = cvt_pk_bf16(v1[0], v1[1]); w.w = cvt_pk_bf16(v1[2], v1[3]);
                    *(u32x4*)(rowp + bj * HALF) = w; }
                s += __shfl_xor(s, 16); s += __shfl_xor(s, 32);
                if (fq == 0) part[(size_t)r * 32 + u.pn * 4 + wc] = s; }
    }
};

struct EpiPool {
    static constexpr bool PERM = true, AFTER_DRAIN = true;
    bf16_t* O; int ldc; const float* scale; PG8_LAS float* scr; float eps; int sh;
    __device__ __forceinline__ void fused(const f32x4 (&acc)[2][2][4][2], const Unit& u, int wr, int wc, int fr, int fq, PG8_LAS unsigned char*, int, int) const {
        const int grp = u.pm >> sh, rb = u.pm & ((1 << sh) - 1);
#pragma unroll
        for (int ai = 0; ai < 2; ++ai)
#pragma unroll
            for (int m = 0; m < 4; ++m) { float s = 0.f;
#pragma unroll
                for (int bj = 0; bj < 2; ++bj)
#pragma unroll
                    for (int n = 0; n < 2; ++n) { const f32x4 v = acc[ai][bj][m][n]; s += (v[0] * v[0] + v[1] * v[1]) + (v[2] * v[2] + v[3] * v[3]); }
                s += __shfl_xor(s, 16); s += __shfl_xor(s, 32);
                if (fq == 0) scr[(ai * HALF + wr * 64 + m * 16 + fr) * 4 + wc] = s;
                asm volatile("" ::: "memory"); }
        asm volatile("s_waitcnt lgkmcnt(0)" ::: "memory"); __builtin_amdgcn_s_barrier(); asm volatile("" ::: "memory");
        const int gc0 = grp * BM + wc * 32 + 8 * fq;
#pragma unroll
        for (int ai = 0; ai < 2; ++ai)
#pragma unroll
            for (int m = 0; m < 4; ++m) { const int rl = ai * HALF + wr * 64 + m * 16 + fr; const f32x4 p = *(const PG8_LAS f32x4*)(scr + rl * 4);
                const float rstd = __builtin_amdgcn_rsqf(((p[0] + p[1]) + (p[2] + p[3])) * (1.0f / 256.0f) + eps);
                bf16_t* rowp = O + (size_t)(rb * BM + rl) * ldc + 1024 + gc0;
#pragma unroll
                for (int bj = 0; bj < 2; ++bj) { const f32x4 s0 = *(const f32x4*)(scale + gc0 + bj * HALF), s1 = *(const f32x4*)(scale + gc0 + bj * HALF + 4);
                    const f32x4 v0 = acc[ai][bj][m][0] * rstd * s0, v1 = acc[ai][bj][m][1] * rstd * s1;
                    u32x4 w; w.x = cvt_pk_bf16(v0[0], v0[1]); w.y = cvt_pk_bf16(v0[2], v0[3]); w.z = cvt_pk_bf16(v1[0], v1[1]); w.w = cvt_pk_bf16(v1[2], v1[3]);
                    *(u32x4*)(rowp + bj * HALF) = w; }
                asm volatile("" ::: "memory"); }
        asm volatile("s_waitcnt lgkmcnt(0)" ::: "memory"); __builtin_amdgcn_s_barrier(); asm volatile("" ::: "memory");
    }
};

template <class Epi, class Sched, bool ALIGN_EPI = false, bool SP2 = false>
__device__ __forceinline__ void gemm_phase(PG8_LAS unsigned char* lds, const Gemm g, const Sched& S, const Epi& E) {
    const int tid = threadIdx.x, wid = __builtin_amdgcn_readfirstlane(tid >> 6), lane = tid & 63, wr = wid >> 2, wc = wid & 3, fr = lane & 15, fq = lane >> 4;
    const int K = g.K, nt = K / BK;
    unsigned voffA[2], voffB[2];
#pragma unroll
    for (int i = 0; i < 2; ++i) { int R, C; stage_rc(tid * 16 + i * 8192, R, C); const int Rb = Epi::PERM ? ((R & ~31) + perm32(R & 31)) : R;
        voffA[i] = (unsigned)(R * K + C) * 2u; voffB[i] = (unsigned)(Rb * K + C) * 2u; }
    const size_t kstep = (size_t)(BK * 2);
    const size_t hstep = (size_t)HALF * K * 2;
    const size_t tstep = 2 * hstep;
    const unsigned ldsw = (unsigned)wid * 1024u;
    const int aoff = lds_byte(wr * 64 + fr, fq * 8), boff = lds_byte(wc * 32 + fr, fq * 8);
#define PG8_SA(b, h) (((b) * 2 + (h)) * HTB)
#define PG8_SB(b, h) ((4 + (b) * 2 + (h)) * HTB)
#define PG8_STAGE(bufoff, gbase, voff) do { _Pragma("unroll") for (int _i = 0; _i < 2; ++_i) \
        __builtin_amdgcn_global_load_lds((const unsigned*)((const char*)(gbase) + (voff)[_i]), (PG8_LAS unsigned*)(lds + (bufoff) + ldsw + _i * 8192), 16, 0, 0); } while (0)
#define PG8_LDA(dst, b, h) do { _Pragma("unroll") for (int m = 0; m < 4; ++m) _Pragma("unroll") for (int k = 0; k < 2; ++k) dst[m][k] = *(const PG8_LAS bf16x8*)(lds + PG8_SA(b, h) + aoff + m * 2048 + k * 1024); } while (0)
#define PG8_LDB(dst, b, h) do { _Pragma("unroll") for (int n = 0; n < 2; ++n) _Pragma("unroll") for (int k = 0; k < 2; ++k) dst[n][k] = *(const PG8_LAS bf16x8*)(lds + PG8_SB(b, h) + boff + n * 2048 + k * 1024); } while (0)
#define PG8_MMA(ai, bj, At, Bt) do { __builtin_amdgcn_s_setprio(1); _Pragma("unroll") for (int m = 0; m < 4; ++m) _Pragma("unroll") for (int n = 0; n < 2; ++n) _Pragma("unroll") for (int k = 0; k < 2; ++k) \
        acc[ai][bj][m][n] = __builtin_amdgcn_mfma_f32_16x16x32_bf16(Bt[n][k], At[m][k], acc[ai][bj][m][n], 0, 0, 0); __builtin_amdgcn_s_setprio(0); } while (0)
#define PG8_WAIT_V(n) asm volatile("s_waitcnt vmcnt(" #n ")" ::: "memory")
#define PG8_WAIT_L(n) asm volatile("s_waitcnt lgkmcnt(" #n ")" ::: "memory")
#define PG8_BAR __builtin_amdgcn_s_barrier()
#define PG8_SCHED __builtin_amdgcn_sched_barrier(0)
    Unit cur, nxt; int ui = 0;
    if (!S.next(0, cur)) return;
    f32x4 acc[2][2][4][2];
#pragma unroll
    for (int a = 0; a < 2; ++a)
#pragma unroll
        for (int b = 0; b < 2; ++b)
#pragma unroll
            for (int m = 0; m < 4; ++m)
#pragma unroll
                for (int n = 0; n < 2; ++n) acc[a][b][m][n] = (f32x4){0.f, 0.f, 0.f, 0.f};
    bf16x8 At[4][2], B0[2][2], B1[2][2];
    const char* cA = (const char*)g.A + (size_t)cur.pm * tstep; const char* cB = (const char*)g.Bt + (size_t)btile(g, cur) * tstep;
    S.a_ready(cur);
    if constexpr (SP2) {
        PG8_STAGE(PG8_SB(0, 0), cB, voffB); PG8_STAGE(PG8_SB(0, 1), cB + hstep, voffB); PG8_STAGE(PG8_SA(0, 0), cA, voffA); PG8_STAGE(PG8_SA(0, 1), cA + hstep, voffA);
        if (wr == 1) PG8_BAR;
        PG8_WAIT_V(2); PG8_BAR;
        PG8_STAGE(PG8_SB(1, 0), cB + kstep, voffB); PG8_STAGE(PG8_SA(1, 0), cA + kstep, voffA); PG8_STAGE(PG8_SB(1, 1), cB + hstep + kstep, voffB);
        PG8_WAIT_V(6); PG8_BAR;
    } else {
        PG8_STAGE(PG8_SB(0, 0), cB, voffB); PG8_STAGE(PG8_SA(0, 0), cA, voffA); PG8_STAGE(PG8_SB(0, 1), cB + hstep, voffB); PG8_STAGE(PG8_SA(0, 1), cA + hstep, voffA);
        if (wr == 1) PG8_BAR;
        PG8_WAIT_V(4); PG8_BAR;
        PG8_STAGE(PG8_SB(1, 0), cB + kstep, voffB); PG8_STAGE(PG8_SA(1, 0), cA + kstep, voffA); PG8_STAGE(PG8_SB(1, 1), cB + hstep + kstep, voffB);
        PG8_WAIT_V(6); PG8_BAR;
    }
    for (;;) {
        const bool has_next = S.next(ui + 1, nxt);
        const char* nA = has_next ? (const char*)g.A + (size_t)nxt.pm * tstep : cA; const char* nB = has_next ? (const char*)g.Bt + (size_t)btile(g, nxt) * tstep : cB;
        for (int t = 0; t < nt; t += 2) {
            const bool last = (t == nt - 2);
            const char* a1 = cA + (size_t)(t + 1) * kstep;
            const char* a2 = last ? nA : cA + (size_t)(t + 2) * kstep; const char* b2 = last ? nB : cB + (size_t)(t + 2) * kstep;
            const char* a3 = a2 + kstep; const char* b3 = b2 + kstep;
            if (last && has_next) S.a_ready(nxt);
            if constexpr (SP2) {
            PG8_LDB(B0, 0, 0); PG8_LDB(B1, 0, 1); PG8_SCHED; PG8_LDA(At, 0, 0); PG8_STAGE(PG8_SA(1, 1), a1 + hstep, voffA);
            PG8_WAIT_V(8); PG8_WAIT_L(0); PG8_BAR; PG8_MMA(0, 0, At, B0); PG8_MMA(0, 1, At, B1); PG8_BAR; PG8_SCHED;
            PG8_LDA(At, 0, 1); PG8_STAGE(PG8_SB(0, 0), b2, voffB); PG8_STAGE(PG8_SB(0, 1), b2 + hstep, voffB); PG8_STAGE(PG8_SA(0, 0), a2, voffA);
            PG8_WAIT_V(8); PG8_WAIT_L(0); PG8_BAR; PG8_MMA(1, 0, At, B0); PG8_MMA(1, 1, At, B1); PG8_BAR; PG8_SCHED;
            PG8_LDB(B0, 1, 0); PG8_LDB(B1, 1, 1); PG8_SCHED; PG8_LDA(At, 1, 0); PG8_STAGE(PG8_SA(0, 1), a2 + hstep, voffA);
            PG8_WAIT_V(8); PG8_WAIT_L(0); PG8_BAR; PG8_MMA(0, 0, At, B0); PG8_MMA(0, 1, At, B1); PG8_BAR; PG8_SCHED;
            PG8_LDA(At, 1, 1); PG8_STAGE(PG8_SB(1, 0), b3, voffB); PG8_STAGE(PG8_SB(1, 1), b3 + hstep, voffB); PG8_STAGE(PG8_SA(1, 0), a3, voffA);
            PG8_WAIT_V(8); PG8_WAIT_L(0); PG8_BAR; PG8_MMA(1, 0, At, B0); PG8_MMA(1, 1, At, B1); PG8_BAR; PG8_SCHED;
            } else {
            PG8_LDB(B0, 0, 0); PG8_SCHED; PG8_LDA(At, 0, 0); PG8_STAGE(PG8_SA(1, 1), a1 + hstep, voffA);
            PG8_WAIT_L(8); PG8_BAR; PG8_WAIT_L(0); PG8_MMA(0, 0, At, B0); PG8_BAR; PG8_SCHED;
            PG8_LDB(B1, 0, 1); PG8_STAGE(PG8_SB(0, 0), b2, voffB);
            PG8_BAR; PG8_WAIT_L(0); PG8_MMA(0, 1, At, B1); PG8_BAR;
            PG8_LDA(At, 0, 1); PG8_STAGE(PG8_SA(0, 0), a2, voffA);
            PG8_BAR; PG8_WAIT_L(0); PG8_MMA(1, 0, At, B0); PG8_BAR; PG8_SCHED;
            PG8_STAGE(PG8_SB(0, 1), b2 + hstep, voffB);
            PG8_WAIT_V(6); PG8_BAR; PG8_MMA(1, 1, At, B1); PG8_BAR;
            PG8_LDB(B0, 1, 0); PG8_SCHED; PG8_LDA(At, 1, 0); PG8_STAGE(PG8_SA(0, 1), a2 + hstep, voffA);
            PG8_WAIT_L(8); PG8_BAR; PG8_WAIT_L(0); PG8_MMA(0, 0, At, B0); PG8_BAR; PG8_SCHED;
            PG8_LDB(B1, 1, 1); PG8_STAGE(PG8_SB(1, 0), b3, voffB);
            PG8_BAR; PG8_WAIT_L(0); PG8_MMA(0, 1, At, B1); PG8_BAR;
            PG8_LDA(At, 1, 1); PG8_STAGE(PG8_SA(1, 0), a3, voffA);
            PG8_BAR; PG8_WAIT_L(0); PG8_MMA(1, 0, At, B0); PG8_BAR; PG8_SCHED;
            PG8_STAGE(PG8_SB(1, 1), b3 + hstep, voffB);
            PG8_WAIT_V(6); PG8_BAR; PG8_MMA(1, 1, At, B1); PG8_BAR;
            }
        }
        if constexpr (ALIGN_EPI) { if (wr == 0) PG8_BAR; }
        if constexpr (!Epi::AFTER_DRAIN) { E(acc, cur, wr, wc, fr, fq); S.done(cur); }
        if (!has_next) break;
#pragma unroll
        for (int a = 0; a < 2; ++a)
#pragma unroll
            for (int b = 0; b < 2; ++b)
#pragma unroll
                for (int m = 0; m < 4; ++m)
#pragma unroll
                    for (int n = 0; n < 2; ++n) acc[a][b][m][n] = (f32x4){0.f, 0.f, 0.f, 0.f};
        cur = nxt; cA = nA; cB = nB; ++ui;
        if constexpr (ALIGN_EPI) { if (wr == 1) PG8_BAR; }
    }
    PG8_WAIT_V(0);
    if constexpr (!ALIGN_EPI) { if (wr == 0) PG8_BAR; }
    PG8_BAR;
    if constexpr (Epi::AFTER_DRAIN) { E.fused(acc, cur, wr, wc, fr, fq, lds, wid, lane); S.done(cur); }
#undef PG8_SA
#undef PG8_SB
#undef PG8_STAGE
#undef PG8_LDA
#undef PG8_LDB
#undef PG8_MMA
#undef PG8_WAIT_V
#undef PG8_WAIT_L
#undef PG8_BAR
#undef PG8_SCHED
}
}

constexpr int NWAVES = 8;
constexpr int BATCH = 2, SEQ = 8192, D = 2048, CW = 1024, PW = 1024, NPROJ = 4096, FF = 5632;
constexpr int M = BATCH * SEQ;
constexpr float EPS = 1e-6f;
constexpr int NGRP = 2, GW = 128, MG = SEQ;

constexpr size_t MiB = 1u << 20;
constexpr size_t WS_CTL = 0, CTL_ZERO_BYTES = 49152;
constexpr int CW_P4 = 9600;
constexpr int CW_SLAB = 8448;
constexpr int CW_FLAG = 8192 - 128;
constexpr size_t WS_PART1 = 1 * MiB, WS_PART2 = 3 * MiB;
constexpr size_t WS_WD = 5 * MiB;
constexpr size_t WS_WIN = 27 * MiB;
constexpr size_t WS_WOUT = 43 * MiB;
constexpr size_t WS_WGU = 51 * MiB;
constexpr size_t WS_WPOOL = 95 * MiB;
constexpr size_t WS_H = 96 * MiB;
constexpr size_t WS_MIXOUT = 160 * MiB;
constexpr size_t WS_BLK = 224 * MiB, BLK_STRIDE = 120 * MiB;
#define WS_PROJ   (WS_BLK + (size_t)F.grp * BLK_STRIDE - (size_t)F.row0 * NPROJ * 2)
#define WS_POOLED (WS_BLK + (size_t)F.grp * BLK_STRIDE + 64 * MiB - (size_t)F.grp * 4 * MG * 256 * 2)
#define WS_MIXED  (WS_BLK + (size_t)F.grp * BLK_STRIDE + 80 * MiB - (size_t)F.row0 * D * 2)
#define WS_ACT    (WS_BLK + (size_t)F.grp * BLK_STRIDE - (size_t)F.row0 * FF * 2)
#define WS_FF     (WS_BLK + (size_t)F.grp * BLK_STRIDE + 88 * MiB - (size_t)F.row0 * D * 2)
constexpr size_t WS_END = WS_BLK + 2 * BLK_STRIDE;
static_assert(WS_WD + (size_t)D * FF * 2 <= WS_WIN && WS_WPOOL + 4 * 65536 * 2 <= WS_H && WS_H + (size_t)M * D * 2 <= WS_MIXOUT && WS_MIXOUT + (size_t)M * D * 2 <= WS_BLK
              && (size_t)MG * FF * 2 <= 88 * MiB && (size_t)MG * NPROJ * 2 <= 64 * MiB && 88 * MiB + (size_t)MG * D * 2 <= BLK_STRIDE && BLK_STRIDE <= WS_BLK, "d_ws map");

constexpr int RING_BYTES = 131072, EPI_SCR_OFF = RING_BYTES, MISC_OFF = RING_BYTES + 4096, LDS_BYTES = 147456;

#define GAS __attribute__((address_space(1)))
#define LAS __attribute__((address_space(3)))
typedef unsigned short bf16;
typedef unsigned v4u __attribute__((ext_vector_type(4)));
typedef unsigned v2u __attribute__((ext_vector_type(2)));
typedef float f32x4 __attribute__((ext_vector_type(4)));
#define LDS_WAIT() asm volatile("s_waitcnt lgkmcnt(0)" ::: "memory")
__device__ __forceinline__ unsigned f2bf(float f) { unsigned u = __builtin_bit_cast(unsigned, f); return (u + 0x7fffu + ((u >> 16) & 1u)) >> 16; }
__device__ __forceinline__ unsigned pk2(float lo, float hi) { return f2bf(lo) | (f2bf(hi) << 16); }
__device__ __forceinline__ float bflo(unsigned w) { return __builtin_bit_cast(float, w << 16); }
__device__ __forceinline__ float bfhi(unsigned w) { return __builtin_bit_cast(float, w & 0xffff0000u); }
__device__ __forceinline__ float wave_sum(float v) {
#pragma unroll
    for (int o = 1; o < 64; o <<= 1) v += __shfl_xor(v, o);
    return v;
}

typedef GAS unsigned gu32;
#define RLX_AGENT __ATOMIC_RELAXED, __HIP_MEMORY_SCOPE_AGENT
#define XB_TMO      128
#define XB_XCNT(j)  (256  + 64 * (j))
#define XB_XSUB(j)  (1280 + 64 * (j))
#define XB_XGEN(j)  (2304 + 64 * (j))
#define XB_TOP      3328
#define XB_TOPGEN   3392
#define XCD_BAR_WORDS 3456
#define XB_SPIN_CAP (1u << 18)

__device__ __forceinline__ unsigned xb_ld(unsigned* p)              { return __hip_atomic_load(p, __ATOMIC_RELAXED, __HIP_MEMORY_SCOPE_AGENT); }
__device__ __forceinline__ unsigned xb_add(unsigned* p, unsigned v) { return __hip_atomic_fetch_add(p, v, __ATOMIC_RELAXED, __HIP_MEMORY_SCOPE_AGENT); }
__device__ __forceinline__ unsigned xb_xcc_id() { return (unsigned)__builtin_amdgcn_s_getreg((3 << 11) | 20) & 0xFu; }
#define XB_SPIN(cond, bar) do { unsigned _sp = 0; while (cond) { __builtin_amdgcn_s_sleep(1); \
    if ((++_sp & 255u) == 0u) { if (xb_ld(&(bar)[XB_TMO])) break; if (_sp > XB_SPIN_CAP) { atomicAdd(&(bar)[XB_TMO], 1u); break; } } } } while (0)

struct XcdBarrier {
    unsigned* bar; unsigned x; unsigned G;
    volatile LAS unsigned* st;
};

__device__ __forceinline__ XcdBarrier xcd_barrier_post(unsigned* bar, volatile LAS unsigned* st, unsigned G) {
    XcdBarrier b; b.bar = bar; b.x = xb_xcc_id(); b.st = st; b.G = G;
    if (threadIdx.x == 0) (void)xb_add(&bar[XB_XCNT(b.x)], 1u);
    return b;
}
__device__ __forceinline__ void xcd_barrier_complete(unsigned* bar, unsigned x, unsigned G, unsigned& nloc, unsigned& nx) {
    unsigned sum, cnt, mine, sp = 0u;
    for (;;) {
        sum = 0u; cnt = 0u; mine = 0u;
#pragma unroll
        for (unsigned j = 0; j < 16; ++j) { const unsigned c = xb_ld(&bar[XB_XCNT(j)]); sum += c; cnt += (c > 0u) ? 1u : 0u; mine = (j == x) ? c : mine; }
        if (sum == G) break;
        __builtin_amdgcn_s_sleep(1);
        if ((++sp & 255u) == 0u) { if (xb_ld(&bar[XB_TMO])) break; if (sp > XB_SPIN_CAP) { atomicAdd(&bar[XB_TMO], 1u); break; } }
    }
    nloc = mine > 0u ? mine : 1u; nx = cnt > 0u ? cnt : 1u;
}

__device__ __forceinline__ void xcd_barrier(const XcdBarrier& b) {
    asm volatile("s_waitcnt vmcnt(0)" ::: "memory");
    __syncthreads();
    if (threadIdx.x == 0) {
        unsigned* bar = b.bar;
        __builtin_amdgcn_s_waitcnt(0);
        unsigned nloc = b.st[0], nx = b.st[1];
        if (nloc == 0u) { xcd_barrier_complete(bar, b.x, b.G, nloc, nx); b.st[0] = nloc; b.st[1] = nx; }
        const unsigned old = xb_add(&bar[XB_XSUB(b.x)], 1u);
        const unsigned gen = old / nloc;
        if (old + 1u == (gen + 1u) * nloc) {
            __builtin_amdgcn_fence(__ATOMIC_RELEASE, "agent");
            asm volatile("s_waitcnt vmcnt(0)" ::: "memory");
            const unsigned og = xb_add(&bar[XB_TOP], 1u);
            const unsigned tg = og / nx;
            if (og + 1u == (tg + 1u) * nx) xb_add(&bar[XB_TOPGEN], 1u);
            else XB_SPIN(xb_ld(&bar[XB_TOPGEN]) == tg, bar);
            __builtin_amdgcn_fence(__ATOMIC_ACQUIRE, "agent");
            xb_add(&bar[XB_XGEN(b.x)], 1u);
            asm volatile("s_waitcnt vmcnt(0)" ::: "memory");
        } else {
            XB_SPIN(xb_ld(&bar[XB_XGEN(b.x)]) == gen, bar);
            __builtin_amdgcn_fence(__ATOMIC_ACQUIRE, "agent");
            asm volatile("s_waitcnt vmcnt(0)" ::: "memory");
        }
    }
    __syncthreads();
}

struct Frame {
    LAS unsigned char* lds;
    int tid, lane, wave;
    int grp, c, row0, sw;
    const float *x, *g_pre, *w_in, *conv_w, *pool_w, *pool_scale, *w_out, *g_post, *g_fpre, *w_gate, *w_up, *w_down, *g_fpost;
    float* out; unsigned char* ws;
};

__device__ __forceinline__ int opq(int v) { asm volatile("" : "+v"(v)); return v; }
__device__ __forceinline__ unsigned pkbf(float lo, float hi) { return pg8::cvt_pk_bf16(lo, hi); }
constexpr int TSCR_BYTES = 64 * 65 * 4;
struct TItem { const float* W; bf16* WT; int K, N, drow0, k0, n0; };
__device__ __forceinline__ TItem titem(const float* W, int K, int N, bf16* WT, int mode, int item) {
    TItem t; t.W = W; t.WT = WT; t.K = K; t.N = N;
    const int nblk = N / 64, kb = item / nblk, nb = item % nblk; t.k0 = 64 * kb; t.n0 = 64 * nb;
    t.drow0 = mode == 0 ? t.n0 : ((t.n0 >> 7) * 256 + (t.n0 & 127) + (mode == 2 ? 128 : 0));
    return t;
}
__device__ __forceinline__ void titem_load(const TItem& t, f32x4 (&r)[16], int lane) {
    const GAS f32x4* src = (const GAS f32x4*)(t.W + (size_t)(t.k0 + (lane >> 4)) * t.N + t.n0 + 4 * (lane & 15));
#pragma unroll
    for (int i = 0; i < 16; ++i) r[i] = __builtin_nontemporal_load(src + (size_t)i * t.N);
}
template <bool NTS>
__device__ __forceinline__ void titem_store(const TItem& t, const f32x4 (&r)[16], LAS float* scr, int lane) {
#pragma unroll
    for (int i = 0; i < 16; ++i) { LAS float* d = scr + (4 * i + (lane >> 4)) * 65 + 4 * (lane & 15); d[0] = r[i].x; d[1] = r[i].y; d[2] = r[i].z; d[3] = r[i].w; }
    LDS_WAIT(); asm volatile("" ::: "memory");
    const int c = lane & 7;
#pragma unroll
    for (int j = 0; j < 8; ++j) { const int n = (lane >> 3) + 8 * j; const LAS float* s = scr + (8 * c) * 65 + n;
        v4u o; o.x = pkbf(s[0 * 65], s[1 * 65]); o.y = pkbf(s[2 * 65], s[3 * 65]); o.z = pkbf(s[4 * 65], s[5 * 65]); o.w = pkbf(s[6 * 65], s[7 * 65]);
        if (NTS) __builtin_nontemporal_store(o, (GAS v4u*)(t.WT + (size_t)(t.drow0 + n) * t.K + t.k0 + 8 * c)); else *(GAS v4u*)(t.WT + (size_t)(t.drow0 + n) * t.K + t.k0 + 8 * c) = o; }
    LDS_WAIT(); asm volatile("" ::: "memory");
}
__device__ __forceinline__ TItem win_item(Frame& F, int r) {
    constexpr int I_IN = (D / 64) * (NPROJ / 64), I_OUT = (D / 64) * (D / 64), I_P1 = (256 / 64) * (256 / 64);
    if (r < I_IN) return titem(F.w_in, D, NPROJ, (bf16*)(F.ws + WS_WIN), 0, r);
    r -= I_IN;
    if (r < I_OUT) return titem(F.w_out, D, D, (bf16*)(F.ws + WS_WOUT), 0, r);
    r -= I_OUT;
    const int g = r / I_P1; return titem(F.pool_w + (size_t)g * 65536, 256, 256, (bf16*)(F.ws + WS_WPOOL) + (size_t)g * 65536, 0, r % I_P1);
}
__device__ __forceinline__ TItem wrest_item(Frame& F, int r) {
    constexpr int I_G = (D / 64) * (FF / 64);
    if (r < I_G) return titem(F.w_gate, D, FF, (bf16*)(F.ws + WS_WGU), 1, r);
    r -= I_G;
    if (r < I_G) return titem(F.w_up, D, FF, (bf16*)(F.ws + WS_WGU), 2, r);
    r -= I_G;
    return titem(F.w_down, FF, D, (bf16*)(F.ws + WS_WD), 0, r);
}
template <bool REST>
__device__ __forceinline__ void p0_weights(Frame& F) {
    LAS float* scr = (LAS float*)(F.lds + F.wave * TSCR_BYTES);
    const int gw = F.c * NWAVES + F.wave, NGW = GW * NWAVES;
    constexpr int NITEMS = REST ? 2 * (D / 64) * (FF / 64) + (FF / 64) * (D / 64) : (D / 64) * (NPROJ / 64) + (D / 64) * (D / 64) + 4 * 16;
    int it = gw; if (it >= NITEMS) return;
    TItem cur = REST ? wrest_item(F, it) : win_item(F, it); f32x4 rc[16]; titem_load(cur, rc, F.lane);
#pragma unroll 1
    for (;;) {
        const int itn = it + NGW; const bool has = itn < NITEMS;
        TItem nxt = cur; f32x4 rn[16];
        if (has) { nxt = REST ? wrest_item(F, itn) : win_item(F, itn); titem_load(nxt, rn, F.lane); }
        titem_store<REST>(cur, rc, scr, F.lane);
        if (!has) break;
        cur = nxt; it = itn;
#pragma unroll
        for (int i = 0; i < 16; ++i) rc[i] = rn[i];
    }
}
__device__ __forceinline__ void p0_hrows(Frame& F) {
    const int gw = F.c * NWAVES + F.wave, NGW = GW * NWAVES;
    f32x4 gv[8];
#pragma unroll
    for (int j = 0; j < 8; ++j) gv[j] = ((const GAS f32x4*)F.g_pre)[F.lane + 64 * j];
    bf16* H = (bf16*)(F.ws + WS_H);
    for (int blk = gw; blk < MG / 8; blk += NGW) {
        const int m0 = F.row0 + 8 * blk;
        f32x4 v[2][8], w[2][8];
#pragma unroll
        for (int q = 0; q < 2; ++q) { const GAS f32x4* xr = (const GAS f32x4*)(F.x + (size_t)(m0 + q) * D) + F.lane;
#pragma unroll
            for (int j = 0; j < 8; ++j) v[q][j] = __builtin_nontemporal_load(xr + 64 * j); }
#pragma unroll 1
        for (int pr = 0; pr < 4; ++pr) {
            if (pr < 3) {
#pragma unroll
                for (int q = 0; q < 2; ++q) { const GAS f32x4* xr = (const GAS f32x4*)(F.x + (size_t)(m0 + 2 * pr + 2 + q) * D) + F.lane;
#pragma unroll
                    for (int j = 0; j < 8; ++j) w[q][j] = __builtin_nontemporal_load(xr + 64 * j); } }
#pragma unroll
            for (int q = 0; q < 2; ++q) { float s = 0.f;
#pragma unroll
                for (int j = 0; j < 8; ++j) s += (v[q][j].x * v[q][j].x + v[q][j].y * v[q][j].y) + (v[q][j].z * v[q][j].z + v[q][j].w * v[q][j].w);
                const float rstd = 1.0f / sqrtf(wave_sum(s) * (1.0f / D) + EPS);
                GAS v2u* o8 = (GAS v2u*)(H + (size_t)(m0 + 2 * pr + q) * D) + F.lane;
#pragma unroll
                for (int j = 0; j < 8; ++j) { const f32x4 y = v[q][j] * rstd * gv[j]; v2u o; o.x = pkbf(y.x, y.y); o.y = pkbf(y.z, y.w); o8[64 * j] = o; } }
            if (pr < 3) {
#pragma unroll
                for (int q = 0; q < 2; ++q)
#pragma unroll
                    for (int j = 0; j < 8; ++j) v[q][j] = w[q][j]; }
        }
    }
}

__device__ __forceinline__ void up8(const v4u w, float (&f)[8]) { f[0] = bflo(w.x); f[1] = bfhi(w.x); f[2] = bflo(w.y); f[3] = bfhi(w.y); f[4] = bflo(w.z); f[5] = bfhi(w.z); f[6] = bflo(w.w); f[7] = bfhi(w.w); }
__device__ __forceinline__ v4u pk8(const float (&f)[8]) { v4u o; o.x = pkbf(f[0], f[1]); o.y = pkbf(f[2], f[3]); o.z = pkbf(f[4], f[5]); o.w = pkbf(f[6], f[7]); return o; }
__device__ __forceinline__ v4u ldg16(const bf16* p) { return __builtin_nontemporal_load((const GAS v4u*)p); }
__device__ __forceinline__ void conv_pass(Frame& F, int p, int t0, int m0) {
    const int l = opq(F.lane), cb = 512 * p + 8 * l;
    const bf16* P = (const bf16*)(F.ws + WS_PROJ) + cb; bf16* MIX = (bf16*)(F.ws + WS_MIXED) + cb;
    const v4u z = {0u, 0u, 0u, 0u};
    v4u hc[2], hu[2];
#pragma unroll
    for (int j = 0; j < 2; ++j) { hc[j] = z; hu[j] = z; }
    if (t0 > 0) {
#pragma unroll
        for (int j = 0; j < 2; ++j) { hc[j] = ldg16(P + (size_t)(m0 - 1 - j) * NPROJ + CW); hu[j] = ldg16(P + (size_t)(m0 - 1 - j) * NPROJ + 2 * CW); } }
    float w0[8], w1[8], w2[8];
#pragma unroll
    for (int i = 0; i < 8; ++i) { w0[i] = F.conv_w[0 * CW + cb + i]; w1[i] = F.conv_w[1 * CW + cb + i]; w2[i] = F.conv_w[2 * CW + cb + i]; }
    float cu1[8], cu2[8];
#pragma unroll 1
    for (int h = 0; h < 2; ++h) {
        v4u rb[4], rc[4], ru[4];
        const bf16* row = P + (size_t)(m0 + 4 * h) * NPROJ;
#pragma unroll
        for (int r = 0; r < 4; ++r) { rb[r] = ldg16(row + (size_t)r * NPROJ); rc[r] = ldg16(row + (size_t)r * NPROJ + CW); ru[r] = ldg16(row + (size_t)r * NPROJ + 2 * CW); }
        if (h == 0) { float c[8], u[8]; up8(hc[0], c); up8(hu[0], u);
#pragma unroll
            for (int i = 0; i < 8; ++i) cu1[i] = c[i] * u[i];
            up8(hc[1], c); up8(hu[1], u);
#pragma unroll
            for (int i = 0; i < 8; ++i) cu2[i] = c[i] * u[i]; }
#pragma unroll
        for (int r = 0; r < 4; ++r) {
            float b[8], c[8], u[8], y[8]; up8(rb[r], b); up8(rc[r], c); up8(ru[r], u);
            float ss = 0.f;
#pragma unroll
            for (int i = 0; i < 8; ++i) { const float cu0 = c[i] * u[i]; y[i] = b[i] * (w0[i] * cu2[i] + w1[i] * cu1[i] + w2[i] * cu0); ss += y[i] * y[i]; cu2[i] = cu1[i]; cu1[i] = cu0; }
            ss += __shfl_xor(ss, 1); ss += __shfl_xor(ss, 2); ss += __shfl_xor(ss, 4); ss += __shfl_xor(ss, 8);
            const float rstd = 1.0f / sqrtf(ss * (1.0f / 128.0f) + EPS);
#pragma unroll
            for (int i = 0; i < 8; ++i) y[i] *= rstd;
            *(GAS v4u*)(MIX + (size_t)(m0 + 4 * h + r) * D) = pk8(y);
            __builtin_amdgcn_sched_barrier(0);
        }
    }
}
template <int WLO, int WHI>
__device__ __forceinline__ void pool_pass(Frame& F, int p, int t0, int m0) {
    const int l = opq(F.lane); const bool lo = l < 32;
    const bf16* V = (const bf16*)(F.ws + WS_PROJ) + 3 * CW + 512 * p + 8 * l;
    bf16* PO = (bf16*)(F.ws + WS_POOLED) + ((size_t)(F.grp * 4 + 2 * p + (l >> 5)) * MG + t0) * 256 + 8 * (l & 31);
    const v4u z = {0u, 0u, 0u, 0u};
    v4u pv[WHI], cv[8];
#pragma unroll
    for (int j = 1; j < WHI; ++j) pv[j] = z;
    if (t0 >= 16) {
#pragma unroll
        for (int j = 1; j < WHI; ++j) pv[j] = ldg16(V + (size_t)(m0 - j) * NPROJ);
    } else if (t0 == 8) {
#pragma unroll
        for (int j = 1; j < WHI && j <= 8; ++j) pv[j] = ldg16(V + (size_t)(m0 - j) * NPROJ);
    }
#pragma unroll
    for (int r = 0; r < 8; ++r) cv[r] = ldg16(V + (size_t)(m0 + r) * NPROJ);
    float Wl[8], Wh[8];
#pragma unroll
    for (int i = 0; i < 8; ++i) { Wl[i] = 0.f; Wh[i] = 0.f; }
#pragma unroll
    for (int j = 1; j < WHI; ++j) { float f[8]; up8(pv[j], f);
#pragma unroll
        for (int i = 0; i < 8; ++i) { if (j < WLO) Wl[i] += f[i]; Wh[i] += f[i]; } }
#pragma unroll
    for (int r = 0; r < 8; ++r) {
        const int t = t0 + r; float v[8], o[8]; up8(cv[r], v);
        const float il = 1.0f / (float)((t + 1) < WLO ? (t + 1) : WLO), ih = 1.0f / (float)((t + 1) < WHI ? (t + 1) : WHI);
#pragma unroll
        for (int i = 0; i < 8; ++i) { Wl[i] += v[i]; Wh[i] += v[i]; o[i] = (lo ? Wl[i] * il : Wh[i] * ih) - v[i]; }
        *(GAS v4u*)(PO + (size_t)r * 256) = pk8(o);
        { float f[8]; up8((r - WLO + 1 >= 0) ? cv[(r - WLO + 1 >= 0) ? r - WLO + 1 : 0] : pv[(WLO - 1 - r > 0) ? WLO - 1 - r : 1], f);
#pragma unroll
          for (int i = 0; i < 8; ++i) Wl[i] -= f[i]; }
        { float f[8]; up8((r - WHI + 1 >= 0) ? cv[(r - WHI + 1 >= 0) ? r - WHI + 1 : 0] : pv[(WHI - 1 - r > 0) ? WHI - 1 - r : 1], f);
#pragma unroll
          for (int i = 0; i < 8; ++i) Wh[i] -= f[i]; }
        __builtin_amdgcn_sched_barrier(0);
    }
}
__device__ __forceinline__ void p2_mixer(Frame& F) {
    const int gw = F.sw * NWAVES + F.wave, NGW = GW * NWAVES;
    for (int chunk = gw; chunk < MG / 8; chunk += NGW) {
        const int t0 = chunk * 8, m0 = F.row0 + t0;
        conv_pass(F, 0, t0, m0); asm volatile("" ::: "memory"); conv_pass(F, 1, t0, m0); asm volatile("" ::: "memory");
        pool_pass<2, 4>(F, 0, t0, m0); asm volatile("" ::: "memory"); pool_pass<8, 16>(F, 1, t0, m0); asm volatile("" ::: "memory");
    }
}

__device__ __forceinline__ float sq4(const f32x4 v) { return (v.x * v.x + v.y * v.y) + (v.z * v.z + v.w * v.w); }
__device__ __forceinline__ f32x4 bf4lo(const v4u w) { return (f32x4){bflo(w.x), bfhi(w.x), bflo(w.y), bfhi(w.y)}; }
__device__ __forceinline__ f32x4 bf4hi(const v4u w) { return (f32x4){bflo(w.z), bfhi(w.z), bflo(w.w), bfhi(w.w)}; }
struct Row5 { f32x4 x[4][2]; v4u mo[4]; float p; };
__device__ __forceinline__ void ld_row5(Row5& R, const float* x, const bf16* MO, const float* part, int m, int l) {
    const GAS f32x4* xr = (const GAS f32x4*)(x + (size_t)m * D + 8 * l); const GAS v4u* mr = (const GAS v4u*)(MO + (size_t)m * D + 8 * l);
#pragma unroll
    for (int j = 0; j < 4; ++j) { R.x[j][0] = xr[128 * j]; R.x[j][1] = xr[128 * j + 1]; R.mo[j] = mr[64 * j]; }
    R.p = part[(size_t)m * 32 + (l & 31)];
}
__device__ __forceinline__ void p5_resnorm(Frame& F) {
    const int gw = F.sw * NWAVES + F.wave, NGW = GW * NWAVES, l = opq(F.lane);
    const bf16* MO = (const bf16*)(F.ws + WS_MIXOUT); const float* part = (const float*)(F.ws + WS_PART1); bf16* H = (bf16*)(F.ws + WS_H);
    LAS f32x4* G1 = (LAS f32x4*)F.lds; LAS f32x4* G2 = (LAS f32x4*)(F.lds + 8192);
    if (F.tid < 512) { G1[F.tid] = ((const GAS f32x4*)F.g_post)[F.tid]; G2[F.tid] = ((const GAS f32x4*)F.g_fpre)[F.tid]; }
    __syncthreads();
    for (int blk = gw; blk < MG / 8; blk += NGW) {
        const int m0 = F.row0 + 8 * blk;
        Row5 cur, nxt, nx2; ld_row5(cur, F.x, MO, part, m0, l); ld_row5(nxt, F.x, MO, part, m0 + 1, l);
#pragma unroll 1
        for (int r = 0; r < 8; ++r) {
            if (r + 2 < 8) ld_row5(nx2, F.x, MO, part, m0 + r + 2, l);
            const float rstd1 = 1.0f / sqrtf(wave_sum(l < 32 ? cur.p : 0.f) * (1.0f / D) + EPS);
            f32x4 v[4][2]; float s = 0.f;
#pragma unroll
            for (int j = 0; j < 4; ++j) { v[j][0] = cur.x[j][0] + bf4lo(cur.mo[j]) * rstd1 * G1[2 * l + 128 * j]; v[j][1] = cur.x[j][1] + bf4hi(cur.mo[j]) * rstd1 * G1[2 * l + 128 * j + 1]; s += sq4(v[j][0]) + sq4(v[j][1]); }
            const float rstd2 = 1.0f / sqrtf(wave_sum(s) * (1.0f / D) + EPS);
            GAS v4u* hr = (GAS v4u*)(H + (size_t)(m0 + r) * D + 8 * l);
#pragma unroll
            for (int j = 0; j < 4; ++j) { const f32x4 y0 = v[j][0] * rstd2 * G2[2 * l + 128 * j], y1 = v[j][1] * rstd2 * G2[2 * l + 128 * j + 1];
                v4u w; w.x = pkbf(y0.x, y0.y); w.y = pkbf(y0.z, y0.w); w.z = pkbf(y1.x, y1.y); w.w = pkbf(y1.z, y1.w); hr[64 * j] = w; __builtin_amdgcn_sched_barrier(0); }
            cur = nxt; nxt = nx2;
        }
    }
}
struct Row8 { f32x4 x[4][2]; v4u mo[4], ff[4]; float p1, p2; };
__device__ __forceinline__ void ld_row8(Row8& R, const float* x, const bf16* MO, const bf16* FFO, const float* part1, const float* part2, int m, int l) {
    const GAS f32x4* xr = (const GAS f32x4*)(x + (size_t)m * D + 8 * l); const GAS v4u* mr = (const GAS v4u*)(MO + (size_t)m * D + 8 * l); const GAS v4u* fr = (const GAS v4u*)(FFO + (size_t)m * D + 8 * l);
#pragma unroll
    for (int j = 0; j < 4; ++j) { R.x[j][0] = xr[128 * j]; R.x[j][1] = xr[128 * j + 1]; R.mo[j] = mr[64 * j]; R.ff[j] = fr[64 * j]; }
    R.p1 = part1[(size_t)m * 32 + (l & 31)]; R.p2 = part2[(size_t)m * 32 + (l & 31)];
}
__device__ __forceinline__ void p8_final(Frame& F) {
    const int gw = F.sw * NWAVES + F.wave, NGW = GW * NWAVES, l = opq(F.lane);
    const bf16* MO = (const bf16*)(F.ws + WS_MIXOUT); const bf16* FFO = (const bf16*)(F.ws + WS_FF);
    const float* part1 = (const float*)(F.ws + WS_PART1); const float* part2 = (const float*)(F.ws + WS_PART2);
    LAS f32x4* G1 = (LAS f32x4*)F.lds; LAS f32x4* G3 = (LAS f32x4*)(F.lds + 8192);
    if (F.tid < 512) { G1[F.tid] = ((const GAS f32x4*)F.g_post)[F.tid]; G3[F.tid] = ((const GAS f32x4*)F.g_fpost)[F.tid]; }
    __syncthreads();
    for (int blk = gw; blk < MG / 8; blk += NGW) {
        const int m0 = F.row0 + 8 * blk;
        Row8 cur, nxt, nx2; ld_row8(cur, F.x, MO, FFO, part1, part2, m0, l); ld_row8(nxt, F.x, MO, FFO, part1, part2, m0 + 1, l);
#pragma unroll 1
        for (int r = 0; r < 8; ++r) {
            if (r + 2 < 8) ld_row8(nx2, F.x, MO, FFO, part1, part2, m0 + r + 2, l);
            const float rstd1 = 1.0f / sqrtf(wave_sum(l < 32 ? cur.p1 : 0.f) * (1.0f / D) + EPS), rstd2 = 1.0f / sqrtf(wave_sum(l < 32 ? cur.p2 : 0.f) * (1.0f / D) + EPS);
            GAS f32x4* orow = (GAS f32x4*)(F.out + (size_t)(m0 + r) * D + 8 * l);
#pragma unroll
            for (int j = 0; j < 4; ++j) { orow[128 * j] = cur.x[j][0] + bf4lo(cur.mo[j]) * rstd1 * G1[2 * l + 128 * j] + bf4lo(cur.ff[j]) * rstd2 * G3[2 * l + 128 * j];
                orow[128 * j + 1] = cur.x[j][1] + bf4hi(cur.mo[j]) * rstd1 * G1[2 * l + 128 * j + 1] + bf4hi(cur.ff[j]) * rstd2 * G3[2 * l + 128 * j + 1]; __builtin_amdgcn_sched_barrier(0); }
            cur = nxt; nxt = nx2;
        }
    }
}

__device__ __forceinline__ void flag_set(unsigned* flag) { __hip_atomic_store(flag, 1u, __ATOMIC_RELAXED, __HIP_MEMORY_SCOPE_AGENT); }
__device__ __forceinline__ void flag_wait(unsigned* flag, unsigned* tmo) {
    if (threadIdx.x == 0) {
        unsigned sp = 0u;
        while (xb_ld(flag) == 0u) { __builtin_amdgcn_s_sleep(2); if ((++sp & 255u) == 0u) { if (xb_ld(tmo)) break; if (sp > XB_SPIN_CAP) { atomicAdd(tmo, 1u); break; } } }
        __builtin_amdgcn_fence(__ATOMIC_ACQUIRE, "agent");
        asm volatile("s_waitcnt vmcnt(0)" ::: "memory");
    }
    __syncthreads();
}

__device__ __forceinline__ void slab_barrier(unsigned* cnt, unsigned target, unsigned* tmo, unsigned samex) {
    asm volatile("s_waitcnt vmcnt(0)" ::: "memory");
    __syncthreads();
    if (threadIdx.x == 0) {
        if (!samex) { __builtin_amdgcn_fence(__ATOMIC_RELEASE, "agent"); asm volatile("s_waitcnt vmcnt(0)" ::: "memory"); }
        (void)xb_add(cnt, 1u);
        unsigned sp = 0u;
        while (xb_ld(cnt) < target) { __builtin_amdgcn_s_sleep(1); if ((++sp & 255u) == 0u) { if (xb_ld(tmo)) break; if (sp > XB_SPIN_CAP) { atomicAdd(tmo, 1u); break; } } }
        __builtin_amdgcn_fence(__ATOMIC_ACQUIRE, "agent");
        asm volatile("s_waitcnt vmcnt(0)" ::: "memory");
    }
    __syncthreads();
}
struct SlabPoolOrder {
    int c;
    __device__ __forceinline__ bool next(int i, pg8::Unit& u) const { if (i) return false; u.pm = ((c >> 3) >> 2) * 32 + 4 * (c & 7) + ((c >> 3) & 3); u.pn = 0; return true; }
    __device__ __forceinline__ void a_ready(const pg8::Unit&) const {}
    __device__ __forceinline__ void done(const pg8::Unit&) const {}
};

#ifndef WGMG
#define WGMG 4
#endif
constexpr int NXG = 8;
struct Args { const float* in[13]; float* out; unsigned char* ws; };
__global__ void __launch_bounds__(NWAVES * 64, 2) mk_fwd(Args args) {
    extern __shared__ __attribute__((aligned(16))) unsigned char lds[];
    Frame F;
    F.lds = (LAS unsigned char*)lds;
    F.tid = threadIdx.x; F.lane = F.tid & 63; F.wave = __builtin_amdgcn_readfirstlane(F.tid >> 6);
    { const int bx = blockIdx.x; F.grp = (bx >> 3) & 1; F.c = (bx >> 4) * 8 + (bx & 7); F.row0 = F.grp * MG; F.sw = (F.c & 7) * 16 + (F.c >> 3); }
    F.x = args.in[0]; F.g_pre = args.in[1]; F.w_in = args.in[2]; F.conv_w = args.in[3]; F.pool_w = args.in[4]; F.pool_scale = args.in[5]; F.w_out = args.in[6];
    F.g_post = args.in[7]; F.g_fpre = args.in[8]; F.w_gate = args.in[9]; F.w_up = args.in[10]; F.w_down = args.in[11]; F.g_fpost = args.in[12];
    F.out = args.out; F.ws = args.ws;
    unsigned char* ws = args.ws;
    unsigned* ctl = (unsigned*)(ws + WS_CTL);
    volatile LAS unsigned* MISC = (volatile LAS unsigned*)(F.lds + MISC_OFF);
    if (F.tid < 64) MISC[F.tid] = 0u;
    __syncthreads();
    const XcdBarrier bar = xcd_barrier_post(ctl + 4096 * F.grp, MISC + 8, (unsigned)GW);
    unsigned* flagA = ctl + CW_FLAG; unsigned* flagB = ctl + CW_FLAG + 64; unsigned* tmo = ctl + 4096 * F.grp + XB_TMO;
#define BAR() xcd_barrier(bar)
    unsigned* slabcnt = ctl + CW_SLAB + 64 * (8 * F.grp + (F.c & 7));
    if (F.tid == 0) (void)__hip_atomic_fetch_or(slabcnt + 1, 1u << bar.x, __ATOMIC_RELAXED, __HIP_MEMORY_SCOPE_AGENT);
    unsigned samex = 0u;
#define SBAR(k) slab_barrier(slabcnt, 16u * (k), ctl + 4096 * F.grp + XB_TMO, samex)
#ifndef PROBE_B
#define PROBE_G 0
#define PROBE_A 0
#define PROBE_B 0
#define PROBE_MUL 4
#endif
    unsigned long long* stamps = (unsigned long long*)(ctl + 8192);
#define STAMP(k) do { if (PROBE_B > PROBE_A && F.c == 0 && F.tid == 0) __hip_atomic_store(stamps + F.grp * 16 + (k), (unsigned long long)__builtin_amdgcn_s_memrealtime(), __ATOMIC_RELAXED, __HIP_MEMORY_SCOPE_AGENT); } while (0)
    STAMP(0);
    typedef pg8::bf16_t bt;
    const size_t r0 = (size_t)F.row0;
    if (F.grp == 0) { p0_weights<false>(F); p0_hrows(F); BAR(); if (F.c == 0 && F.tid == 0) flag_set(flagA); }
    else { p0_weights<true>(F); p0_hrows(F); BAR(); if (F.c == 0 && F.tid == 0) flag_set(flagB); flag_wait(flagA, tmo); }
    STAMP(1);
#ifndef PHMASK
#define PHMASK 0x1ff
#endif
    if (PHMASK & 2) {
        pg8::Gemm g{(const bt*)(ws + WS_H) + r0 * D, (const bt*)(ws + WS_WIN), MG, NPROJ, D, 0}; pg8::StaticOrder S; S.init(MG, NPROJ, GW, F.c, NXG, WGMG);
        pg8::EpiBf16 E{(bt*)(ws + WS_PROJ) + r0 * NPROJ, NPROJ};
        pg8::gemm_phase<pg8::EpiBf16, pg8::StaticOrder, false, true>(F.lds, g, S, E);
    }
    BAR(); STAMP(2);
    if (F.tid == 0) MISC[12] = (__builtin_popcount(xb_ld(slabcnt + 1)) == 1) ? 1u : 0u;
    __syncthreads();
    samex = MISC[12];
    if (PHMASK & 4) p2_mixer(F);
    SBAR(1);
    STAMP(3);
    if (PHMASK & 8) {
        int kpool = 256; asm volatile("" : "+s"(kpool));
        pg8::Gemm g{(const bt*)(ws + WS_POOLED) + (size_t)F.grp * 4 * MG * 256, (const bt*)(ws + WS_WPOOL), 4 * MG, 256, kpool, MG / 256}; SlabPoolOrder S{F.c};
        pg8::EpiPool E{(bt*)(ws + WS_MIXED) + r0 * D, D, F.pool_scale, (LAS float*)(F.lds + EPI_SCR_OFF), EPS, 5};
        pg8::gemm_phase<pg8::EpiPool, SlabPoolOrder, false, true>(F.lds, g, S, E);
    }
    SBAR(2); STAMP(4);
    if (PHMASK & 16) {
        pg8::Gemm g{(const bt*)(ws + WS_MIXED) + r0 * D, (const bt*)(ws + WS_WOUT), MG, D, D, 0}; pg8::StaticOrder S; S.init(MG, D, GW, F.c, NXG, WGMG);
        pg8::EpiBf16Stat E{(bt*)(ws + WS_MIXOUT) + r0 * D, D, (float*)(ws + WS_PART1) + r0 * 32};
        pg8::gemm_phase<pg8::EpiBf16Stat, pg8::StaticOrder, false, true>(F.lds, g, S, E);
    }
    SBAR(3); STAMP(5);
    if (F.tid == 0) (void)xb_add(ctl + CW_P4 + 64 * F.grp, 1u);
    if (PHMASK & 32) p5_resnorm(F);
    SBAR(4);
    if (F.tid == 0) { unsigned sp = 0u; unsigned* w = ctl + CW_P4 + 64 * F.grp;
        while (xb_ld(w) < (unsigned)GW) { __builtin_amdgcn_s_sleep(2); if ((++sp & 255u) == 0u) { if (xb_ld(tmo)) break; if (sp > XB_SPIN_CAP) { atomicAdd(tmo, 1u); break; } } } }
    __syncthreads();
    if (F.grp == 0) flag_wait(flagB, tmo);
    STAMP(6);
    if (PHMASK & 64) {
        pg8::Gemm g{(const bt*)(ws + WS_H) + r0 * D, (const bt*)(ws + WS_WGU), MG, 2 * FF, D, 0}; pg8::StaticOrder S; S.init(MG, 2 * FF, GW, F.c, NXG, WGMG);
        pg8::EpiSwiGLU E{(bt*)(ws + WS_ACT) + r0 * FF, FF};
        pg8::gemm_phase<pg8::EpiSwiGLU, pg8::StaticOrder, false, true>(F.lds, g, S, E);
    }
    SBAR(5); STAMP(7);
    if (PHMASK & 128) {
        pg8::Gemm g{(const bt*)(ws + WS_ACT) + r0 * FF, (const bt*)(ws + WS_WD), MG, D, FF, 0}; pg8::StaticOrder S; S.init(MG, D, GW, F.c, NXG, WGMG);
        pg8::EpiBf16Stat E{(bt*)(ws + WS_FF) + r0 * D, D, (float*)(ws + WS_PART2) + r0 * 32};
        pg8::gemm_phase<pg8::EpiBf16Stat, pg8::StaticOrder, false, true>(F.lds, g, S, E);
    }
    SBAR(6); STAMP(8);
    if (PHMASK & 256) p8_final(F);
    if (PROBE_B > PROBE_A) {
        asm volatile("s_waitcnt vmcnt(0)" ::: "memory"); __syncthreads(); STAMP(9);
        if (F.grp == 1 && F.c == 0 && F.tid == 0) {
            asm volatile("s_waitcnt vmcnt(0)" ::: "memory");
            const unsigned long long a = __hip_atomic_load(stamps + PROBE_G * 16 + PROBE_A, __ATOMIC_RELAXED, __HIP_MEMORY_SCOPE_AGENT), b = __hip_atomic_load(stamps + PROBE_G * 16 + PROBE_B, __ATOMIC_RELAXED, __HIP_MEMORY_SCOPE_AGENT);
            const unsigned long long span = (b > a && b - a < 400000ull) ? (b - a) * PROBE_MUL : 1000000ull;
            const unsigned long long t0 = __builtin_amdgcn_s_memrealtime();
            while (__builtin_amdgcn_s_memrealtime() - t0 < span) __builtin_amdgcn_s_sleep(8);
        }
    }
#undef BAR
#undef SBAR
#undef STAMP
}

extern "C" void kernel_launch(void* const* d_in, const int* in_sizes, int n_in, void* d_out, int out_size, void* d_ws, size_t ws_size, hipStream_t stream) {
    static int grid = 0;
    if (grid == 0) {
        if (n_in != 13 || in_sizes[0] != M * D || out_size != M * D || ws_size < WS_END) { fprintf(stderr, "kernel_launch: shape/workspace mismatch (n_in %d, in0 %d, out %d, ws %zu, need %zu); nothing launched\n", n_in, n_in > 0 ? in_sizes[0] : -1, out_size, ws_size, (size_t)WS_END); grid = -1; return; }
        int dev = 0, cus = 0, per_cu = 0;
        if (hipGetDevice(&dev) != hipSuccess || hipDeviceGetAttribute(&cus, hipDeviceAttributeMultiprocessorCount, dev) != hipSuccess) { fprintf(stderr, "kernel_launch: device query failed\n"); grid = -1; return; }
        if (hipFuncSetAttribute((const void*)mk_fwd, hipFuncAttributeMaxDynamicSharedMemorySize, LDS_BYTES) != hipSuccess) { fprintf(stderr, "kernel_launch: hipFuncSetAttribute failed\n"); grid = -1; return; }
        if (hipOccupancyMaxActiveBlocksPerMultiprocessor(&per_cu, (const void*)mk_fwd, NWAVES * 64, LDS_BYTES) != hipSuccess || per_cu < 1) { fprintf(stderr, "kernel_launch: occupancy query says %d blocks per CU\n", per_cu); per_cu = 1; }
        (void)hipGetLastError();
        if (cus * per_cu < NGRP * GW) { fprintf(stderr, "kernel_launch: needs %d co-resident workgroups, the device holds %d; nothing launched\n", NGRP * GW, cus * per_cu); grid = -1; return; }
        grid = NGRP * GW;
    }
    if (grid < 0) return;
    Args a{};
    for (int i = 0; i < 13; ++i) a.in[i] = (const float*)d_in[i];
    a.out = (float*)d_out; a.ws = (unsigned char*)d_ws;
    if (hipMemsetAsync((char*)d_ws + WS_CTL, 0, CTL_ZERO_BYTES, stream) != hipSuccess) { fprintf(stderr, "kernel_launch: hipMemsetAsync failed\n"); return; }
    hipLaunchKernelGGL(mk_fwd, dim3(grid), dim3(NWAVES * 64), LDS_BYTES, stream, a);
    const hipError_t e = hipPeekAtLastError();
    if (e != hipSuccess) fprintf(stderr, "kernel_launch: launch failed: %s (grid %d)\n", hipGetErrorString(e), grid);
}
```

```cpp
#include <hip/hip_runtime.h>
#include <cstdio>
#include <cstdint>
namespace pg8 {
#define PG8_LAS __attribute__((address_space(3)))
typedef unsigned short bf16_t;
typedef short bf16x8 __attribute__((ext_vector_type(8)));
typedef float f32x4 __attribute__((ext_vector_type(4)));
typedef unsigned u32x4 __attribute__((ext_vector_type(4)));
constexpr int BM = 256, BK = 64, HALF = 128, HTB = HALF * BK * 2  , STAGE_BYTES = 8 * HTB, NXCD = 8, WGM = 8;

__host__ __device__ __forceinline__ int lds_byte(int r, int c) { const int st = (r >> 4) * 2 + (c >> 5), rr = r & 15, cc = c & 31, ob = rr * 64 + cc * 2; return st * 1024 + (ob ^ (((ob >> 9) & 1) << 5)); }
__host__ __device__ __forceinline__ void stage_rc(int b, int& R, int& C) { const int st = b / 1024, sb = b % 1024, swz = sb ^ (((sb >> 9) & 1) << 5); R = (st >> 1) * 16 + swz / 64; C = (st & 1) * 32 + (swz % 64) / 2; }
__host__ __device__ __forceinline__ int perm32(int rho) { const int n = rho >> 4, i = rho & 15; return 8 * (i >> 2) + 4 * n + (i & 3); }

struct Unit { int pm, pn; };
struct Gemm { const bf16_t* A; const bf16_t* Bt; int M, N, K; int bdiv; };
__device__ __forceinline__ int btile(const Gemm& g, const Unit& u) { return u.pn + (g.bdiv ? (u.pm / g.bdiv) * (g.N / BM) : 0); }

struct StaticOrder {
    int nM, nN, nwg, G, c, nxcd, wgm;
    __host__ __device__ void init(int M, int N, int G_, int c_, int nxcd_, int wgm_ = WGM) { nM = M / BM; nN = N / BM; nwg = nM * nN; G = G_; c = c_; nxcd = nxcd_; wgm = wgm_; }
    __host__ __device__ bool next(int i, Unit& u) const {
        const long L = (long)i * G + c; if (L >= nwg) return false;
        int wgid = (int)L; { const int q = nwg / nxcd, r = nwg % nxcd, xcd = wgid % nxcd, off = wgid / nxcd; wgid = (xcd < r ? xcd * (q + 1) : r * (q + 1) + (xcd - r) * q) + off; }
        const int nig = wgm * nN, gid = wgid / nig, fm = gid * wgm, gsz = (nM - fm) < wgm ? (nM - fm) : wgm;
        u.pm = fm + ((wgid % nig) % gsz); u.pn = (wgid % nig) / gsz; return true;
    }
    __device__ __forceinline__ void a_ready(const Unit&) const {}
    __device__ __forceinline__ void done(const Unit&) const {}
};

__device__ __forceinline__ unsigned cvt_pk_bf16(float lo, float hi) { unsigned r; asm volatile("v_cvt_pk_bf16_f32 %0, %1, %2" : "=v"(r) : "v"(lo), "v"(hi)); return r; }

struct EpiBf16 {
    static constexpr bool PERM = true, AFTER_DRAIN = false;
    bf16_t* O; int ldc;
    __device__ __forceinline__ void operator()(const f32x4 (&acc)[2][2][4][2], const Unit& u, int wr, int wc, int fr, int fq) const {
        const int row0 = u.pm * BM + wr * 64 + fr; const int col0 = u.pn * BM + wc * 32 + 8 * fq;
#pragma unroll
        for (int ai = 0; ai < 2; ++ai)
#pragma unroll
            for (int m = 0; m < 4; ++m) { bf16_t* rowp = O + (size_t)(row0 + ai * HALF + m * 16) * ldc + col0;
#pragma unroll
                for (int bj = 0; bj < 2; ++bj) { const f32x4 v0 = acc[ai][bj][m][0], v1 = acc[ai][bj][m][1];
                    u32x4 w; w.x = cvt_pk_bf16(v0[0], v0[1]); w.y = cvt_pk_bf16(v0[2], v0[3]); w.z = cvt_pk_bf16(v1[0], v1[1]); w.w = cvt_pk_bf16(v1[2], v1[3]);
                    __builtin_nontemporal_store(w, (u32x4*)(rowp + bj * HALF)); } }
    }
};

__device__ __forceinline__ float silu_mul(float g, float u) { const float e = __builtin_amdgcn_exp2f(g * -1.4426950408889634f); return g * __builtin_amdgcn_rcpf(1.0f + e) * u; }
struct EpiSwiGLU {
    static constexpr bool PERM = true, AFTER_DRAIN = false;
    bf16_t* O; int ldc;
    __device__ __forceinline__ void operator()(const f32x4 (&acc)[2][2][4][2], const Unit& u, int wr, int wc, int fr, int fq) const {
        const int row0 = u.pm * BM + wr * 64 + fr; const int col0 = u.pn * HALF + wc * 32 + 8 * fq;
#pragma unroll
        for (int ai = 0; ai < 2; ++ai)
#pragma unroll
            for (int m = 0; m < 4; ++m) { bf16_t* rowp = O + (size_t)(row0 + ai * HALF + m * 16) * ldc + col0;
                const f32x4 g0 = acc[ai][0][m][0], g1 = acc[ai][0][m][1], u0 = acc[ai][1][m][0], u1 = acc[ai][1][m][1];
                u32x4 w; w.x = cvt_pk_bf16(silu_mul(g0[0], u0[0]), silu_mul(g0[1], u0[1])); w.y = cvt_pk_bf16(silu_mul(g0[2], u0[2]), silu_mul(g0[3], u0[3]));
                w.z = cvt_pk_bf16(silu_mul(g1[0], u1[0]), silu_mul(g1[1], u1[1])); w.w = cvt_pk_bf16(silu_mul(g1[2], u1[2]), silu_mul(g1[3], u1[3]));
                __builtin_nontemporal_store(w, (u32x4*)rowp); }
    }
};

struct EpiBf16Stat {
    static constexpr bool PERM = true, AFTER_DRAIN = false;
    bf16_t* O; int ldc; float* part;
    __device__ __forceinline__ void operator()(const f32x4 (&acc)[2][2][4][2], const Unit& u, int wr, int wc, int fr, int fq) const {
        const int col0 = u.pn * BM + wc * 32 + 8 * fq;
#pragma unroll
        for (int ai = 0; ai < 2; ++ai)
#pragma unroll
            for (int m = 0; m < 4; ++m) { const int r = u.pm * BM + ai * HALF + wr * 64 + m * 16 + fr; bf16_t* rowp = O + (size_t)r * ldc + col0; float s = 0.f;
#pragma unroll
                for (int bj = 0; bj < 2; ++bj) { const f32x4 v0 = acc[ai][bj][m][0], v1 = acc[ai][bj][m][1];
                    s += ((v0[0] * v0[0] + v0[1] * v0[1]) + (v0[2] * v0[2] + v0[3] * v0[3])) + ((v1[0] * v1[0] + v1[1] * v1[1]) + (v1[2] * v1[2] + v1[3] * v1[3]));
                    u32x4 w; w.x = cvt_pk_bf16(v0[0], v0[1]); w.y = cvt_pk_bf16(v0[2], v0[3]); w.z = cvt_pk_bf16(v1[0], v1[1]); w.w = cvt_pk_bf16(v1[2], v1[3]);
                    *(u32x4*)(rowp + bj * HALF) = w; }
                s += __shfl_xor(s, 16); s += __shfl_xor(s, 32);
                if (fq == 0) part[(size_t)r * 32 + u.pn * 4 + wc] = s; }
    }
};

struct EpiPool {
    static constexpr bool PERM = true, AFTER_DRAIN = true;
    bf16_t* O; int ldc; const float* scale; PG8_LAS float* scr; float eps; int sh;
    __device__ __forceinline__ void fused(const f32x4 (&acc)[2][2][4][2], const Unit& u, int wr, int wc, int fr, int fq, PG8_LAS unsigned char*, int, int) const {
        const int grp = u.pm >> sh, rb = u.pm & ((1 << sh) - 1);
#pragma unroll
        for (int ai = 0; ai < 2; ++ai)
#pragma unroll
            for (int m = 0; m < 4; ++m) { float s = 0.f;
#pragma unroll
                for (int bj = 0; bj < 2; ++bj)
#pragma unroll
                    for (int n = 0; n < 2; ++n) { const f32x4 v = acc[ai][bj][m][n]; s += (v[0] * v[0] + v[1] * v[1]) + (v[2] * v[2] + v[3] * v[3]); }
                s += __shfl_xor(s, 16); s += __shfl_xor(s, 32);
                if (fq == 0) scr[(ai * HALF + wr * 64 + m * 16 + fr) * 4 + wc] = s;
                asm volatile("" ::: "memory"); }
        asm volatile("s_waitcnt lgkmcnt(0)" ::: "memory"); __builtin_amdgcn_s_barrier(); asm volatile("" ::: "memory");
        const int gc0 = grp * BM + wc * 32 + 8 * fq;
#pragma unroll
        for (int ai = 0; ai < 2; ++ai)
#pragma unroll
            for (int m = 0; m < 4; ++m) { const int rl = ai * HALF + wr * 64 + m * 16 + fr; const f32x4 p = *(const PG8_LAS f32x4*)(scr + rl * 4);
                const float rstd = __builtin_amdgcn_rsqf(((p[0] + p[1]) + (p[2] + p[3])) * (1.0f / 256.0f) + eps);
                bf16_t* rowp = O + (size_t)(rb * BM + rl) * ldc + 1024 + gc0;
#pragma unroll
                for (int bj = 0; bj < 2; ++bj) { const f32x4 s0 = *(const f32x4*)(scale + gc0 + bj * HALF), s1 = *(const f32x4*)(scale + gc0 + bj * HALF + 4);
                    const f32x4 v0 = acc[ai][bj][m][0] * rstd * s0, v1 = acc[ai][bj][m][1] * rstd * s1;
                    u32x4 w; w.x = cvt_pk_bf16(v0[0], v0[1]); w.y = cvt_pk_bf16(v0[2], v0[3]); w.z = cvt_pk_bf16(v1[0], v1[1]); w.w = cvt_pk_bf16(v1[2], v1[3]);
                    *(u32x4*)(rowp + bj * HALF) = w; }
                asm volatile("" ::: "memory"); }
        asm volatile("s_waitcnt lgkmcnt(0)" ::: "memory"); __builtin_amdgcn_s_barrier(); asm volatile("" ::: "memory");
    }
};

template <class Epi, class Sched, bool ALIGN_EPI = false, bool SP2 = false>
__device__ __forceinline__ void gemm_phase(PG8_LAS unsigned char* lds, const Gemm g, const Sched& S, const Epi& E) {
    const int tid = threadIdx.x, wid = __builtin_amdgcn_readfirstlane(tid >> 6), lane = tid & 63, wr = wid >> 2, wc = wid & 3, fr = lane & 15, fq = lane >> 4;
    const int K = g.K, nt = K / BK;
    unsigned voffA[2], voffB[2];
#pragma unroll
    for (int i = 0; i < 2; ++i) { int R, C; stage_rc(tid * 16 + i * 8192, R, C); const int Rb = Epi::PERM ? ((R & ~31) + perm32(R & 31)) : R;
        voffA[i] = (unsigned)(R * K + C) * 2u; voffB[i] = (unsigned)(Rb * K + C) * 2u; }
    const size_t kstep = (size_t)(BK * 2);
    const size_t hstep = (size_t)HALF * K * 2;
    const size_t tstep = 2 * hstep;
    const unsigned ldsw = (unsigned)wid * 1024u;
    const int aoff = lds_byte(wr * 64 + fr, fq * 8), boff = lds_byte(wc * 32 + fr, fq * 8);
#define PG8_SA(b, h) (((b) * 2 + (h)) * HTB)
#define PG8_SB(b, h) ((4 + (b) * 2 + (h)) * HTB)
#define PG8_STAGE(bufoff, gbase, voff) do { _Pragma("unroll") for (int _i = 0; _i < 2; ++_i) \
        __builtin_amdgcn_global_load_lds((const unsigned*)((const char*)(gbase) + (voff)[_i]), (PG8_LAS unsigned*)(lds + (bufoff) + ldsw + _i * 8192), 16, 0, 0); } while (0)
#define PG8_LDA(dst, b, h) do { _Pragma("unroll") for (int m = 0; m < 4; ++m) _Pragma("unroll") for (int k = 0; k < 2; ++k) dst[m][k] = *(const PG8_LAS bf16x8*)(lds + PG8_SA(b, h) + aoff + m * 2048 + k * 1024); } while (0)
#define PG8_LDB(dst, b, h) do { _Pragma("unroll") for (int n = 0; n < 2; ++n) _Pragma("unroll") for (int k = 0; k < 2; ++k) dst[n][k] = *(const PG8_LAS bf16x8*)(lds + PG8_SB(b, h) + boff + n * 2048 + k * 1024); } while (0)
#define PG8_MMA(ai, bj, At, Bt) do { __builtin_amdgcn_s_setprio(1); _Pragma("unroll") for (int m = 0; m < 4; ++m) _Pragma("unroll") for (int n = 0; n < 2; ++n) _Pragma("unroll") for (int k = 0; k < 2; ++k) \
        acc[ai][bj][m][n] = __builtin_amdgcn_mfma_f32_16x16x32_bf16(Bt[n][k], At[m][k], acc[ai][bj][m][n], 0, 0, 0); __builtin_amdgcn_s_setprio(0); } while (0)
#define PG8_WAIT_V(n) asm volatile("s_waitcnt vmcnt(" #n ")" ::: "memory")
#define PG8_WAIT_L(n) asm volatile("s_waitcnt lgkmcnt(" #n ")" ::: "memory")
#define PG8_BAR __builtin_amdgcn_s_barrier()
#define PG8_SCHED __builtin_amdgcn_sched_barrier(0)
    Unit cur, nxt; int ui = 0;
    if (!S.next(0, cur)) return;
    f32x4 acc[2][2][4][2];
#pragma unroll
    for (int a = 0; a < 2; ++a)
#pragma unroll
        for (int b = 0; b < 2; ++b)
#pragma unroll
            for (int m = 0; m < 4; ++m)
#pragma unroll
                for (int n = 0; n < 2; ++n) acc[a][b][m][n] = (f32x4){0.f, 0.f, 0.f, 0.f};
    bf16x8 At[4][2], B0[2][2], B1[2][2];
    const char* cA = (const char*)g.A + (size_t)cur.pm * tstep; const char* cB = (const char*)g.Bt + (size_t)btile(g, cur) * tstep;
    S.a_ready(cur);
    if constexpr (SP2) {
        PG8_STAGE(PG8_SB(0, 0), cB, voffB); PG8_STAGE(PG8_SB(0, 1), cB + hstep, voffB); PG8_STAGE(PG8_SA(0, 0), cA, voffA); PG8_STAGE(PG8_SA(0, 1), cA + hstep, voffA);
        if (wr == 1) PG8_BAR;
        PG8_WAIT_V(2); PG8_BAR;
        PG8_STAGE(PG8_SB(1, 0), cB + kstep, voffB); PG8_STAGE(PG8_SA(1, 0), cA + kstep, voffA); PG8_STAGE(PG8_SB(1, 1), cB + hstep + kstep, voffB);
        PG8_WAIT_V(6); PG8_BAR;
    } else {
        PG8_STAGE(PG8_SB(0, 0), cB, voffB); PG8_STAGE(PG8_SA(0, 0), cA, voffA); PG8_STAGE(PG8_SB(0, 1), cB + hstep, voffB); PG8_STAGE(PG8_SA(0, 1), cA + hstep, voffA);
        if (wr == 1) PG8_BAR;
        PG8_WAIT_V(4); PG8_BAR;
        PG8_STAGE(PG8_SB(1, 0), cB + kstep, voffB); PG8_STAGE(PG8_SA(1, 0), cA + kstep, voffA); PG8_STAGE(PG8_SB(1, 1), cB + hstep + kstep, voffB);
        PG8_WAIT_V(6); PG8_BAR;
    }
    for (;;) {
        const bool has_next = S.next(ui + 1, nxt);
        const char* nA = has_next ? (const char*)g.A + (size_t)nxt.pm * tstep : cA; const char* nB = has_next ? (const char*)g.Bt + (size_t)btile(g, nxt) * tstep : cB;
        for (int t = 0; t < nt; t += 2) {
            const bool last = (t == nt - 2);
            const char* a1 = cA + (size_t)(t + 1) * kstep;
            const char* a2 = last ? nA : cA + (size_t)(t + 2) * kstep; const char* b2 = last ? nB : cB + (size_t)(t + 2) * kstep;
            const char* a3 = a2 + kstep; const char* b3 = b2 + kstep;
            if (last && has_next) S.a_ready(nxt);
            if constexpr (SP2) {
            PG8_LDB(B0, 0, 0); PG8_LDB(B1, 0, 1); PG8_SCHED; PG8_LDA(At, 0, 0); PG8_STAGE(PG8_SA(1, 1), a1 + hstep, voffA);
            PG8_WAIT_V(8); PG8_WAIT_L(0); PG8_BAR; PG8_MMA(0, 0, At, B0); PG8_MMA(0, 1, At, B1); PG8_BAR; PG8_SCHED;
            PG8_LDA(At, 0, 1); PG8_STAGE(PG8_SB(0, 0), b2, voffB); PG8_STAGE(PG8_SB(0, 1), b2 + hstep, voffB); PG8_STAGE(PG8_SA(0, 0), a2, voffA);
            PG8_WAIT_V(8); PG8_WAIT_L(0); PG8_BAR; PG8_MMA(1, 0, At, B0); PG8_MMA(1, 1, At, B1); PG8_BAR; PG8_SCHED;
            PG8_LDB(B0, 1, 0); PG8_LDB(B1, 1, 1); PG8_SCHED; PG8_LDA(At, 1, 0); PG8_STAGE(PG8_SA(0, 1), a2 + hstep, voffA);
            PG8_WAIT_V(8); PG8_WAIT_L(0); PG8_BAR; PG8_MMA(0, 0, At, B0); PG8_MMA(0, 1, At, B1); PG8_BAR; PG8_SCHED;
            PG8_LDA(At, 1, 1); PG8_STAGE(PG8_SB(1, 0), b3, voffB); PG8_STAGE(PG8_SB(1, 1), b3 + hstep, voffB); PG8_STAGE(PG8_SA(1, 0), a3, voffA);
            PG8_WAIT_V(8); PG8_WAIT_L(0); PG8_BAR; PG8_MMA(1, 0, At, B0); PG8_MMA(1, 1, At, B1); PG8_BAR; PG8_SCHED;
            } else {
            PG8_LDB(B0, 0, 0); PG8_SCHED; PG8_LDA(At, 0, 0); PG8_STAGE(PG8_SA(1, 1), a1 + hstep, voffA);
            PG8_WAIT_L(8); PG8_BAR; PG8_WAIT_L(0); PG8_MMA(0, 0, At, B0); PG8_BAR; PG8_SCHED;
            PG8_LDB(B1, 0, 1); PG8_STAGE(PG8_SB(0, 0), b2, voffB);
            PG8_BAR; PG8_WAIT_L(0); PG8_MMA(0, 1, At, B1); PG8_BAR;
            PG8_LDA(At, 0, 1); PG8_STAGE(PG8_SA(0, 0), a2, voffA);
            PG8_BAR; PG8_WAIT_L(0); PG8_MMA(1, 0, At, B0); PG8_BAR; PG8_SCHED;
            PG8_STAGE(PG8_SB(0, 1), b2 + hstep, voffB);
            PG8_WAIT_V(6); PG8_BAR; PG8_MMA(1, 1, At, B1); PG8_BAR;
            PG8_LDB(B0, 1, 0); PG8_SCHED; PG8_LDA(At, 1, 0); PG8_STAGE(PG8_SA(0, 1), a2 + hstep, voffA);
            PG8_WAIT_L(8); PG8_BAR; PG8_WAIT_L(0); PG8_MMA(0, 0, At, B0); PG8_BAR; PG8_SCHED;
            PG8_LDB(B1, 1, 1); PG8_STAGE(PG8_SB(1, 0), b3, voffB);
            PG8_BAR; PG8_WAIT_L(0); PG8_MMA(0, 1, At, B1); PG8_BAR;
            PG8_LDA(At, 1, 1); PG8_STAGE(PG8_SA(1, 0), a3, voffA);
            PG8_BAR; PG8_WAIT_L(0); PG8_MMA(1, 0, At, B0); PG8_BAR; PG8_SCHED;
            PG8_STAGE(PG8_SB(1, 1), b3 + hstep, voffB);
            PG8_WAIT_V(6); PG8_BAR; PG8_MMA(1, 1, At, B1); PG8_BAR;
            }
        }
        if constexpr (ALIGN_EPI) { if (wr == 0) PG8_BAR; }
        if constexpr (!Epi::AFTER_DRAIN) { E(acc, cur, wr, wc, fr, fq); S.done(cur); }
        if (!has_next) break;
#pragma unroll
        for (int a = 0; a < 2; ++a)
#pragma unroll
            for (int b = 0; b < 2; ++b)
#pragma unroll
                for (int m = 0; m < 4; ++m)
#pragma unroll
                    for (int n = 0; n < 2; ++n) acc[a][b][m][n] = (f32x4){0.f, 0.f, 0.f, 0.f};
        cur = nxt; cA = nA; cB = nB; ++ui;
        if constexpr (ALIGN_EPI) { if (wr == 1) PG8_BAR; }
    }
    PG8_WAIT_V(0);
    if constexpr (!ALIGN_EPI) { if (wr == 0) PG8_BAR; }
    PG8_BAR;
    if constexpr (Epi::AFTER_DRAIN) { E.fused(acc, cur, wr, wc, fr, fq, lds, wid, lane); S.done(cur); }
#undef PG8_SA
#undef PG8_SB
#undef PG8_STAGE
#undef PG8_LDA
#undef PG8_LDB
#undef PG8_MMA
#undef PG8_WAIT_V
#undef PG8_WAIT_L
#undef PG8_BAR
#undef PG8_SCHED
}
}

constexpr int NWAVES = 8;
constexpr int BATCH = 2, SEQ = 8192, D = 2048, CW = 1024, PW = 1024, NPROJ = 4096, FF = 5632;
constexpr int M = BATCH * SEQ;
constexpr float EPS = 1e-6f;
constexpr int NGRP = 2, GW = 128, MG = SEQ;

constexpr size_t MiB = 1u << 20;
constexpr size_t WS_CTL = 0, CTL_ZERO_BYTES = 49152;
constexpr int CW_P4 = 9600;
constexpr int CW_SLAB = 8448;
constexpr int CW_FLAG = 8192 - 128;
constexpr size_t WS_PART1 = 1 * MiB, WS_PART2 = 3 * MiB;
constexpr size_t WS_WD = 5 * MiB;
constexpr size_t WS_WIN = 27 * MiB;
constexpr size_t WS_WOUT = 43 * MiB;
constexpr size_t WS_WGU = 51 * MiB;
constexpr size_t WS_WPOOL = 95 * MiB;
constexpr size_t WS_H = 96 * MiB;
constexpr size_t WS_MIXOUT = 160 * MiB;
constexpr size_t WS_BLK = 224 * MiB, BLK_STRIDE = 120 * MiB;
#define WS_PROJ   (WS_BLK + (size_t)F.grp * BLK_STRIDE - (size_t)F.row0 * NPROJ * 2)
#define WS_POOLED (WS_BLK + (size_t)F.grp * BLK_STRIDE + 64 * MiB - (size_t)F.grp * 4 * MG * 256 * 2)
#define WS_MIXED  (WS_BLK + (size_t)F.grp * BLK_STRIDE + 80 * MiB - (size_t)F.row0 * D * 2)
#define WS_ACT    (WS_BLK + (size_t)F.grp * BLK_STRIDE - (size_t)F.row0 * FF * 2)
#define WS_FF     (WS_BLK + (size_t)F.grp * BLK_STRIDE + 88 * MiB - (size_t)F.row0 * D * 2)
constexpr size_t WS_END = WS_BLK + 2 * BLK_STRIDE;
static_assert(WS_WD + (size_t)D * FF * 2 <= WS_WIN && WS_WPOOL + 4 * 65536 * 2 <= WS_H && WS_H + (size_t)M * D * 2 <= WS_MIXOUT && WS_MIXOUT + (size_t)M * D * 2 <= WS_BLK
              && (size_t)MG * FF * 2 <= 88 * MiB && (size_t)MG * NPROJ * 2 <= 64 * MiB && 88 * MiB + (size_t)MG * D * 2 <= BLK_STRIDE && BLK_STRIDE <= WS_BLK, "d_ws map");

constexpr int RING_BYTES = 131072, EPI_SCR_OFF = RING_BYTES, MISC_OFF = RING_BYTES + 4096, LDS_BYTES = 147456;

#define GAS __attribute__((address_space(1)))
#define LAS __attribute__((address_space(3)))
typedef unsigned short bf16;
typedef unsigned v4u __attribute__((ext_vector_type(4)));
typedef unsigned v2u __attribute__((ext_vector_type(2)));
typedef float f32x4 __attribute__((ext_vector_type(4)));
#define LDS_WAIT() asm volatile("s_waitcnt lgkmcnt(0)" ::: "memory")
__device__ __forceinline__ unsigned f2bf(float f) { unsigned u = __builtin_bit_cast(unsigned, f); return (u + 0x7fffu + ((u >> 16) & 1u)) >> 16; }
__device__ __forceinline__ unsigned pk2(float lo, float hi) { return f2bf(lo) | (f2bf(hi) << 16); }
__device__ __forceinline__ float bflo(unsigned w) { return __builtin_bit_cast(float, w << 16); }
__device__ __forceinline__ float bfhi(unsigned w) { return __builtin_bit_cast(float, w & 0xffff0000u); }
__device__ __forceinline__ float wave_sum(float v) {
#pragma unroll
    for (int o = 1; o < 64; o <<= 1) v += __shfl_xor(v, o);
    return v;
}

typedef GAS unsigned gu32;
#define RLX_AGENT __ATOMIC_RELAXED, __HIP_MEMORY_SCOPE_AGENT
#define XB_TMO      128
#define XB_XCNT(j)  (256  + 64 * (j))
#define XB_XSUB(j)  (1280 + 64 * (j))
#define XB_XGEN(j)  (2304 + 64 * (j))
#define XB_TOP      3328
#define XB_TOPGEN   3392
#define XCD_BAR_WORDS 3456
#define XB_SPIN_CAP (1u << 18)

__device__ __forceinline__ unsigned xb_ld(unsigned* p)              { return __hip_atomic_load(p, __ATOMIC_RELAXED, __HIP_MEMORY_SCOPE_AGENT); }
__device__ __forceinline__ unsigned xb_add(unsigned* p, unsigned v) { return __hip_atomic_fetch_add(p, v, __ATOMIC_RELAXED, __HIP_MEMORY_SCOPE_AGENT); }
__device__ __forceinline__ unsigned xb_xcc_id() { return (unsigned)__builtin_amdgcn_s_getreg((3 << 11) | 20) & 0xFu; }
#define XB_SPIN(cond, bar) do { unsigned _sp = 0; while (cond) { __builtin_amdgcn_s_sleep(1); \
    if ((++_sp & 255u) == 0u) { if (xb_ld(&(bar)[XB_TMO])) break; if (_sp > XB_SPIN_CAP) { atomicAdd(&(bar)[XB_TMO], 1u); break; } } } } while (0)

struct XcdBarrier {
    unsigned* bar; unsigned x; unsigned G;
    volatile LAS unsigned* st;
};

__device__ __forceinline__ XcdBarrier xcd_barrier_post(unsigned* bar, volatile LAS unsigned* st, unsigned G) {
    XcdBarrier b; b.bar = bar; b.x = xb_xcc_id(); b.st = st; b.G = G;
    if (threadIdx.x == 0) (void)xb_add(&bar[XB_XCNT(b.x)], 1u);
    return b;
}
__device__ __forceinline__ void xcd_barrier_complete(unsigned* bar, unsigned x, unsigned G, unsigned& nloc, unsigned& nx) {
    unsigned sum, cnt, mine, sp = 0u;
    for (;;) {
        sum = 0u; cnt = 0u; mine = 0u;
#pragma unroll
        for (unsigned j = 0; j < 16; ++j) { const unsigned c = xb_ld(&bar[XB_XCNT(j)]); sum += c; cnt += (c > 0u) ? 1u : 0u; mine = (j == x) ? c : mine; }
        if (sum == G) break;
        __builtin_amdgcn_s_sleep(1);
        if ((++sp & 255u) == 0u) { if (xb_ld(&bar[XB_TMO])) break; if (sp > XB_SPIN_CAP) { atomicAdd(&bar[XB_TMO], 1u); break; } }
    }
    nloc = mine > 0u ? mine : 1u; nx = cnt > 0u ? cnt : 1u;
}

__device__ __forceinline__ void xcd_barrier(const XcdBarrier& b) {
    asm volatile("s_waitcnt vmcnt(0)" ::: "memory");
    __syncthreads();
    if (threadIdx.x == 0) {
        unsigned* bar = b.bar;
        __builtin_amdgcn_s_waitcnt(0);
        unsigned nloc = b.st[0], nx = b.st[1];
        if (nloc == 0u) { xcd_barrier_complete(bar, b.x, b.G, nloc, nx); b.st[0] = nloc; b.st[1] = nx; }
        const unsigned old = xb_add(&bar[XB_XSUB(b.x)], 1u);
        const unsigned gen = old / nloc;
        if (old + 1u == (gen + 1u) * nloc) {
            __builtin_amdgcn_fence(__ATOMIC_RELEASE, "agent");
            asm volatile("s_waitcnt vmcnt(0)" ::: "memory");
            const unsigned og = xb_add(&bar[XB_TOP], 1u);
            const unsigned tg = og / nx;
            if (og + 1u == (tg + 1u) * nx) xb_add(&bar[XB_TOPGEN], 1u);
            else XB_SPIN(xb_ld(&bar[XB_TOPGEN]) == tg, bar);
            __builtin_amdgcn_fence(__ATOMIC_ACQUIRE, "agent");
            xb_add(&bar[XB_XGEN(b.x)], 1u);
            asm volatile("s_waitcnt vmcnt(0)" ::: "memory");
        } else {
            XB_SPIN(xb_ld(&bar[XB_XGEN(b.x)]) == gen, bar);
            __builtin_amdgcn_fence(__ATOMIC_ACQUIRE, "agent");
            asm volatile("s_waitcnt vmcnt(0)" ::: "memory");
        }
    }
    __syncthreads();
}

struct Frame {
    LAS unsigned char* lds;
    int tid, lane, wave;
    int grp, c, row0, sw;
    const float *x, *g_pre, *w_in, *conv_w, *pool_w, *pool_scale, *w_out, *g_post, *g_fpre, *w_gate, *w_up, *w_down, *g_fpost;
    float* out; unsigned char* ws;
};

__device__ __forceinline__ int opq(int v) { asm volatile("" : "+v"(v)); return v; }
__device__ __forceinline__ unsigned pkbf(float lo, float hi) { return pg8::cvt_pk_bf16(lo, hi); }
constexpr int TSCR_BYTES = 64 * 65 * 4;
struct TItem { const float* W; bf16* WT; int K, N, drow0, k0, n0; };
__device__ __forceinline__ TItem titem(const float* W, int K, int N, bf16* WT, int mode, int item) {
    TItem t; t.W = W; t.WT = WT; t.K = K; t.N = N;
    const int nblk = N / 64, kb = item / nblk, nb = item % nblk; t.k0 = 64 * kb; t.n0 = 64 * nb;
    t.drow0 = mode == 0 ? t.n0 : ((t.n0 >> 7) * 256 + (t.n0 & 127) + (mode == 2 ? 128 : 0));
    return t;
}
__device__ __forceinline__ void titem_load(const TItem& t, f32x4 (&r)[16], int lane) {
    const GAS f32x4* src = (const GAS f32x4*)(t.W + (size_t)(t.k0 + (lane >> 4)) * t.N + t.n0 + 4 * (lane & 15));
#pragma unroll
    for (int i = 0; i < 16; ++i) r[i] = __builtin_nontemporal_load(src + (size_t)i * t.N);
}
template <bool NTS>
__device__ __forceinline__ void titem_store(const TItem& t, const f32x4 (&r)[16], LAS float* scr, int lane) {
#pragma unroll
    for (int i = 0; i < 16; ++i) { LAS float* d = scr + (4 * i + (lane >> 4)) * 65 + 4 * (lane & 15); d[0] = r[i].x; d[1] = r[i].y; d[2] = r[i].z; d[3] = r[i].w; }
    LDS_WAIT(); asm volatile("" ::: "memory");
    const int c = lane & 7;
#pragma unroll
    for (int j = 0; j < 8; ++j) { const int n = (lane >> 3) + 8 * j; const LAS float* s = scr + (8 * c) * 65 + n;
        v4u o; o.x = pkbf(s[0 * 65], s[1 * 65]); o.y = pkbf(s[2 * 65], s[3 * 65]); o.z = pkbf(s[4 * 65], s[5 * 65]); o.w = pkbf(s[6 * 65], s[7 * 65]);
        if (NTS) __builtin_nontemporal_store(o, (GAS v4u*)(t.WT + (size_t)(t.drow0 + n) * t.K + t.k0 + 8 * c)); else *(GAS v4u*)(t.WT + (size_t)(t.drow0 + n) * t.K + t.k0 + 8 * c) = o; }
    LDS_WAIT(); asm volatile("" ::: "memory");
}
__device__ __forceinline__ TItem win_item(Frame& F, int r) {
    constexpr int I_IN = (D / 64) * (NPROJ / 64), I_OUT = (D / 64) * (D / 64), I_P1 = (256 / 64) * (256 / 64);
    if (r < I_IN) return titem(F.w_in, D, NPROJ, (bf16*)(F.ws + WS_WIN), 0, r);
    r -= I_IN;
    if (r < I_OUT) return titem(F.w_out, D, D, (bf16*)(F.ws + WS_WOUT), 0, r);
    r -= I_OUT;
    const int g = r / I_P1; return titem(F.pool_w + (size_t)g * 65536, 256, 256, (bf16*)(F.ws + WS_WPOOL) + (size_t)g * 65536, 0, r % I_P1);
}
__device__ __forceinline__ TItem wrest_item(Frame& F, int r) {
    constexpr int I_G = (D / 64) * (FF / 64);
    if (r < I_G) return titem(F.w_gate, D, FF, (bf16*)(F.ws + WS_WGU), 1, r);
    r -= I_G;
    if (r < I_G) return titem(F.w_up, D, FF, (bf16*)(F.ws + WS_WGU), 2, r);
    r -= I_G;
    return titem(F.w_down, FF, D, (bf16*)(F.ws + WS_WD), 0, r);
}
template <bool REST>
__device__ __forceinline__ void p0_weights(Frame& F) {
    LAS float* scr = (LAS float*)(F.lds + F.wave * TSCR_BYTES);
    const int gw = F.c * NWAVES + F.wave, NGW = GW * NWAVES;
    constexpr int NITEMS = REST ? 2 * (D / 64) * (FF / 64) + (FF / 64) * (D / 64) : (D / 64) * (NPROJ / 64) + (D / 64) * (D / 64) + 4 * 16;
    int it = gw; if (it >= NITEMS) return;
    TItem cur = REST ? wrest_item(F, it) : win_item(F, it); f32x4 rc[16]; titem_load(cur, rc, F.lane);
#pragma unroll 1
    for (;;) {
        const int itn = it + NGW; const bool has = itn < NITEMS;
        TItem nxt = cur; f32x4 rn[16];
        if (has) { nxt = REST ? wrest_item(F, itn) : win_item(F, itn); titem_load(nxt, rn, F.lane); }
        titem_store<REST>(cur, rc, scr, F.lane);
        if (!has) break;
        cur = nxt; it = itn;
#pragma unroll
        for (int i = 0; i < 16; ++i) rc[i] = rn[i];
    }
}
__device__ __forceinline__ void p0_hrows(Frame& F) {
    const int gw = F.c * NWAVES + F.wave, NGW = GW * NWAVES;
    f32x4 gv[8];
#pragma unroll
    for (int j = 0; j < 8; ++j) gv[j] = ((const GAS f32x4*)F.g_pre)[F.lane + 64 * j];
    bf16* H = (bf16*)(F.ws + WS_H);
    for (int blk = gw; blk < MG / 8; blk += NGW) {
        const int m0 = F.row0 + 8 * blk;
        f32x4 v[2][8], w[2][8];
#pragma unroll
        for (int q = 0; q < 2; ++q) { const GAS f32x4* xr = (const GAS f32x4*)(F.x + (size_t)(m0 + q) * D) + F.lane;
#pragma unroll
            for (int j = 0; j < 8; ++j) v[q][j] = __builtin_nontemporal_load(xr + 64 * j); }
#pragma unroll 1
        for (int pr = 0; pr < 4; ++pr) {
            if (pr < 3) {
#pragma unroll
                for (int q = 0; q < 2; ++q) { const GAS f32x4* xr = (const GAS f32x4*)(F.x + (size_t)(m0 + 2 * pr + 2 + q) * D) + F.lane;
#pragma unroll
                    for (int j = 0; j < 8; ++j) w[q][j] = __builtin_nontemporal_load(xr + 64 * j); } }
#pragma unroll
            for (int q = 0; q < 2; ++q) { float s = 0.f;
#pragma unroll
                for (int j = 0; j < 8; ++j) s += (v[q][j].x * v[q][j].x + v[q][j].y * v[q][j].y) + (v[q][j].z * v[q][j].z + v[q][j].w * v[q][j].w);
                const float rstd = 1.0f / sqrtf(wave_sum(s) * (1.0f / D) + EPS);
                GAS v2u* o8 = (GAS v2u*)(H + (size_t)(m0 + 2 * pr + q) * D) + F.lane;
#pragma unroll
                for (int j = 0; j < 8; ++j) { const f32x4 y = v[q][j] * rstd * gv[j]; v2u o; o.x = pkbf(y.x, y.y); o.y = pkbf(y.z, y.w); o8[64 * j] = o; } }
            if (pr < 3) {
#pragma unroll
                for (int q = 0; q < 2; ++q)
#pragma unroll
                    for (int j = 0; j < 8; ++j) v[q][j] = w[q][j]; }
        }
    }
}

__device__ __forceinline__ void up8(const v4u w, float (&f)[8]) { f[0] = bflo(w.x); f[1] = bfhi(w.x); f[2] = bflo(w.y); f[3] = bfhi(w.y); f[4] = bflo(w.z); f[5] = bfhi(w.z); f[6] = bflo(w.w); f[7] = bfhi(w.w); }
__device__ __forceinline__ v4u pk8(const float (&f)[8]) { v4u o; o.x = pkbf(f[0], f[1]); o.y = pkbf(f[2], f[3]); o.z = pkbf(f[4], f[5]); o.w = pkbf(f[6], f[7]); return o; }
__device__ __forceinline__ v4u ldg16(const bf16* p) { return __builtin_nontemporal_load((const GAS v4u*)p); }
__device__ __forceinline__ void conv_pass(Frame& F, int p, int t0, int m0) {
    const int l = opq(F.lane), cb = 512 * p + 8 * l;
    const bf16* P = (const bf16*)(F.ws + WS_PROJ) + cb; bf16* MIX = (bf16*)(F.ws + WS_MIXED) + cb;
    const v4u z = {0u, 0u, 0u, 0u};
    v4u hc[2], hu[2];
#pragma unroll
    for (int j = 0; j < 2; ++j) { hc[j] = z; hu[j] = z; }
    if (t0 > 0) {
#pragma unroll
        for (int j = 0; j < 2; ++j) { hc[j] = ldg16(P + (size_t)(m0 - 1 - j) * NPROJ + CW); hu[j] = ldg16(P + (size_t)(m0 - 1 - j) * NPROJ + 2 * CW); } }
    float w0[8], w1[8], w2[8];
#pragma unroll
    for (int i = 0; i < 8; ++i) { w0[i] = F.conv_w[0 * CW + cb + i]; w1[i] = F.conv_w[1 * CW + cb + i]; w2[i] = F.conv_w[2 * CW + cb + i]; }
    float cu1[8], cu2[8];
#pragma unroll 1
    for (int h = 0; h < 2; ++h) {
        v4u rb[4], rc[4], ru[4];
        const bf16* row = P + (size_t)(m0 + 4 * h) * NPROJ;
#pragma unroll
        for (int r = 0; r < 4; ++r) { rb[r] = ldg16(row + (size_t)r * NPROJ); rc[r] = ldg16(row + (size_t)r * NPROJ + CW); ru[r] = ldg16(row + (size_t)r * NPROJ + 2 * CW); }
        if (h == 0) { float c[8], u[8]; up8(hc[0], c); up8(hu[0], u);
#pragma unroll
            for (int i = 0; i < 8; ++i) cu1[i] = c[i] * u[i];
            up8(hc[1], c); up8(hu[1], u);
#pragma unroll
            for (int i = 0; i < 8; ++i) cu2[i] = c[i] * u[i]; }
#pragma unroll
        for (int r = 0; r < 4; ++r) {
            float b[8], c[8], u[8], y[8]; up8(rb[r], b); up8(rc[r], c); up8(ru[r], u);
            float ss = 0.f;
#pragma unroll
            for (int i = 0; i < 8; ++i) { const float cu0 = c[i] * u[i]; y[i] = b[i] * (w0[i] * cu2[i] + w1[i] * cu1[i] + w2[i] * cu0); ss += y[i] * y[i]; cu2[i] = cu1[i]; cu1[i] = cu0; }
            ss += __shfl_xor(ss, 1); ss += __shfl_xor(ss, 2); ss += __shfl_xor(ss, 4); ss += __shfl_xor(ss, 8);
            const float rstd = 1.0f / sqrtf(ss * (1.0f / 128.0f) + EPS);
#pragma unroll
            for (int i = 0; i < 8; ++i) y[i] *= rstd;
            *(GAS v4u*)(MIX + (size_t)(m0 + 4 * h + r) * D) = pk8(y);
            __builtin_amdgcn_sched_barrier(0);
        }
    }
}
template <int WLO, int WHI>
__device__ __forceinline__ void pool_pass(Frame& F, int p, int t0, int m0) {
    const int l = opq(F.lane); const bool lo = l < 32;
    const bf16* V = (const bf16*)(F.ws + WS_PROJ) + 3 * CW + 512 * p + 8 * l;
    bf16* PO = (bf16*)(F.ws + WS_POOLED) + ((size_t)(F.grp * 4 + 2 * p + (l >> 5)) * MG + t0) * 256 + 8 * (l & 31);
    const v4u z = {0u, 0u, 0u, 0u};
    v4u pv[WHI], cv[8];
#pragma unroll
    for (int j = 1; j < WHI; ++j) pv[j] = z;
    if (t0 >= 16) {
#pragma unroll
        for (int j = 1; j < WHI; ++j) pv[j] = ldg16(V + (size_t)(m0 - j) * NPROJ);
    } else if (t0 == 8) {
#pragma unroll
        for (int j = 1; j < WHI && j <= 8; ++j) pv[j] = ldg16(V + (size_t)(m0 - j) * NPROJ);
    }
#pragma unroll
    for (int r = 0; r < 8; ++r) cv[r] = ldg16(V + (size_t)(m0 + r) * NPROJ);
    float Wl[8], Wh[8];
#pragma unroll
    for (int i = 0; i < 8; ++i) { Wl[i] = 0.f; Wh[i] = 0.f; }
#pragma unroll
    for (int j = 1; j < WHI; ++j) { float f[8]; up8(pv[j], f);
#pragma unroll
        for (int i = 0; i < 8; ++i) { if (j < WLO) Wl[i] += f[i]; Wh[i] += f[i]; } }
#pragma unroll
    for (int r = 0; r < 8; ++r) {
        const int t = t0 + r; float v[8], o[8]; up8(cv[r], v);
        const float il = 1.0f / (float)((t + 1) < WLO ? (t + 1) : WLO), ih = 1.0f / (float)((t + 1) < WHI ? (t + 1) : WHI);
#pragma unroll
        for (int i = 0; i < 8; ++i) { Wl[i] += v[i]; Wh[i] += v[i]; o[i] = (lo ? Wl[i] * il : Wh[i] * ih) - v[i]; }
        *(GAS v4u*)(PO + (size_t)r * 256) = pk8(o);
        { float f[8]; up8((r - WLO + 1 >= 0) ? cv[(r - WLO + 1 >= 0) ? r - WLO + 1 : 0] : pv[(WLO - 1 - r > 0) ? WLO - 1 - r : 1], f);
#pragma unroll
          for (int i = 0; i < 8; ++i) Wl[i] -= f[i]; }
        { float f[8]; up8((r - WHI + 1 >= 0) ? cv[(r - WHI + 1 >= 0) ? r - WHI + 1 : 0] : pv[(WHI - 1 - r > 0) ? WHI - 1 - r : 1], f);
#pragma unroll
          for (int i = 0; i < 8; ++i) Wh[i] -= f[i]; }
        __builtin_amdgcn_sched_barrier(0);
    }
}
__device__ __forceinline__ void p2_mixer(Frame& F) {
    const int gw = F.sw * NWAVES + F.wave, NGW = GW * NWAVES;
    for (int chunk = gw; chunk < MG / 8; chunk += NGW) {
        const int t0 = chunk * 8, m0 = F.row0 + t0;
        conv_pass(F, 0, t0, m0); asm volatile("" ::: "memory"); conv_pass(F, 1, t0, m0); asm volatile("" ::: "memory");
        pool_pass<2, 4>(F, 0, t0, m0); asm volatile("" ::: "memory"); pool_pass<8, 16>(F, 1, t0, m0); asm volatile("" ::: "memory");
    }
}

__device__ __forceinline__ float sq4(const f32x4 v) { return (v.x * v.x + v.y * v.y) + (v.z * v.z + v.w * v.w); }
__device__ __forceinline__ f32x4 bf4lo(const v4u w) { return (f32x4){bflo(w.x), bfhi(w.x), bflo(w.y), bfhi(w.y)}; }
__device__ __forceinline__ f32x4 bf4hi(const v4u w) { return (f32x4){bflo(w.z), bfhi(w.z), bflo(w.w), bfhi(w.w)}; }
struct Row5 { f32x4 x[4][2]; v4u mo[4]; float p; };
__device__ __forceinline__ void ld_row5(Row5& R, const float* x, const bf16* MO, const float* part, int m, int l) {
    const GAS f32x4* xr = (const GAS f32x4*)(x + (size_t)m * D + 8 * l); const GAS v4u* mr = (const GAS v4u*)(MO + (size_t)m * D + 8 * l);
#pragma unroll
    for (int j = 0; j < 4; ++j) { R.x[j][0] = xr[128 * j]; R.x[j][1] = xr[128 * j + 1]; R.mo[j] = mr[64 * j]; }
    R.p = part[(size_t)m * 32 + (l & 31)];
}
__device__ __forceinline__ void p5_resnorm(Frame& F) {
    const int gw = F.sw * NWAVES + F.wave, NGW = GW * NWAVES, l = opq(F.lane);
    const bf16* MO = (const bf16*)(F.ws + WS_MIXOUT); const float* part = (const float*)(F.ws + WS_PART1); bf16* H = (bf16*)(F.ws + WS_H);
    LAS f32x4* G1 = (LAS f32x4*)F.lds; LAS f32x4* G2 = (LAS f32x4*)(F.lds + 8192);
    if (F.tid < 512) { G1[F.tid] = ((const GAS f32x4*)F.g_post)[F.tid]; G2[F.tid] = ((const GAS f32x4*)F.g_fpre)[F.tid]; }
    __syncthreads();
    for (int blk = gw; blk < MG / 8; blk += NGW) {
        const int m0 = F.row0 + 8 * blk;
        Row5 cur, nxt, nx2; ld_row5(cur, F.x, MO, part, m0, l); ld_row5(nxt, F.x, MO, part, m0 + 1, l);
#pragma unroll 1
        for (int r = 0; r < 8; ++r) {
            if (r + 2 < 8) ld_row5(nx2, F.x, MO, part, m0 + r + 2, l);
            const float rstd1 = 1.0f / sqrtf(wave_sum(l < 32 ? cur.p : 0.f) * (1.0f / D) + EPS);
            f32x4 v[4][2]; float s = 0.f;
#pragma unroll
            for (int j = 0; j < 4; ++j) { v[j][0] = cur.x[j][0] + bf4lo(cur.mo[j]) * rstd1 * G1[2 * l + 128 * j]; v[j][1] = cur.x[j][1] + bf4hi(cur.mo[j]) * rstd1 * G1[2 * l + 128 * j + 1]; s += sq4(v[j][0]) + sq4(v[j][1]); }
            const float rstd2 = 1.0f / sqrtf(wave_sum(s) * (1.0f / D) + EPS);
            GAS v4u* hr = (GAS v4u*)(H + (size_t)(m0 + r) * D + 8 * l);
#pragma unroll
            for (int j = 0; j < 4; ++j) { const f32x4 y0 = v[j][0] * rstd2 * G2[2 * l + 128 * j], y1 = v[j][1] * rstd2 * G2[2 * l + 128 * j + 1];
                v4u w; w.x = pkbf(y0.x, y0.y); w.y = pkbf(y0.z, y0.w); w.z = pkbf(y1.x, y1.y); w.w = pkbf(y1.z, y1.w); hr[64 * j] = w; __builtin_amdgcn_sched_barrier(0); }
            cur = nxt; nxt = nx2;
        }
    }
}
struct Row8 { f32x4 x[4][2]; v4u mo[4], ff[4]; float p1, p2; };
__device__ __forceinline__ void ld_row8(Row8& R, const float* x, const bf16* MO, const bf16* FFO, const float* part1, const float* part2, int m, int l) {
    const GAS f32x4* xr = (const GAS f32x4*)(x + (size_t)m * D + 8 * l); const GAS v4u* mr = (const GAS v4u*)(MO + (size_t)m * D + 8 * l); const GAS v4u* fr = (const GAS v4u*)(FFO + (size_t)m * D + 8 * l);
#pragma unroll
    for (int j = 0; j < 4; ++j) { R.x[j][0] = xr[128 * j]; R.x[j][1] = xr[128 * j + 1]; R.mo[j] = mr[64 * j]; R.ff[j] = fr[64 * j]; }
    R.p1 = part1[(size_t)m * 32 + (l & 31)]; R.p2 = part2[(size_t)m * 32 + (l & 31)];
}
__device__ __forceinline__ void p8_final(Frame& F) {
    const int gw = F.sw * NWAVES + F.wave, NGW = GW * NWAVES, l = opq(F.lane);
    const bf16* MO = (const bf16*)(F.ws + WS_MIXOUT); const bf16* FFO = (const bf16*)(F.ws + WS_FF);
    const float* part1 = (const float*)(F.ws + WS_PART1); const float* part2 = (const float*)(F.ws + WS_PART2);
    LAS f32x4* G1 = (LAS f32x4*)F.lds; LAS f32x4* G3 = (LAS f32x4*)(F.lds + 8192);
    if (F.tid < 512) { G1[F.tid] = ((const GAS f32x4*)F.g_post)[F.tid]; G3[F.tid] = ((const GAS f32x4*)F.g_fpost)[F.tid]; }
    __syncthreads();
    for (int blk = gw; blk < MG / 8; blk += NGW) {
        const int m0 = F.row0 + 8 * blk;
        Row8 cur, nxt, nx2; ld_row8(cur, F.x, MO, FFO, part1, part2, m0, l); ld_row8(nxt, F.x, MO, FFO, part1, part2, m0 + 1, l);
#pragma unroll 1
        for (int r = 0; r < 8; ++r) {
            if (r + 2 < 8) ld_row8(nx2, F.x, MO, FFO, part1, part2, m0 + r + 2, l);
            const float rstd1 = 1.0f / sqrtf(wave_sum(l < 32 ? cur.p1 : 0.f) * (1.0f / D) + EPS), rstd2 = 1.0f / sqrtf(wave_sum(l < 32 ? cur.p2 : 0.f) * (1.0f / D) + EPS);
            GAS f32x4* orow = (GAS f32x4*)(F.out + (size_t)(m0 + r) * D + 8 * l);
#pragma unroll
            for (int j = 0; j < 4; ++j) { orow[128 * j] = cur.x[j][0] + bf4lo(cur.mo[j]) * rstd1 * G1[2 * l + 128 * j] + bf4lo(cur.ff[j]) * rstd2 * G3[2 * l + 128 * j];
                orow[128 * j + 1] = cur.x[j][1] + bf4hi(cur.mo[j]) * rstd1 * G1[2 * l + 128 * j + 1] + bf4hi(cur.ff[j]) * rstd2 * G3[2 * l + 128 * j + 1]; __builtin_amdgcn_sched_barrier(0); }
            cur = nxt; nxt = nx2;
        }
    }
}

__device__ __forceinline__ void flag_set(unsigned* flag) { __hip_atomic_store(flag, 1u, __ATOMIC_RELAXED, __HIP_MEMORY_SCOPE_AGENT); }
__device__ __forceinline__ void flag_wait(unsigned* flag, unsigned* tmo) {
    if (threadIdx.x == 0) {
        unsigned sp = 0u;
        while (xb_ld(flag) == 0u) { __builtin_amdgcn_s_sleep(2); if ((++sp & 255u) == 0u) { if (xb_ld(tmo)) break; if (sp > XB_SPIN_CAP) { atomicAdd(tmo, 1u); break; } } }
        __builtin_amdgcn_fence(__ATOMIC_ACQUIRE, "agent");
        asm volatile("s_waitcnt vmcnt(0)" ::: "memory");
    }
    __syncthreads();
}

__device__ __forceinline__ void slab_barrier(unsigned* cnt, unsigned target, unsigned* tmo, unsigned samex) {
    asm volatile("s_waitcnt vmcnt(0)" ::: "memory");
    __syncthreads();
    if (threadIdx.x == 0) {
        if (!samex) { __builtin_amdgcn_fence(__ATOMIC_RELEASE, "agent"); asm volatile("s_waitcnt vmcnt(0)" ::: "memory"); }
        (void)xb_add(cnt, 1u);
        unsigned sp = 0u;
        while (xb_ld(cnt) < target) { __builtin_amdgcn_s_sleep(1); if ((++sp & 255u) == 0u) { if (xb_ld(tmo)) break; if (sp > XB_SPIN_CAP) { atomicAdd(tmo, 1u); break; } } }
        __builtin_amdgcn_fence(__ATOMIC_ACQUIRE, "agent");
        asm volatile("s_waitcnt vmcnt(0)" ::: "memory");
    }
    __syncthreads();
}
struct SlabPoolOrder {
    int c;
    __device__ __forceinline__ bool next(int i, pg8::Unit& u) const { if (i) return false; u.pm = ((c >> 3) >> 2) * 32 + 4 * (c & 7) + ((c >> 3) & 3); u.pn = 0; return true; }
    __device__ __forceinline__ void a_ready(const pg8::Unit&) const {}
    __device__ __forceinline__ void done(const pg8::Unit&) const {}
};

#ifndef WGMG
#define WGMG 4
#endif
constexpr int NXG = 8;
struct Args { const float* in[13]; float* out; unsigned char* ws; };
__global__ void __launch_bounds__(NWAVES * 64, 2) mk_fwd(Args args) {
    extern __shared__ __attribute__((aligned(16))) unsigned char lds[];
    Frame F;
    F.lds = (LAS unsigned char*)lds;
    F.tid = threadIdx.x; F.lane = F.tid & 63; F.wave = __builtin_amdgcn_readfirstlane(F.tid >> 6);
    { const int bx = blockIdx.x; F.grp = (bx >> 3) & 1; F.c = (bx >> 4) * 8 + (bx & 7); F.row0 = F.grp * MG; F.sw = (F.c & 7) * 16 + (F.c >> 3); }
    F.x = args.in[0]; F.g_pre = args.in[1]; F.w_in = args.in[2]; F.conv_w = args.in[3]; F.pool_w = args.in[4]; F.pool_scale = args.in[5]; F.w_out = args.in[6];
    F.g_post = args.in[7]; F.g_fpre = args.in[8]; F.w_gate = args.in[9]; F.w_up = args.in[10]; F.w_down = args.in[11]; F.g_fpost = args.in[12];
    F.out = args.out; F.ws = args.ws;
    unsigned char* ws = args.ws;
    unsigned* ctl = (unsigned*)(ws + WS_CTL);
    volatile LAS unsigned* MISC = (volatile LAS unsigned*)(F.lds + MISC_OFF);
    if (F.tid < 64) MISC[F.tid] = 0u;
    __syncthreads();
    const XcdBarrier bar = xcd_barrier_post(ctl + 4096 * F.grp, MISC + 8, (unsigned)GW);
    unsigned* flagA = ctl + CW_FLAG; unsigned* flagB = ctl + CW_FLAG + 64; unsigned* tmo = ctl + 4096 * F.grp + XB_TMO;
#define BAR() xcd_barrier(bar)
    unsigned* slabcnt = ctl + CW_SLAB + 64 * (8 * F.grp + (F.c & 7));
    if (F.tid == 0) (void)__hip_atomic_fetch_or(slabcnt + 1, 1u << bar.x, __ATOMIC_RELAXED, __HIP_MEMORY_SCOPE_AGENT);
    unsigned samex = 0u;
#define SBAR(k) slab_barrier(slabcnt, 16u * (k), ctl + 4096 * F.grp + XB_TMO, samex)
#ifndef PROBE_B
#define PROBE_G 0
#define PROBE_A 0
#define PROBE_B 0
#define PROBE_MUL 4
#endif
    unsigned long long* stamps = (unsigned long long*)(ctl + 8192);
#define STAMP(k) do { if (PROBE_B > PROBE_A && F.c == 0 && F.tid == 0) __hip_atomic_store(stamps + F.grp * 16 + (k), (unsigned long long)__builtin_amdgcn_s_memrealtime(), __ATOMIC_RELAXED, __HIP_MEMORY_SCOPE_AGENT); } while (0)
    STAMP(0);
    typedef pg8::bf16_t bt;
    const size_t r0 = (size_t)F.row0;
    if (F.grp == 0) { p0_weights<false>(F); p0_hrows(F); BAR(); if (F.c == 0 && F.tid == 0) flag_set(flagA); }
    else { p0_weights<true>(F); p0_hrows(F); BAR(); if (F.c == 0 && F.tid == 0) flag_set(flagB); flag_wait(flagA, tmo); }
    STAMP(1);
#ifndef PHMASK
#define PHMASK 0x1ff
#endif
    if (PHMASK & 2) {
        pg8::Gemm g{(const bt*)(ws + WS_H) + r0 * D, (const bt*)(ws + WS_WIN), MG, NPROJ, D, 0}; pg8::StaticOrder S; S.init(MG, NPROJ, GW, F.c, NXG, WGMG);
        pg8::EpiBf16 E{(bt*)(ws + WS_PROJ) + r0 * NPROJ, NPROJ};
        pg8::gemm_phase<pg8::EpiBf16, pg8::StaticOrder, true, true>(F.lds, g, S, E);
    }
    BAR(); STAMP(2);
    if (F.tid == 0) MISC[12] = (__builtin_popcount(xb_ld(slabcnt + 1)) == 1) ? 1u : 0u;
    __syncthreads();
    samex = MISC[12];
    if (PHMASK & 4) p2_mixer(F);
    SBAR(1);
    STAMP(3);
    if (PHMASK & 8) {
        int kpool = 256; asm volatile("" : "+s"(kpool));
        pg8::Gemm g{(const bt*)(ws + WS_POOLED) + (size_t)F.grp * 4 * MG * 256, (const bt*)(ws + WS_WPOOL), 4 * MG, 256, kpool, MG / 256}; SlabPoolOrder S{F.c};
        pg8::EpiPool E{(bt*)(ws + WS_MIXED) + r0 * D, D, F.pool_scale, (LAS float*)(F.lds + EPI_SCR_OFF), EPS, 5};
        pg8::gemm_phase<pg8::EpiPool, SlabPoolOrder, false, true>(F.lds, g, S, E);
    }
    SBAR(2); STAMP(4);
    if (PHMASK & 16) {
        pg8::Gemm g{(const bt*)(ws + WS_MIXED) + r0 * D, (const bt*)(ws + WS_WOUT), MG, D, D, 0}; pg8::StaticOrder S; S.init(MG, D, GW, F.c, NXG, WGMG);
        pg8::EpiBf16Stat E{(bt*)(ws + WS_MIXOUT) + r0 * D, D, (float*)(ws + WS_PART1) + r0 * 32};
        pg8::gemm_phase<pg8::EpiBf16Stat, pg8::StaticOrder, false, true>(F.lds, g, S, E);
    }
    SBAR(3); STAMP(5);
    if (F.tid == 0) (void)xb_add(ctl + CW_P4 + 64 * F.grp, 1u);
    if (PHMASK & 32) p5_resnorm(F);
    SBAR(4);
    if (F.tid == 0) { unsigned sp = 0u; unsigned* w = ctl + CW_P4 + 64 * F.grp;
        while (xb_ld(w) < (unsigned)GW) { __builtin_amdgcn_s_sleep(2); if ((++sp & 255u) == 0u) { if (xb_ld(tmo)) break; if (sp > XB_SPIN_CAP) { atomicAdd(tmo, 1u); break; } } } }
    __syncthreads();
    if (F.grp == 0) flag_wait(flagB, tmo);
    STAMP(6);
    if (PHMASK & 64) {
        pg8::Gemm g{(const bt*)(ws + WS_H) + r0 * D, (const bt*)(ws + WS_WGU), MG, 2 * FF, D, 0}; pg8::StaticOrder S; S.init(MG, 2 * FF, GW, F.c, NXG, WGMG);
        pg8::EpiSwiGLU E{(bt*)(ws + WS_ACT) + r0 * FF, FF};
        pg8::gemm_phase<pg8::EpiSwiGLU, pg8::StaticOrder, false, true>(F.lds, g, S, E);
    }
    SBAR(5); STAMP(7);
    if (PHMASK & 128) {
        pg8::Gemm g{(const bt*)(ws + WS_ACT) + r0 * FF, (const bt*)(ws + WS_WD), MG, D, FF, 0}; pg8::StaticOrder S; S.init(MG, D, GW, F.c, NXG, WGMG);
        pg8::EpiBf16Stat E{(bt*)(ws + WS_FF) + r0 * D, D, (float*)(ws + WS_PART2) + r0 * 32};
        pg8::gemm_phase<pg8::EpiBf16Stat, pg8::StaticOrder, false, true>(F.lds, g, S, E);
    }
    SBAR(6); STAMP(8);
    if (PHMASK & 256) p8_final(F);
    if (PROBE_B > PROBE_A) {
        asm volatile("s_waitcnt vmcnt(0)" ::: "memory"); __syncthreads(); STAMP(9);
        if (F.grp == 1 && F.c == 0 && F.tid == 0) {
            asm volatile("s_waitcnt vmcnt(0)" ::: "memory");
            const unsigned long long a = __hip_atomic_load(stamps + PROBE_G * 16 + PROBE_A, __ATOMIC_RELAXED, __HIP_MEMORY_SCOPE_AGENT), b = __hip_atomic_load(stamps + PROBE_G * 16 + PROBE_B, __ATOMIC_RELAXED, __HIP_MEMORY_SCOPE_AGENT);
            const unsigned long long span = (b > a && b - a < 400000ull) ? (b - a) * PROBE_MUL : 1000000ull;
            const unsigned long long t0 = __builtin_amdgcn_s_memrealtime();
            while (__builtin_amdgcn_s_memrealtime() - t0 < span) __builtin_amdgcn_s_sleep(8);
        }
    }
#undef BAR
#undef SBAR
#undef STAMP
}

extern "C" void kernel_launch(void* const* d_in, const int* in_sizes, int n_in, void* d_out, int out_size, void* d_ws, size_t ws_size, hipStream_t stream) {
    static int grid = 0;
    if (grid == 0) {
        if (n_in != 13 || in_sizes[0] != M * D || out_size != M * D || ws_size < WS_END) { fprintf(stderr, "kernel_launch: shape/workspace mismatch (n_in %d, in0 %d, out %d, ws %zu, need %zu); nothing launched\n", n_in, n_in > 0 ? in_sizes[0] : -1, out_size, ws_size, (size_t)WS_END); grid = -1; return; }
        int dev = 0, cus = 0, per_cu = 0;
        if (hipGetDevice(&dev) != hipSuccess || hipDeviceGetAttribute(&cus, hipDeviceAttributeMultiprocessorCount, dev) != hipSuccess) { fprintf(stderr, "kernel_launch: device query failed\n"); grid = -1; return; }
        if (hipFuncSetAttribute((const void*)mk_fwd, hipFuncAttributeMaxDynamicSharedMemorySize, LDS_BYTES) != hipSuccess) { fprintf(stderr, "kernel_launch: hipFuncSetAttribute failed\n"); grid = -1; return; }
        if (hipOccupancyMaxActiveBlocksPerMultiprocessor(&per_cu, (const void*)mk_fwd, NWAVES * 64, LDS_BYTES) != hipSuccess || per_cu < 1) { fprintf(stderr, "kernel_launch: occupancy query says %d blocks per CU\n", per_cu); per_cu = 1; }
        (void)hipGetLastError();
        if (cus * per_cu < NGRP * GW) { fprintf(stderr, "kernel_launch: needs %d co-resident workgroups, the device holds %d; nothing launched\n", NGRP * GW, cus * per_cu); grid = -1; return; }
        grid = NGRP * GW;
    }
    if (grid < 0) return;
    Args a{};
    for (int i = 0; i < 13; ++i) a.in[i] = (const float*)d_in[i];
    a.out = (float*)d_out; a.ws = (unsigned char*)d_ws;
    if (hipMemsetAsync((char*)d_ws + WS_CTL, 0, CTL_ZERO_BYTES, stream) != hipSuccess) { fprintf(stderr, "kernel_launch: hipMemsetAsync failed\n"); return; }
    hipLaunchKernelGGL(mk_fwd, dim3(grid), dim3(NWAVES * 64), LDS_BYTES, stream, a);
    const hipError_t e = hipPeekAtLastError();
    if (e != hipSuccess) fprintf(stderr, "kernel_launch: launch failed: %s (grid %d)\n", hipGetErrorString(e), grid);
}
```

```cpp
#include <hip/hip_runtime.h>
#include <cstdio>
#include <cstdint>
namespace pg8 {
#define PG8_LAS __attribute__((address_space(3)))
typedef unsigned short bf16_t;
typedef short bf16x8 __attribute__((ext_vector_type(8)));
typedef float f32x4 __attribute__((ext_vector_type(4)));
typedef unsigned u32x4 __attribute__((ext_vector_type(4)));
constexpr int BM = 256, BK = 64, HALF = 128, HTB = HALF * BK * 2  , STAGE_BYTES = 8 * HTB, NXCD = 8, WGM = 8;

__host__ __device__ __forceinline__ int lds_byte(int r, int c) { const int st = (r >> 4) * 2 + (c >> 5), rr = r & 15, cc = c & 31, ob = rr * 64 + cc * 2; return st * 1024 + (ob ^ (((ob >> 9) & 1) << 5)); }
__host__ __device__ __forceinline__ void stage_rc(int b, int& R, int& C) { const int st = b / 1024, sb = b % 1024, swz = sb ^ (((sb >> 9) & 1) << 5); R = (st >> 1) * 16 + swz / 64; C = (st & 1) * 32 + (swz % 64) / 2; }
__host__ __device__ __forceinline__ int perm32(int rho) { const int n = rho >> 4, i = rho & 15; return 8 * (i >> 2) + 4 * n + (i & 3); }

struct Unit { int pm, pn; };
struct Gemm { const bf16_t* A; const bf16_t* Bt; int M, N, K; int bdiv; };
__device__ __forceinline__ int btile(const Gemm& g, const Unit& u) { return u.pn + (g.bdiv ? (u.pm / g.bdiv) * (g.N / BM) : 0); }

struct StaticOrder {
    int nM, nN, nwg, G, c, nxcd, wgm;
    __host__ __device__ void init(int M, int N, int G_, int c_, int nxcd_, int wgm_ = WGM) { nM = M / BM; nN = N / BM; nwg = nM * nN; G = G_; c = c_; nxcd = nxcd_; wgm = wgm_; }
    __host__ __device__ bool next(int i, Unit& u) const {
        const long L = (long)i * G + c; if (L >= nwg) return false;
        int wgid = (int)L; { const int q = nwg / nxcd, r = nwg % nxcd, xcd = wgid % nxcd, off = wgid / nxcd; wgid = (xcd < r ? xcd * (q + 1) : r * (q + 1) + (xcd - r) * q) + off; }
        const int nig = wgm * nN, gid = wgid / nig, fm = gid * wgm, gsz = (nM - fm) < wgm ? (nM - fm) : wgm;
        u.pm = fm + ((wgid % nig) % gsz); u.pn = (wgid % nig) / gsz; return true;
    }
    __device__ __forceinline__ void a_ready(const Unit&) const {}
    __device__ __forceinline__ void done(const Unit&) const {}
};

__device__ __forceinline__ unsigned cvt_pk_bf16(float lo, float hi) { unsigned r; asm volatile("v_cvt_pk_bf16_f32 %0, %1, %2" : "=v"(r) : "v"(lo), "v"(hi)); return r; }

struct EpiBf16 {
    static constexpr bool PERM = true, AFTER_DRAIN = false;
    bf16_t* O; int ldc;
    __device__ __forceinline__ void operator()(const f32x4 (&acc)[2][2][4][2], const Unit& u, int wr, int wc, int fr, int fq) const {
        const int row0 = u.pm * BM + wr * 64 + fr; const int col0 = u.pn * BM + wc * 32 + 8 * fq;
#pragma unroll
        for (int ai = 0; ai < 2; ++ai)
#pragma unroll
            for (int m = 0; m < 4; ++m) { bf16_t* rowp = O + (size_t)(row0 + ai * HALF + m * 16) * ldc + col0;
#pragma unroll
                for (int bj = 0; bj < 2; ++bj) { const f32x4 v0 = acc[ai][bj][m][0], v1 = acc[ai][bj][m][1];
                    u32x4 w; w.x = cvt_pk_bf16(v0[0], v0[1]); w.y = cvt_pk_bf16(v0[2], v0[3]); w.z = cvt_pk_bf16(v1[0], v1[1]); w.w = cvt_pk_bf16(v1[2], v1[3]);
                    __builtin_nontemporal_store(w, (u32x4*)(rowp + bj * HALF)); } }
    }
};

__device__ __forceinline__ float silu_mul(float g, float u) { const float e = __builtin_amdgcn_exp2f(g * -1.4426950408889634f); return g * __builtin_amdgcn_rcpf(1.0f + e) * u; }
struct EpiSwiGLU {
    static constexpr bool PERM = true, AFTER_DRAIN = false;
    bf16_t* O; int ldc;
    __device__ __forceinline__ void operator()(const f32x4 (&acc)[2][2][4][2], const Unit& u, int wr, int wc, int fr, int fq) const {
        const int row0 = u.pm * BM + wr * 64 + fr; const int col0 = u.pn * HALF + wc * 32 + 8 * fq;
#pragma unroll
        for (int ai = 0; ai < 2; ++ai)
#pragma unroll
            for (int m = 0; m < 4; ++m) { bf16_t* rowp = O + (size_t)(row0 + ai * HALF + m * 16) * ldc + col0;
                const f32x4 g0 = acc[ai][0][m][0], g1 = acc[ai][0][m][1], u0 = acc[ai][1][m][0], u1 = acc[ai][1][m][1];
                u32x4 w; w.x = cvt_pk_bf16(silu_mul(g0[0], u0[0]), silu_mul(g0[1], u0[1])); w.y = cvt_pk_bf16(silu_mul(g0[2], u0[2]), silu_mul(g0[3], u0[3]));
                w.z = cvt_pk_bf16(silu_mul(g1[0], u1[0]), silu_mul(g1[1], u1[1])); w.w = cvt_pk_bf16(silu_mul(g1[2], u1[2]), silu_mul(g1[3], u1[3]));
                __builtin_nontemporal_store(w, (u32x4*)rowp); }
    }
};

struct EpiBf16Stat {
    static constexpr bool PERM = true, AFTER_DRAIN = false;
    bf16_t* O; int ldc; float* part;
    __device__ __forceinline__ void operator()(const f32x4 (&acc)[2][2][4][2], const Unit& u, int wr, int wc, int fr, int fq) const {
        const int col0 = u.pn * BM + wc * 32 + 8 * fq;
#pragma unroll
        for (int ai = 0; ai < 2; ++ai)
#pragma unroll
            for (int m = 0; m < 4; ++m) { const int r = u.pm * BM + ai * HALF + wr * 64 + m * 16 + fr; bf16_t* rowp = O + (size_t)r * ldc + col0; float s = 0.f;
#pragma unroll
                for (int bj = 0; bj < 2; ++bj) { const f32x4 v0 = acc[ai][bj][m][0], v1 = acc[ai][bj][m][1];
                    s += ((v0[0] * v0[0] + v0[1] * v0[1]) + (v0[2] * v0[2] + v0[3] * v0[3])) + ((v1[0] * v1[0] + v1[1] * v1[1]) + (v1[2] * v1[2] + v1[3] * v1[3]));
                    u32x4 w; w.x = cvt_pk_bf16(v0[0], v0[1]); w.y = cvt_pk_bf16(v0[2], v0[3]); w.z = cvt_pk_bf16(v1[0], v1[1]); w.w = cvt_pk_bf16(v1[2], v1[3]);
                    *(u32x4*)(rowp + bj * HALF) = w; }
                s += __shfl_xor(s, 16); s += __shfl_xor(s, 32);
                if (fq == 0) part[(size_t)r * 32 + u.pn * 4 + wc] = s; }
    }
};

struct EpiPool {
    static constexpr bool PERM = true, AFTER_DRAIN = true;
    bf16_t* O; int ldc; const float* scale; PG8_LAS float* scr; float eps; int sh;
    __device__ __forceinline__ void fused(const f32x4 (&acc)[2][2][4][2], const Unit& u, int wr, int wc, int fr, int fq, PG8_LAS unsigned char*, int, int) const {
        const int grp = u.pm >> sh, rb = u.pm & ((1 << sh) - 1);
#pragma unroll
        for (int ai = 0; ai < 2; ++ai)
#pragma unroll
            for (int m = 0; m < 4; ++m) { float s = 0.f;
#pragma unroll
                for (int bj = 0; bj < 2; ++bj)
#pragma unroll
                    for (int n = 0; n < 2; ++n) { const f32x4 v = acc[ai][bj][m][n]; s += (v[0] * v[0] + v[1] * v[1]) + (v[2] * v[2] + v[3] * v[3]); }
                s += __shfl_xor(s, 16); s += __shfl_xor(s, 32);
                if (fq == 0) scr[(ai * HALF + wr * 64 + m * 16 + fr) * 4 + wc] = s;
                asm volatile("" ::: "memory"); }
        asm volatile("s_waitcnt lgkmcnt(0)" ::: "memory"); __builtin_amdgcn_s_barrier(); asm volatile("" ::: "memory");
        const int gc0 = grp * BM + wc * 32 + 8 * fq;
#pragma unroll
        for (int ai = 0; ai < 2; ++ai)
#pragma unroll
            for (int m = 0; m < 4; ++m) { const int rl = ai * HALF + wr * 64 + m * 16 + fr; const f32x4 p = *(const PG8_LAS f32x4*)(scr + rl * 4);
                const float rstd = __builtin_amdgcn_rsqf(((p[0] + p[1]) + (p[2] + p[3])) * (1.0f / 256.0f) + eps);
                bf16_t* rowp = O + (size_t)(rb * BM + rl) * ldc + 1024 + gc0;
#pragma unroll
                for (int bj = 0; bj < 2; ++bj) { const f32x4 s0 = *(const f32x4*)(scale + gc0 + bj * HALF), s1 = *(const f32x4*)(scale + gc0 + bj * HALF + 4);
                    const f32x4 v0 = acc[ai][bj][m][0] * rstd * s0, v1 = acc[ai][bj][m][1] * rstd * s1;
                    u32x4 w; w.x = cvt_pk_bf16(v0[0], v0[1]); w.y = cvt_pk_bf16(v0[2], v0[3]); w.z = cvt_pk_bf16(v1[0], v1[1]); w.w = cvt_pk_bf16(v1[2], v1[3]);
                    *(u32x4*)(rowp + bj * HALF) = w; }
                asm volatile("" ::: "memory"); }
        asm volatile("s_waitcnt lgkmcnt(0)" ::: "memory"); __builtin_amdgcn_s_barrier(); asm volatile("" ::: "memory");
    }
};

template <class Epi, class Sched, bool ALIGN_EPI = false, bool SP2 = false>
__device__ __forceinline__ void gemm_phase(PG8_LAS unsigned char* lds, const Gemm g, const Sched& S, const Epi& E) {
    const int tid = threadIdx.x, wid = __builtin_amdgcn_readfirstlane(tid >> 6), lane = tid & 63, wr = wid >> 2, wc = wid & 3, fr = lane & 15, fq = lane >> 4;
    const int K = g.K, nt = K / BK;
    unsigned voffA[2], voffB[2];
#pragma unroll
    for (int i = 0; i < 2; ++i) { int R, C; stage_rc(tid * 16 + i * 8192, R, C); const int Rb = Epi::PERM ? ((R & ~31) + perm32(R & 31)) : R;
        voffA[i] = (unsigned)(R * K + C) * 2u; voffB[i] = (unsigned)(Rb * K + C) * 2u; }
    const size_t kstep = (size_t)(BK * 2);
    const size_t hstep = (size_t)HALF * K * 2;
    const size_t tstep = 2 * hstep;
    const unsigned ldsw = (unsigned)wid * 1024u;
    const int aoff = lds_byte(wr * 64 + fr, fq * 8), boff = lds_byte(wc * 32 + fr, fq * 8);
#define PG8_SA(b, h) (((b) * 2 + (h)) * HTB)
#define PG8_SB(b, h) ((4 + (b) * 2 + (h)) * HTB)
#define PG8_STAGE(bufoff, gbase, voff) do { _Pragma("unroll") for (int _i = 0; _i < 2; ++_i) \
        __builtin_amdgcn_global_load_lds((const unsigned*)((const char*)(gbase) + (voff)[_i]), (PG8_LAS unsigned*)(lds + (bufoff) + ldsw + _i * 8192), 16, 0, 0); } while (0)
#define PG8_LDA(dst, b, h) do { _Pragma("unroll") for (int m = 0; m < 4; ++m) _Pragma("unroll") for (int k = 0; k < 2; ++k) dst[m][k] = *(const PG8_LAS bf16x8*)(lds + PG8_SA(b, h) + aoff + m * 2048 + k * 1024); } while (0)
#define PG8_LDB(dst, b, h) do { _Pragma("unroll") for (int n = 0; n < 2; ++n) _Pragma("unroll") for (int k = 0; k < 2; ++k) dst[n][k] = *(const PG8_LAS bf16x8*)(lds + PG8_SB(b, h) + boff + n * 2048 + k * 1024); } while (0)
#define PG8_MMA(ai, bj, At, Bt) do { __builtin_amdgcn_s_setprio(1); _Pragma("unroll") for (int m = 0; m < 4; ++m) _Pragma("unroll") for (int n = 0; n < 2; ++n) _Pragma("unroll") for (int k = 0; k < 2; ++k) \
        acc[ai][bj][m][n] = __builtin_amdgcn_mfma_f32_16x16x32_bf16(Bt[n][k], At[m][k], acc[ai][bj][m][n], 0, 0, 0); __builtin_amdgcn_s_setprio(0); } while (0)
#define PG8_WAIT_V(n) asm volatile("s_waitcnt vmcnt(" #n ")" ::: "memory")
#define PG8_WAIT_L(n) asm volatile("s_waitcnt lgkmcnt(" #n ")" ::: "memory")
#define PG8_BAR __builtin_amdgcn_s_barrier()
#define PG8_SCHED __builtin_amdgcn_sched_barrier(0)
    Unit cur, nxt; int ui = 0;
    if (!S.next(0, cur)) return;
    f32x4 acc[2][2][4][2];
#pragma unroll
    for (int a = 0; a < 2; ++a)
#pragma unroll
        for (int b = 0; b < 2; ++b)
#pragma unroll
            for (int m = 0; m < 4; ++m)
#pragma unroll
                for (int n = 0; n < 2; ++n) acc[a][b][m][n] = (f32x4){0.f, 0.f, 0.f, 0.f};
    bf16x8 At[4][2], B0[2][2], B1[2][2];
    const char* cA = (const char*)g.A + (size_t)cur.pm * tstep; const char* cB = (const char*)g.Bt + (size_t)btile(g, cur) * tstep;
    S.a_ready(cur);
    if constexpr (SP2) {
        PG8_STAGE(PG8_SB(0, 0), cB, voffB); PG8_STAGE(PG8_SB(0, 1), cB + hstep, voffB); PG8_STAGE(PG8_SA(0, 0), cA, voffA); PG8_STAGE(PG8_SA(0, 1), cA + hstep, voffA);
        if (wr == 1) PG8_BAR;
        PG8_WAIT_V(2); PG8_BAR;
        PG8_STAGE(PG8_SB(1, 0), cB + kstep, voffB); PG8_STAGE(PG8_SA(1, 0), cA + kstep, voffA); PG8_STAGE(PG8_SB(1, 1), cB + hstep + kstep, voffB);
        PG8_WAIT_V(6); PG8_BAR;
    } else {
        PG8_STAGE(PG8_SB(0, 0), cB, voffB); PG8_STAGE(PG8_SA(0, 0), cA, voffA); PG8_STAGE(PG8_SB(0, 1), cB + hstep, voffB); PG8_STAGE(PG8_SA(0, 1), cA + hstep, voffA);
        if (wr == 1) PG8_BAR;
        PG8_WAIT_V(4); PG8_BAR;
        PG8_STAGE(PG8_SB(1, 0), cB + kstep, voffB); PG8_STAGE(PG8_SA(1, 0), cA + kstep, voffA); PG8_STAGE(PG8_SB(1, 1), cB + hstep + kstep, voffB);
        PG8_WAIT_V(6); PG8_BAR;
    }
    for (;;) {
        const bool has_next = S.next(ui + 1, nxt);
        const char* nA = has_next ? (const char*)g.A + (size_t)nxt.pm * tstep : cA; const char* nB = has_next ? (const char*)g.Bt + (size_t)btile(g, nxt) * tstep : cB;
        for (int t = 0; t < nt; t += 2) {
            const bool last = (t == nt - 2);
            const char* a1 = cA + (size_t)(t + 1) * kstep;
            const char* a2 = last ? nA : cA + (size_t)(t + 2) * kstep; const char* b2 = last ? nB : cB + (size_t)(t + 2) * kstep;
            const char* a3 = a2 + kstep; const char* b3 = b2 + kstep;
            if (last && has_next) S.a_ready(nxt);
            if constexpr (SP2) {
            PG8_LDB(B0, 0, 0); PG8_LDB(B1, 0, 1); PG8_SCHED; PG8_LDA(At, 0, 0); PG8_STAGE(PG8_SA(1, 1), a1 + hstep, voffA);
            PG8_WAIT_V(8); PG8_WAIT_L(0); PG8_BAR; PG8_MMA(0, 0, At, B0); PG8_MMA(0, 1, At, B1); PG8_BAR; PG8_SCHED;
            PG8_LDA(At, 0, 1); PG8_STAGE(PG8_SB(0, 0), b2, voffB); PG8_STAGE(PG8_SB(0, 1), b2 + hstep, voffB); PG8_STAGE(PG8_SA(0, 0), a2, voffA);
            PG8_WAIT_V(8); PG8_WAIT_L(0); PG8_BAR; PG8_MMA(1, 0, At, B0); PG8_MMA(1, 1, At, B1); PG8_BAR; PG8_SCHED;
            PG8_LDB(B0, 1, 0); PG8_LDB(B1, 1, 1); PG8_SCHED; PG8_LDA(At, 1, 0); PG8_STAGE(PG8_SA(0, 1), a2 + hstep, voffA);
            PG8_WAIT_V(8); PG8_WAIT_L(0); PG8_BAR; PG8_MMA(0, 0, At, B0); PG8_MMA(0, 1, At, B1); PG8_BAR; PG8_SCHED;
            PG8_LDA(At, 1, 1); PG8_STAGE(PG8_SB(1, 0), b3, voffB); PG8_STAGE(PG8_SB(1, 1), b3 + hstep, voffB); PG8_STAGE(PG8_SA(1, 0), a3, voffA);
            PG8_WAIT_V(8); PG8_WAIT_L(0); PG8_BAR; PG8_MMA(1, 0, At, B0); PG8_MMA(1, 1, At, B1); PG8_BAR; PG8_SCHED;
            } else {
            PG8_LDB(B0, 0, 0); PG8_SCHED; PG8_LDA(At, 0, 0); PG8_STAGE(PG8_SA(1, 1), a1 + hstep, voffA);
            PG8_WAIT_L(8); PG8_BAR; PG8_WAIT_L(0); PG8_MMA(0, 0, At, B0); PG8_BAR; PG8_SCHED;
            PG8_LDB(B1, 0, 1); PG8_STAGE(PG8_SB(0, 0), b2, voffB);
            PG8_BAR; PG8_WAIT_L(0); PG8_MMA(0, 1, At, B1); PG8_BAR;
            PG8_LDA(At, 0, 1); PG8_STAGE(PG8_SA(0, 0), a2, voffA);
            PG8_BAR; PG8_WAIT_L(0); PG8_MMA(1, 0, At, B0); PG8_BAR; PG8_SCHED;
            PG8_STAGE(PG8_SB(0, 1), b2 + hstep, voffB);
            PG8_WAIT_V(6); PG8_BAR; PG8_MMA(1, 1, At, B1); PG8_BAR;
            PG8_LDB(B0, 1, 0); PG8_SCHED; PG8_LDA(At, 1, 0); PG8_STAGE(PG8_SA(0, 1), a2 + hstep, voffA);
            PG8_WAIT_L(8); PG8_BAR; PG8_WAIT_L(0); PG8_MMA(0, 0, At, B0); PG8_BAR; PG8_SCHED;
            PG8_LDB(B1, 1, 1); PG8_STAGE(PG8_SB(1, 0), b3, voffB);
            PG8_BAR; PG8_WAIT_L(0); PG8_MMA(0, 1, At, B1); PG8_BAR;
            PG8_LDA(At, 1, 1); PG8_STAGE(PG8_SA(1, 0), a3, voffA);
            PG8_BAR; PG8_WAIT_L(0); PG8_MMA(1, 0, At, B0); PG8_BAR; PG8_SCHED;
            PG8_STAGE(PG8_SB(1, 1), b3 + hstep, voffB);
            PG8_WAIT_V(6); PG8_BAR; PG8_MMA(1, 1, At, B1); PG8_BAR;
            }
        }
        if constexpr (ALIGN_EPI) { if (wr == 0) PG8_BAR; }
        if constexpr (!Epi::AFTER_DRAIN) { E(acc, cur, wr, wc, fr, fq); S.done(cur); }
        if (!has_next) break;
#pragma unroll
        for (int a = 0; a < 2; ++a)
#pragma unroll
            for (int b = 0; b < 2; ++b)
#pragma unroll
                for (int m = 0; m < 4; ++m)
#pragma unroll
                    for (int n = 0; n < 2; ++n) acc[a][b][m][n] = (f32x4){0.f, 0.f, 0.f, 0.f};
        cur = nxt; cA = nA; cB = nB; ++ui;
        if constexpr (ALIGN_EPI) { if (wr == 1) PG8_BAR; }
    }
    PG8_WAIT_V(0);
    if constexpr (!ALIGN_EPI) { if (wr == 0) PG8_BAR; }
    PG8_BAR;
    if constexpr (Epi::AFTER_DRAIN) { E.fused(acc, cur, wr, wc, fr, fq, lds, wid, lane); S.done(cur); }
#undef PG8_SA
#undef PG8_SB
#undef PG8_STAGE
#undef PG8_LDA
#undef PG8_LDB
#undef PG8_MMA
#undef PG8_WAIT_V
#undef PG8_WAIT_L
#undef PG8_BAR
#undef PG8_SCHED
}
}

constexpr int NWAVES = 8;
constexpr int BATCH = 2, SEQ = 8192, D = 2048, CW = 1024, PW = 1024, NPROJ = 4096, FF = 5632;
constexpr int M = BATCH * SEQ;
constexpr float EPS = 1e-6f;
constexpr int NGRP = 2, GW = 128, MG = SEQ;

constexpr size_t MiB = 1u << 20;
constexpr size_t WS_CTL = 0, CTL_ZERO_BYTES = 49152;
constexpr int CW_HALO = 9728;
constexpr int CW_P4 = 9600;
constexpr int CW_SLAB = 8448;
constexpr int CW_FLAG = 8192 - 128;
constexpr size_t WS_PART1 = 1 * MiB, WS_PART2 = 3 * MiB;
constexpr size_t WS_WD = 5 * MiB;
constexpr size_t WS_WIN = 27 * MiB;
constexpr size_t WS_WOUT = 43 * MiB;
constexpr size_t WS_WGU = 51 * MiB;
constexpr size_t WS_WPOOL = 95 * MiB;
constexpr size_t WS_H = 96 * MiB;
constexpr size_t WS_MIXOUT = 160 * MiB;
constexpr size_t WS_BLK = 224 * MiB, BLK_STRIDE = 120 * MiB;
#define WS_PROJ   (WS_BLK + (size_t)F.grp * BLK_STRIDE - (size_t)F.row0 * NPROJ * 2)
#define WS_POOLED (WS_BLK + (size_t)F.grp * BLK_STRIDE + 64 * MiB - (size_t)F.grp * 4 * MG * 256 * 2)
#define WS_MIXED  (WS_BLK + (size_t)F.grp * BLK_STRIDE + 80 * MiB - (size_t)F.row0 * D * 2)
#define WS_ACT    (WS_BLK + (size_t)F.grp * BLK_STRIDE - (size_t)F.row0 * FF * 2)
#define WS_FF     (WS_BLK + (size_t)F.grp * BLK_STRIDE + 88 * MiB - (size_t)F.row0 * D * 2)
constexpr size_t WS_END = WS_BLK + 2 * BLK_STRIDE;
static_assert(WS_WD + (size_t)D * FF * 2 <= WS_WIN && WS_WPOOL + 4 * 65536 * 2 <= WS_H && WS_H + (size_t)M * D * 2 <= WS_MIXOUT && WS_MIXOUT + (size_t)M * D * 2 <= WS_BLK
              && (size_t)MG * FF * 2 <= 88 * MiB && (size_t)MG * NPROJ * 2 <= 64 * MiB && 88 * MiB + (size_t)MG * D * 2 <= BLK_STRIDE && BLK_STRIDE <= WS_BLK, "d_ws map");

constexpr int RING_BYTES = 131072, EPI_SCR_OFF = RING_BYTES, MISC_OFF = RING_BYTES + 4096, LDS_BYTES = 147456;

#define GAS __attribute__((address_space(1)))
#define LAS __attribute__((address_space(3)))
typedef unsigned short bf16;
typedef unsigned v4u __attribute__((ext_vector_type(4)));
typedef unsigned v2u __attribute__((ext_vector_type(2)));
typedef float f32x4 __attribute__((ext_vector_type(4)));
#define LDS_WAIT() asm volatile("s_waitcnt lgkmcnt(0)" ::: "memory")
__device__ __forceinline__ unsigned f2bf(float f) { unsigned u = __builtin_bit_cast(unsigned, f); return (u + 0x7fffu + ((u >> 16) & 1u)) >> 16; }
__device__ __forceinline__ unsigned pk2(float lo, float hi) { return f2bf(lo) | (f2bf(hi) << 16); }
__device__ __forceinline__ float bflo(unsigned w) { return __builtin_bit_cast(float, w << 16); }
__device__ __forceinline__ float bfhi(unsigned w) { return __builtin_bit_cast(float, w & 0xffff0000u); }
__device__ __forceinline__ float wave_sum(float v) {
#pragma unroll
    for (int o = 1; o < 64; o <<= 1) v += __shfl_xor(v, o);
    return v;
}

typedef GAS unsigned gu32;
#define RLX_AGENT __ATOMIC_RELAXED, __HIP_MEMORY_SCOPE_AGENT
#define XB_TMO      128
#define XB_XCNT(j)  (256  + 64 * (j))
#define XB_XSUB(j)  (1280 + 64 * (j))
#define XB_XGEN(j)  (2304 + 64 * (j))
#define XB_TOP      3328
#define XB_TOPGEN   3392
#define XCD_BAR_WORDS 3456
#define XB_SPIN_CAP (1u << 18)

__device__ __forceinline__ unsigned xb_ld(unsigned* p)              { return __hip_atomic_load(p, __ATOMIC_RELAXED, __HIP_MEMORY_SCOPE_AGENT); }
__device__ __forceinline__ unsigned xb_add(unsigned* p, unsigned v) { return __hip_atomic_fetch_add(p, v, __ATOMIC_RELAXED, __HIP_MEMORY_SCOPE_AGENT); }
__device__ __forceinline__ unsigned xb_xcc_id() { return (unsigned)__builtin_amdgcn_s_getreg((3 << 11) | 20) & 0xFu; }
#define XB_SPIN(cond, bar) do { unsigned _sp = 0; while (cond) { __builtin_amdgcn_s_sleep(1); \
    if ((++_sp & 255u) == 0u) { if (xb_ld(&(bar)[XB_TMO])) break; if (_sp > XB_SPIN_CAP) { atomicAdd(&(bar)[XB_TMO], 1u); break; } } } } while (0)

struct XcdBarrier {
    unsigned* bar; unsigned x; unsigned G;
    volatile LAS unsigned* st;
};

__device__ __forceinline__ XcdBarrier xcd_barrier_post(unsigned* bar, volatile LAS unsigned* st, unsigned G) {
    XcdBarrier b; b.bar = bar; b.x = xb_xcc_id(); b.st = st; b.G = G;
    if (threadIdx.x == 0) (void)xb_add(&bar[XB_XCNT(b.x)], 1u);
    return b;
}
__device__ __forceinline__ void xcd_barrier_complete(unsigned* bar, unsigned x, unsigned G, unsigned& nloc, unsigned& nx) {
    unsigned sum, cnt, mine, sp = 0u;
    for (;;) {
        sum = 0u; cnt = 0u; mine = 0u;
#pragma unroll
        for (unsigned j = 0; j < 16; ++j) { const unsigned c = xb_ld(&bar[XB_XCNT(j)]); sum += c; cnt += (c > 0u) ? 1u : 0u; mine = (j == x) ? c : mine; }
        if (sum == G) break;
        __builtin_amdgcn_s_sleep(1);
        if ((++sp & 255u) == 0u) { if (xb_ld(&bar[XB_TMO])) break; if (sp > XB_SPIN_CAP) { atomicAdd(&bar[XB_TMO], 1u); break; } }
    }
    nloc = mine > 0u ? mine : 1u; nx = cnt > 0u ? cnt : 1u;
}

__device__ __forceinline__ void xcd_barrier(const XcdBarrier& b) {
    asm volatile("s_waitcnt vmcnt(0)" ::: "memory");
    __syncthreads();
    if (threadIdx.x == 0) {
        unsigned* bar = b.bar;
        __builtin_amdgcn_s_waitcnt(0);
        unsigned nloc = b.st[0], nx = b.st[1];
        if (nloc == 0u) { xcd_barrier_complete(bar, b.x, b.G, nloc, nx); b.st[0] = nloc; b.st[1] = nx; }
        const unsigned old = xb_add(&bar[XB_XSUB(b.x)], 1u);
        const unsigned gen = old / nloc;
        if (old + 1u == (gen + 1u) * nloc) {
            __builtin_amdgcn_fence(__ATOMIC_RELEASE, "agent");
            asm volatile("s_waitcnt vmcnt(0)" ::: "memory");
            const unsigned og = xb_add(&bar[XB_TOP], 1u);
            const unsigned tg = og / nx;
            if (og + 1u == (tg + 1u) * nx) xb_add(&bar[XB_TOPGEN], 1u);
            else XB_SPIN(xb_ld(&bar[XB_TOPGEN]) == tg, bar);
            __builtin_amdgcn_fence(__ATOMIC_ACQUIRE, "agent");
            xb_add(&bar[XB_XGEN(b.x)], 1u);
            asm volatile("s_waitcnt vmcnt(0)" ::: "memory");
        } else {
            XB_SPIN(xb_ld(&bar[XB_XGEN(b.x)]) == gen, bar);
            __builtin_amdgcn_fence(__ATOMIC_ACQUIRE, "agent");
            asm volatile("s_waitcnt vmcnt(0)" ::: "memory");
        }
    }
    __syncthreads();
}

struct Frame {
    LAS unsigned char* lds;
    int tid, lane, wave;
    int grp, c, row0, sw;
    const float *x, *g_pre, *w_in, *conv_w, *pool_w, *pool_scale, *w_out, *g_post, *g_fpre, *w_gate, *w_up, *w_down, *g_fpost;
    float* out; unsigned char* ws;
};

__device__ __forceinline__ int opq(int v) { asm volatile("" : "+v"(v)); return v; }
__device__ __forceinline__ unsigned pkbf(float lo, float hi) { return pg8::cvt_pk_bf16(lo, hi); }
constexpr int TSCR_BYTES = 64 * 65 * 4;
struct TItem { const float* W; bf16* WT; int K, N, drow0, k0, n0; };
__device__ __forceinline__ TItem titem(const float* W, int K, int N, bf16* WT, int mode, int item) {
    TItem t; t.W = W; t.WT = WT; t.K = K; t.N = N;
    const int nblk = N / 64, kb = item / nblk, nb = item % nblk; t.k0 = 64 * kb; t.n0 = 64 * nb;
    t.drow0 = mode == 0 ? t.n0 : ((t.n0 >> 7) * 256 + (t.n0 & 127) + (mode == 2 ? 128 : 0));
    return t;
}
__device__ __forceinline__ void titem_load(const TItem& t, f32x4 (&r)[16], int lane) {
    const GAS f32x4* src = (const GAS f32x4*)(t.W + (size_t)(t.k0 + (lane >> 4)) * t.N + t.n0 + 4 * (lane & 15));
#pragma unroll
    for (int i = 0; i < 16; ++i) r[i] = __builtin_nontemporal_load(src + (size_t)i * t.N);
}
template <bool NTS>
__device__ __forceinline__ void titem_store(const TItem& t, const f32x4 (&r)[16], LAS float* scr, int lane) {
#pragma unroll
    for (int i = 0; i < 16; ++i) { LAS float* d = scr + (4 * i + (lane >> 4)) * 65 + 4 * (lane & 15); d[0] = r[i].x; d[1] = r[i].y; d[2] = r[i].z; d[3] = r[i].w; }
    LDS_WAIT(); asm volatile("" ::: "memory");
    const int c = lane & 7;
#pragma unroll
    for (int j = 0; j < 8; ++j) { const int n = (lane >> 3) + 8 * j; const LAS float* s = scr + (8 * c) * 65 + n;
        v4u o; o.x = pkbf(s[0 * 65], s[1 * 65]); o.y = pkbf(s[2 * 65], s[3 * 65]); o.z = pkbf(s[4 * 65], s[5 * 65]); o.w = pkbf(s[6 * 65], s[7 * 65]);
        if (NTS) __builtin_nontemporal_store(o, (GAS v4u*)(t.WT + (size_t)(t.drow0 + n) * t.K + t.k0 + 8 * c)); else *(GAS v4u*)(t.WT + (size_t)(t.drow0 + n) * t.K + t.k0 + 8 * c) = o; }
    LDS_WAIT(); asm volatile("" ::: "memory");
}
__device__ __forceinline__ TItem win_item(Frame& F, int r) {
    constexpr int I_IN = (D / 64) * (NPROJ / 64), I_OUT = (D / 64) * (D / 64), I_P1 = (256 / 64) * (256 / 64);
    if (r < I_IN) return titem(F.w_in, D, NPROJ, (bf16*)(F.ws + WS_WIN), 0, r);
    r -= I_IN;
    if (r < I_OUT) return titem(F.w_out, D, D, (bf16*)(F.ws + WS_WOUT), 0, r);
    r -= I_OUT;
    const int g = r / I_P1; return titem(F.pool_w + (size_t)g * 65536, 256, 256, (bf16*)(F.ws + WS_WPOOL) + (size_t)g * 65536, 0, r % I_P1);
}
__device__ __forceinline__ TItem wrest_item(Frame& F, int r) {
    constexpr int I_G = (D / 64) * (FF / 64);
    if (r < I_G) return titem(F.w_gate, D, FF, (bf16*)(F.ws + WS_WGU), 1, r);
    r -= I_G;
    if (r < I_G) return titem(F.w_up, D, FF, (bf16*)(F.ws + WS_WGU), 2, r);
    r -= I_G;
    return titem(F.w_down, FF, D, (bf16*)(F.ws + WS_WD), 0, r);
}
template <bool REST>
__device__ __forceinline__ void p0_weights(Frame& F) {
    LAS float* scr = (LAS float*)(F.lds + F.wave * TSCR_BYTES);
    const int gw = F.c * NWAVES + F.wave, NGW = GW * NWAVES;
    constexpr int NITEMS = REST ? 2 * (D / 64) * (FF / 64) + (FF / 64) * (D / 64) : (D / 64) * (NPROJ / 64) + (D / 64) * (D / 64) + 4 * 16;
    int it = gw; if (it >= NITEMS) return;
    TItem cur = REST ? wrest_item(F, it) : win_item(F, it); f32x4 rc[16]; titem_load(cur, rc, F.lane);
#pragma unroll 1
    for (;;) {
        const int itn = it + NGW; const bool has = itn < NITEMS;
        TItem nxt = cur; f32x4 rn[16];
        if (has) { nxt = REST ? wrest_item(F, itn) : win_item(F, itn); titem_load(nxt, rn, F.lane); }
        titem_store<REST>(cur, rc, scr, F.lane);
        if (!has) break;
        cur = nxt; it = itn;
#pragma unroll
        for (int i = 0; i < 16; ++i) rc[i] = rn[i];
    }
}
__device__ __forceinline__ void p0_hrows(Frame& F) {
    const int gw = F.c * NWAVES + F.wave, NGW = GW * NWAVES;
    f32x4 gv[8];
#pragma unroll
    for (int j = 0; j < 8; ++j) gv[j] = ((const GAS f32x4*)F.g_pre)[F.lane + 64 * j];
    bf16* H = (bf16*)(F.ws + WS_H);
    for (int blk = gw; blk < MG / 8; blk += NGW) {
        const int m0 = F.row0 + 8 * blk;
        f32x4 v[2][8], w[2][8];
#pragma unroll
        for (int q = 0; q < 2; ++q) { const GAS f32x4* xr = (const GAS f32x4*)(F.x + (size_t)(m0 + q) * D) + F.lane;
#pragma unroll
            for (int j = 0; j < 8; ++j) v[q][j] = __builtin_nontemporal_load(xr + 64 * j); }
#pragma unroll 1
        for (int pr = 0; pr < 4; ++pr) {
            if (pr < 3) {
#pragma unroll
                for (int q = 0; q < 2; ++q) { const GAS f32x4* xr = (const GAS f32x4*)(F.x + (size_t)(m0 + 2 * pr + 2 + q) * D) + F.lane;
#pragma unroll
                    for (int j = 0; j < 8; ++j) w[q][j] = __builtin_nontemporal_load(xr + 64 * j); } }
#pragma unroll
            for (int q = 0; q < 2; ++q) { float s = 0.f;
#pragma unroll
                for (int j = 0; j < 8; ++j) s += (v[q][j].x * v[q][j].x + v[q][j].y * v[q][j].y) + (v[q][j].z * v[q][j].z + v[q][j].w * v[q][j].w);
                const float rstd = 1.0f / sqrtf(wave_sum(s) * (1.0f / D) + EPS);
                GAS v2u* o8 = (GAS v2u*)(H + (size_t)(m0 + 2 * pr + q) * D) + F.lane;
#pragma unroll
                for (int j = 0; j < 8; ++j) { const f32x4 y = v[q][j] * rstd * gv[j]; v2u o; o.x = pkbf(y.x, y.y); o.y = pkbf(y.z, y.w); o8[64 * j] = o; } }
            if (pr < 3) {
#pragma unroll
                for (int q = 0; q < 2; ++q)
#pragma unroll
                    for (int j = 0; j < 8; ++j) v[q][j] = w[q][j]; }
        }
    }
}

__device__ __forceinline__ void up8(const v4u w, float (&f)[8]) { f[0] = bflo(w.x); f[1] = bfhi(w.x); f[2] = bflo(w.y); f[3] = bfhi(w.y); f[4] = bflo(w.z); f[5] = bfhi(w.z); f[6] = bflo(w.w); f[7] = bfhi(w.w); }
__device__ __forceinline__ v4u pk8(const float (&f)[8]) { v4u o; o.x = pkbf(f[0], f[1]); o.y = pkbf(f[2], f[3]); o.z = pkbf(f[4], f[5]); o.w = pkbf(f[6], f[7]); return o; }
__device__ __forceinline__ v4u ldg16(const bf16* p) { return __builtin_nontemporal_load((const GAS v4u*)p); }
__device__ __forceinline__ void conv_pass(Frame& F, int p, int t0, int m0) {
    const int l = opq(F.lane), cb = 512 * p + 8 * l;
    const bf16* P = (const bf16*)(F.ws + WS_PROJ) + cb; bf16* MIX = (bf16*)(F.ws + WS_MIXED) + cb;
    const v4u z = {0u, 0u, 0u, 0u};
    v4u hc[2], hu[2];
#pragma unroll
    for (int j = 0; j < 2; ++j) { hc[j] = z; hu[j] = z; }
    if (t0 > 0) {
#pragma unroll
        for (int j = 0; j < 2; ++j) { hc[j] = ldg16(P + (size_t)(m0 - 1 - j) * NPROJ + CW); hu[j] = ldg16(P + (size_t)(m0 - 1 - j) * NPROJ + 2 * CW); } }
    float w0[8], w1[8], w2[8];
#pragma unroll
    for (int i = 0; i < 8; ++i) { w0[i] = F.conv_w[0 * CW + cb + i]; w1[i] = F.conv_w[1 * CW + cb + i]; w2[i] = F.conv_w[2 * CW + cb + i]; }
    float cu1[8], cu2[8];
#pragma unroll 1
    for (int h = 0; h < 2; ++h) {
        v4u rb[4], rc[4], ru[4];
        const bf16* row = P + (size_t)(m0 + 4 * h) * NPROJ;
#pragma unroll
        for (int r = 0; r < 4; ++r) { rb[r] = ldg16(row + (size_t)r * NPROJ); rc[r] = ldg16(row + (size_t)r * NPROJ + CW); ru[r] = ldg16(row + (size_t)r * NPROJ + 2 * CW); }
        if (h == 0) { float c[8], u[8]; up8(hc[0], c); up8(hu[0], u);
#pragma unroll
            for (int i = 0; i < 8; ++i) cu1[i] = c[i] * u[i];
            up8(hc[1], c); up8(hu[1], u);
#pragma unroll
            for (int i = 0; i < 8; ++i) cu2[i] = c[i] * u[i]; }
#pragma unroll
        for (int r = 0; r < 4; ++r) {
            float b[8], c[8], u[8], y[8]; up8(rb[r], b); up8(rc[r], c); up8(ru[r], u);
            float ss = 0.f;
#pragma unroll
            for (int i = 0; i < 8; ++i) { const float cu0 = c[i] * u[i]; y[i] = b[i] * (w0[i] * cu2[i] + w1[i] * cu1[i] + w2[i] * cu0); ss += y[i] * y[i]; cu2[i] = cu1[i]; cu1[i] = cu0; }
            ss += __shfl_xor(ss, 1); ss += __shfl_xor(ss, 2); ss += __shfl_xor(ss, 4); ss += __shfl_xor(ss, 8);
            const float rstd = 1.0f / sqrtf(ss * (1.0f / 128.0f) + EPS);
#pragma unroll
            for (int i = 0; i < 8; ++i) y[i] *= rstd;
            *(GAS v4u*)(MIX + (size_t)(m0 + 4 * h + r) * D) = pk8(y);
            __builtin_amdgcn_sched_barrier(0);
        }
    }
}
template <int WLO, int WHI>
__device__ __forceinline__ void pool_pass(Frame& F, int p, int t0, int m0) {
    const int l = opq(F.lane); const bool lo = l < 32;
    const bf16* V = (const bf16*)(F.ws + WS_PROJ) + 3 * CW + 512 * p + 8 * l;
    bf16* PO = (bf16*)(F.ws + WS_POOLED) + ((size_t)(F.grp * 4 + 2 * p + (l >> 5)) * MG + t0) * 256 + 8 * (l & 31);
    const v4u z = {0u, 0u, 0u, 0u};
    v4u pv[WHI], cv[8];
#pragma unroll
    for (int j = 1; j < WHI; ++j) pv[j] = z;
    if (t0 >= 16) {
#pragma unroll
        for (int j = 1; j < WHI; ++j) pv[j] = ldg16(V + (size_t)(m0 - j) * NPROJ);
    } else if (t0 == 8) {
#pragma unroll
        for (int j = 1; j < WHI && j <= 8; ++j) pv[j] = ldg16(V + (size_t)(m0 - j) * NPROJ);
    }
#pragma unroll
    for (int r = 0; r < 8; ++r) cv[r] = ldg16(V + (size_t)(m0 + r) * NPROJ);
    float Wl[8], Wh[8];
#pragma unroll
    for (int i = 0; i < 8; ++i) { Wl[i] = 0.f; Wh[i] = 0.f; }
#pragma unroll
    for (int j = 1; j < WHI; ++j) { float f[8]; up8(pv[j], f);
#pragma unroll
        for (int i = 0; i < 8; ++i) { if (j < WLO) Wl[i] += f[i]; Wh[i] += f[i]; } }
#pragma unroll
    for (int r = 0; r < 8; ++r) {
        const int t = t0 + r; float v[8], o[8]; up8(cv[r], v);
        const float il = 1.0f / (float)((t + 1) < WLO ? (t + 1) : WLO), ih = 1.0f / (float)((t + 1) < WHI ? (t + 1) : WHI);
#pragma unroll
        for (int i = 0; i < 8; ++i) { Wl[i] += v[i]; Wh[i] += v[i]; o[i] = (lo ? Wl[i] * il : Wh[i] * ih) - v[i]; }
        *(GAS v4u*)(PO + (size_t)r * 256) = pk8(o);
        { float f[8]; up8((r - WLO + 1 >= 0) ? cv[(r - WLO + 1 >= 0) ? r - WLO + 1 : 0] : pv[(WLO - 1 - r > 0) ? WLO - 1 - r : 1], f);
#pragma unroll
          for (int i = 0; i < 8; ++i) Wl[i] -= f[i]; }
        { float f[8]; up8((r - WHI + 1 >= 0) ? cv[(r - WHI + 1 >= 0) ? r - WHI + 1 : 0] : pv[(WHI - 1 - r > 0) ? WHI - 1 - r : 1], f);
#pragma unroll
          for (int i = 0; i < 8; ++i) Wh[i] -= f[i]; }
        __builtin_amdgcn_sched_barrier(0);
    }
}
__device__ __forceinline__ void p2_mixer(Frame& F) {
    const int gw = F.sw * NWAVES + F.wave, NGW = GW * NWAVES;
    for (int chunk = gw; chunk < MG / 8; chunk += NGW) {
        const int t0 = chunk * 8, m0 = F.row0 + t0;
        conv_pass(F, 0, t0, m0); asm volatile("" ::: "memory"); conv_pass(F, 1, t0, m0); asm volatile("" ::: "memory");
        pool_pass<2, 4>(F, 0, t0, m0); asm volatile("" ::: "memory"); pool_pass<8, 16>(F, 1, t0, m0); asm volatile("" ::: "memory");
    }
}

__device__ __forceinline__ float sq4(const f32x4 v) { return (v.x * v.x + v.y * v.y) + (v.z * v.z + v.w * v.w); }
__device__ __forceinline__ f32x4 bf4lo(const v4u w) { return (f32x4){bflo(w.x), bfhi(w.x), bflo(w.y), bfhi(w.y)}; }
__device__ __forceinline__ f32x4 bf4hi(const v4u w) { return (f32x4){bflo(w.z), bfhi(w.z), bflo(w.w), bfhi(w.w)}; }
struct Row5 { f32x4 x[4][2]; v4u mo[4]; float p; };
__device__ __forceinline__ void ld_row5(Row5& R, const float* x, const bf16* MO, const float* part, int m, int l) {
    const GAS f32x4* xr = (const GAS f32x4*)(x + (size_t)m * D + 8 * l); const GAS v4u* mr = (const GAS v4u*)(MO + (size_t)m * D + 8 * l);
#pragma unroll
    for (int j = 0; j < 4; ++j) { R.x[j][0] = xr[128 * j]; R.x[j][1] = xr[128 * j + 1]; R.mo[j] = mr[64 * j]; }
    R.p = part[(size_t)m * 32 + (l & 31)];
}
__device__ __forceinline__ void p5_resnorm(Frame& F) {
    const int gw = F.sw * NWAVES + F.wave, NGW = GW * NWAVES, l = opq(F.lane);
    const bf16* MO = (const bf16*)(F.ws + WS_MIXOUT); const float* part = (const float*)(F.ws + WS_PART1); bf16* H = (bf16*)(F.ws + WS_H);
    LAS f32x4* G1 = (LAS f32x4*)F.lds; LAS f32x4* G2 = (LAS f32x4*)(F.lds + 8192);
    if (F.tid < 512) { G1[F.tid] = ((const GAS f32x4*)F.g_post)[F.tid]; G2[F.tid] = ((const GAS f32x4*)F.g_fpre)[F.tid]; }
    __syncthreads();
    for (int blk = gw; blk < MG / 8; blk += NGW) {
        const int m0 = F.row0 + 8 * blk;
        Row5 cur, nxt, nx2; ld_row5(cur, F.x, MO, part, m0, l); ld_row5(nxt, F.x, MO, part, m0 + 1, l);
#pragma unroll 1
        for (int r = 0; r < 8; ++r) {
            if (r + 2 < 8) ld_row5(nx2, F.x, MO, part, m0 + r + 2, l);
            const float rstd1 = 1.0f / sqrtf(wave_sum(l < 32 ? cur.p : 0.f) * (1.0f / D) + EPS);
            f32x4 v[4][2]; float s = 0.f;
#pragma unroll
            for (int j = 0; j < 4; ++j) { v[j][0] = cur.x[j][0] + bf4lo(cur.mo[j]) * rstd1 * G1[2 * l + 128 * j]; v[j][1] = cur.x[j][1] + bf4hi(cur.mo[j]) * rstd1 * G1[2 * l + 128 * j + 1]; s += sq4(v[j][0]) + sq4(v[j][1]); }
            const float rstd2 = 1.0f / sqrtf(wave_sum(s) * (1.0f / D) + EPS);
            GAS v4u* hr = (GAS v4u*)(H + (size_t)(m0 + r) * D + 8 * l);
#pragma unroll
            for (int j = 0; j < 4; ++j) { const f32x4 y0 = v[j][0] * rstd2 * G2[2 * l + 128 * j], y1 = v[j][1] * rstd2 * G2[2 * l + 128 * j + 1];
                v4u w; w.x = pkbf(y0.x, y0.y); w.y = pkbf(y0.z, y0.w); w.z = pkbf(y1.x, y1.y); w.w = pkbf(y1.z, y1.w); hr[64 * j] = w; __builtin_amdgcn_sched_barrier(0); }
            cur = nxt; nxt = nx2;
        }
    }
}
struct Row8 { f32x4 x[4][2]; v4u mo[4], ff[4]; float p1, p2; };
__device__ __forceinline__ void ld_row8(Row8& R, const float* x, const bf16* MO, const bf16* FFO, const float* part1, const float* part2, int m, int l) {
    const GAS f32x4* xr = (const GAS f32x4*)(x + (size_t)m * D + 8 * l); const GAS v4u* mr = (const GAS v4u*)(MO + (size_t)m * D + 8 * l); const GAS v4u* fr = (const GAS v4u*)(FFO + (size_t)m * D + 8 * l);
#pragma unroll
    for (int j = 0; j < 4; ++j) { R.x[j][0] = xr[128 * j]; R.x[j][1] = xr[128 * j + 1]; R.mo[j] = mr[64 * j]; R.ff[j] = fr[64 * j]; }
    R.p1 = part1[(size_t)m * 32 + (l & 31)]; R.p2 = part2[(size_t)m * 32 + (l & 31)];
}
__device__ __forceinline__ void p8_final(Frame& F) {
    const int gw = F.sw * NWAVES + F.wave, NGW = GW * NWAVES, l = opq(F.lane);
    const bf16* MO = (const bf16*)(F.ws + WS_MIXOUT); const bf16* FFO = (const bf16*)(F.ws + WS_FF);
    const float* part1 = (const float*)(F.ws + WS_PART1); const float* part2 = (const float*)(F.ws + WS_PART2);
    LAS f32x4* G1 = (LAS f32x4*)F.lds; LAS f32x4* G3 = (LAS f32x4*)(F.lds + 8192);
    if (F.tid < 512) { G1[F.tid] = ((const GAS f32x4*)F.g_post)[F.tid]; G3[F.tid] = ((const GAS f32x4*)F.g_fpost)[F.tid]; }
    __syncthreads();
    for (int blk = gw; blk < MG / 8; blk += NGW) {
        const int m0 = F.row0 + 8 * blk;
        Row8 cur, nxt, nx2; ld_row8(cur, F.x, MO, FFO, part1, part2, m0, l); ld_row8(nxt, F.x, MO, FFO, part1, part2, m0 + 1, l);
#pragma unroll 1
        for (int r = 0; r < 8; ++r) {
            if (r + 2 < 8) ld_row8(nx2, F.x, MO, FFO, part1, part2, m0 + r + 2, l);
            const float rstd1 = 1.0f / sqrtf(wave_sum(l < 32 ? cur.p1 : 0.f) * (1.0f / D) + EPS), rstd2 = 1.0f / sqrtf(wave_sum(l < 32 ? cur.p2 : 0.f) * (1.0f / D) + EPS);
            GAS f32x4* orow = (GAS f32x4*)(F.out + (size_t)(m0 + r) * D + 8 * l);
#pragma unroll
            for (int j = 0; j < 4; ++j) { orow[128 * j] = cur.x[j][0] + bf4lo(cur.mo[j]) * rstd1 * G1[2 * l + 128 * j] + bf4lo(cur.ff[j]) * rstd2 * G3[2 * l + 128 * j];
                orow[128 * j + 1] = cur.x[j][1] + bf4hi(cur.mo[j]) * rstd1 * G1[2 * l + 128 * j + 1] + bf4hi(cur.ff[j]) * rstd2 * G3[2 * l + 128 * j + 1]; __builtin_amdgcn_sched_barrier(0); }
            cur = nxt; nxt = nx2;
        }
    }
}

__device__ __forceinline__ void flag_set(unsigned* flag) { __hip_atomic_store(flag, 1u, __ATOMIC_RELAXED, __HIP_MEMORY_SCOPE_AGENT); }
__device__ __forceinline__ void flag_wait(unsigned* flag, unsigned* tmo) {
    if (threadIdx.x == 0) {
        unsigned sp = 0u;
        while (xb_ld(flag) == 0u) { __builtin_amdgcn_s_sleep(2); if ((++sp & 255u) == 0u) { if (xb_ld(tmo)) break; if (sp > XB_SPIN_CAP) { atomicAdd(tmo, 1u); break; } } }
        __builtin_amdgcn_fence(__ATOMIC_ACQUIRE, "agent");
        asm volatile("s_waitcnt vmcnt(0)" ::: "memory");
    }
    __syncthreads();
}

__device__ __forceinline__ void slab_barrier(unsigned* cnt, unsigned target, unsigned* tmo, unsigned samex) {
    asm volatile("s_waitcnt vmcnt(0)" ::: "memory");
    __syncthreads();
    if (threadIdx.x == 0) {
        if (!samex) { __builtin_amdgcn_fence(__ATOMIC_RELEASE, "agent"); asm volatile("s_waitcnt vmcnt(0)" ::: "memory"); }
        (void)xb_add(cnt, 1u);
        unsigned sp = 0u;
        while (xb_ld(cnt) < target) { __builtin_amdgcn_s_sleep(1); if ((++sp & 255u) == 0u) { if (xb_ld(tmo)) break; if (sp > XB_SPIN_CAP) { atomicAdd(tmo, 1u); break; } } }
        __builtin_amdgcn_fence(__ATOMIC_ACQUIRE, "agent");
        asm volatile("s_waitcnt vmcnt(0)" ::: "memory");
    }
    __syncthreads();
}
struct SlabPoolOrder {
    int c;
    __device__ __forceinline__ bool next(int i, pg8::Unit& u) const { if (i) return false; u.pm = ((c >> 3) >> 2) * 32 + 4 * (c & 7) + ((c >> 3) & 3); u.pn = 0; return true; }
    __device__ __forceinline__ void a_ready(const pg8::Unit&) const {}
    __device__ __forceinline__ void done(const pg8::Unit&) const {}
};

#ifndef WGMG
#define WGMG 4
#endif
constexpr int NXG = 8;
struct Args { const float* in[13]; float* out; unsigned char* ws; };
__global__ void __launch_bounds__(NWAVES * 64, 2) mk_fwd(Args args) {
    extern __shared__ __attribute__((aligned(16))) unsigned char lds[];
    Frame F;
    F.lds = (LAS unsigned char*)lds;
    F.tid = threadIdx.x; F.lane = F.tid & 63; F.wave = __builtin_amdgcn_readfirstlane(F.tid >> 6);
    { const int bx = blockIdx.x; F.grp = (bx >> 3) & 1; F.c = (bx >> 4) * 8 + (bx & 7); F.row0 = F.grp * MG; F.sw = (F.c & 7) * 16 + (F.c >> 3); }
    F.x = args.in[0]; F.g_pre = args.in[1]; F.w_in = args.in[2]; F.conv_w = args.in[3]; F.pool_w = args.in[4]; F.pool_scale = args.in[5]; F.w_out = args.in[6];
    F.g_post = args.in[7]; F.g_fpre = args.in[8]; F.w_gate = args.in[9]; F.w_up = args.in[10]; F.w_down = args.in[11]; F.g_fpost = args.in[12];
    F.out = args.out; F.ws = args.ws;
    unsigned char* ws = args.ws;
    unsigned* ctl = (unsigned*)(ws + WS_CTL);
    volatile LAS unsigned* MISC = (volatile LAS unsigned*)(F.lds + MISC_OFF);
    if (F.tid < 64) MISC[F.tid] = 0u;
    __syncthreads();
    const XcdBarrier bar = xcd_barrier_post(ctl + 4096 * F.grp, MISC + 8, (unsigned)GW);
    unsigned* flagA = ctl + CW_FLAG; unsigned* flagB = ctl + CW_FLAG + 64; unsigned* tmo = ctl + 4096 * F.grp + XB_TMO;
#define BAR() xcd_barrier(bar)
    unsigned* slabcnt = ctl + CW_SLAB + 64 * (8 * F.grp + (F.c & 7));
    if (F.tid == 0) (void)__hip_atomic_fetch_or(slabcnt + 1, 1u << bar.x, __ATOMIC_RELAXED, __HIP_MEMORY_SCOPE_AGENT);
    unsigned samex = 0u;
#define SBAR(k) slab_barrier(slabcnt, 16u * (k), ctl + 4096 * F.grp + XB_TMO, samex)
#ifndef PROBE_B
#define PROBE_G 0
#define PROBE_A 0
#define PROBE_B 0
#define PROBE_MUL 4
#endif
    unsigned long long* stamps = (unsigned long long*)(ctl + 8192);
#define STAMP(k) do { if (PROBE_B > PROBE_A && F.c == 0 && F.tid == 0) __hip_atomic_store(stamps + F.grp * 16 + (k), (unsigned long long)__builtin_amdgcn_s_memrealtime(), __ATOMIC_RELAXED, __HIP_MEMORY_SCOPE_AGENT); } while (0)
    STAMP(0);
    typedef pg8::bf16_t bt;
    const size_t r0 = (size_t)F.row0;
    if (F.grp == 0) { p0_weights<false>(F); p0_hrows(F); BAR(); if (F.c == 0 && F.tid == 0) flag_set(flagA); }
    else { p0_weights<true>(F); p0_hrows(F); BAR(); if (F.c == 0 && F.tid == 0) flag_set(flagB); flag_wait(flagA, tmo); }
    STAMP(1);
    if (F.tid == 0) MISC[12] = (__builtin_popcount(xb_ld(slabcnt + 1)) == 1) ? 1u : 0u;
    __syncthreads();
    samex = MISC[12];
#ifndef PHMASK
#define PHMASK 0x1ff
#endif
    if (PHMASK & 2) {
        pg8::Gemm g{(const bt*)(ws + WS_H) + r0 * D, (const bt*)(ws + WS_WIN), MG, NPROJ, D, 0}; pg8::StaticOrder S; S.init(MG, NPROJ, GW, F.c, NXG, WGMG);
        pg8::EpiBf16 E{(bt*)(ws + WS_PROJ) + r0 * NPROJ, NPROJ};
        pg8::gemm_phase<pg8::EpiBf16, pg8::StaticOrder, true, true>(F.lds, g, S, E);
    }
    asm volatile("s_waitcnt vmcnt(0)" ::: "memory"); __syncthreads();
    if ((((F.c >> 3) & 3) == 3) && F.tid == 0) { __builtin_amdgcn_fence(__ATOMIC_RELEASE, "agent"); asm volatile("s_waitcnt vmcnt(0)" ::: "memory"); (void)xb_add(ctl + CW_HALO + 64 * (8 * F.grp + (F.c & 7)), 1u); }
    SBAR(1); STAMP(2);
    if ((F.c >> 3) == 0 && (F.c & 7) > 0) {
        if (F.tid == 0) { unsigned sp = 0u; unsigned* w = ctl + CW_HALO + 64 * (8 * F.grp + (F.c & 7) - 1);
            while (xb_ld(w) < 4u) { __builtin_amdgcn_s_sleep(2); if ((++sp & 255u) == 0u) { if (xb_ld(tmo)) break; if (sp > XB_SPIN_CAP) { atomicAdd(tmo, 1u); break; } } }
            __builtin_amdgcn_fence(__ATOMIC_ACQUIRE, "agent"); asm volatile("s_waitcnt vmcnt(0)" ::: "memory"); }
        __syncthreads();
    }
    if (PHMASK & 4) p2_mixer(F);
    SBAR(2);
    STAMP(3);
    if (PHMASK & 8) {
        int kpool = 256; asm volatile("" : "+s"(kpool));
        pg8::Gemm g{(const bt*)(ws + WS_POOLED) + (size_t)F.grp * 4 * MG * 256, (const bt*)(ws + WS_WPOOL), 4 * MG, 256, kpool, MG / 256}; SlabPoolOrder S{F.c};
        pg8::EpiPool E{(bt*)(ws + WS_MIXED) + r0 * D, D, F.pool_scale, (LAS float*)(F.lds + EPI_SCR_OFF), EPS, 5};
        pg8::gemm_phase<pg8::EpiPool, SlabPoolOrder, false, true>(F.lds, g, S, E);
    }
    SBAR(3); STAMP(4);
    if (PHMASK & 16) {
        pg8::Gemm g{(const bt*)(ws + WS_MIXED) + r0 * D, (const bt*)(ws + WS_WOUT), MG, D, D, 0}; pg8::StaticOrder S; S.init(MG, D, GW, F.c, NXG, WGMG);
        pg8::EpiBf16Stat E{(bt*)(ws + WS_MIXOUT) + r0 * D, D, (float*)(ws + WS_PART1) + r0 * 32};
        pg8::gemm_phase<pg8::EpiBf16Stat, pg8::StaticOrder, false, true>(F.lds, g, S, E);
    }
    SBAR(4); STAMP(5);
    if (F.tid == 0) (void)xb_add(ctl + CW_P4 + 64 * F.grp, 1u);
    if (PHMASK & 32) p5_resnorm(F);
    SBAR(5);
    if (F.tid == 0) { unsigned sp = 0u; unsigned* w = ctl + CW_P4 + 64 * F.grp;
        while (xb_ld(w) < (unsigned)GW) { __builtin_amdgcn_s_sleep(2); if ((++sp & 255u) == 0u) { if (xb_ld(tmo)) break; if (sp > XB_SPIN_CAP) { atomicAdd(tmo, 1u); break; } } } }
    __syncthreads();
    if (F.grp == 0) flag_wait(flagB, tmo);
    STAMP(6);
    if (PHMASK & 64) {
        pg8::Gemm g{(const bt*)(ws + WS_H) + r0 * D, (const bt*)(ws + WS_WGU), MG, 2 * FF, D, 0}; pg8::StaticOrder S; S.init(MG, 2 * FF, GW, F.c, NXG, WGMG);
        pg8::EpiSwiGLU E{(bt*)(ws + WS_ACT) + r0 * FF, FF};
        pg8::gemm_phase<pg8::EpiSwiGLU, pg8::StaticOrder, false, true>(F.lds, g, S, E);
    }
    SBAR(6); STAMP(7);
    if (PHMASK & 128) {
        pg8::Gemm g{(const bt*)(ws + WS_ACT) + r0 * FF, (const bt*)(ws + WS_WD), MG, D, FF, 0}; pg8::StaticOrder S; S.init(MG, D, GW, F.c, NXG, WGMG);
        pg8::EpiBf16Stat E{(bt*)(ws + WS_FF) + r0 * D, D, (float*)(ws + WS_PART2) + r0 * 32};
        pg8::gemm_phase<pg8::EpiBf16Stat, pg8::StaticOrder, false, true>(F.lds, g, S, E);
    }
    SBAR(7); STAMP(8);
    if (PHMASK & 256) p8_final(F);
    if (PROBE_B > PROBE_A) {
        asm volatile("s_waitcnt vmcnt(0)" ::: "memory"); __syncthreads(); STAMP(9);
        if (F.grp == 1 && F.c == 0 && F.tid == 0) {
            asm volatile("s_waitcnt vmcnt(0)" ::: "memory");
            const unsigned long long a = __hip_atomic_load(stamps + PROBE_G * 16 + PROBE_A, __ATOMIC_RELAXED, __HIP_MEMORY_SCOPE_AGENT), b = __hip_atomic_load(stamps + PROBE_G * 16 + PROBE_B, __ATOMIC_RELAXED, __HIP_MEMORY_SCOPE_AGENT);
            const unsigned long long span = (b > a && b - a < 400000ull) ? (b - a) * PROBE_MUL : 1000000ull;
            const unsigned long long t0 = __builtin_amdgcn_s_memrealtime();
            while (__builtin_amdgcn_s_memrealtime() - t0 < span) __builtin_amdgcn_s_sleep(8);
        }
    }
#undef BAR
#undef SBAR
#undef STAMP
}

extern "C" void kernel_launch(void* const* d_in, const int* in_sizes, int n_in, void* d_out, int out_size, void* d_ws, size_t ws_size, hipStream_t stream) {
    static int grid = 0;
    if (grid == 0) {
        if (n_in != 13 || in_sizes[0] != M * D || out_size != M * D || ws_size < WS_END) { fprintf(stderr, "kernel_launch: shape/workspace mismatch (n_in %d, in0 %d, out %d, ws %zu, need %zu); nothing launched\n", n_in, n_in > 0 ? in_sizes[0] : -1, out_size, ws_size, (size_t)WS_END); grid = -1; return; }
        int dev = 0, cus = 0, per_cu = 0;
        if (hipGetDevice(&dev) != hipSuccess || hipDeviceGetAttribute(&cus, hipDeviceAttributeMultiprocessorCount, dev) != hipSuccess) { fprintf(stderr, "kernel_launch: device query failed\n"); grid = -1; return; }
        if (hipFuncSetAttribute((const void*)mk_fwd, hipFuncAttributeMaxDynamicSharedMemorySize, LDS_BYTES) != hipSuccess) { fprintf(stderr, "kernel_launch: hipFuncSetAttribute failed\n"); grid = -1; return; }
        if (hipOccupancyMaxActiveBlocksPerMultiprocessor(&per_cu, (const void*)mk_fwd, NWAVES * 64, LDS_BYTES) != hipSuccess || per_cu < 1) { fprintf(stderr, "kernel_launch: occupancy query says %d blocks per CU\n", per_cu); per_cu = 1; }
        (void)hipGetLastError();
        if (cus * per_cu < NGRP * GW) { fprintf(stderr, "kernel_launch: needs %d co-resident workgroups, the device holds %d; nothing launched\n", NGRP * GW, cus * per_cu); grid = -1; return; }
        grid = NGRP * GW;
    }
    if (grid < 0) return;
    Args a{};
    for (int i = 0; i < 13; ++i) a.in[i] = (const float*)d_in[i];
    a.out = (float*)d_out; a.ws = (unsigned char*)d_ws;
    if (hipMemsetAsync((char*)d_ws + WS_CTL, 0, CTL_ZERO_BYTES, stream) != hipSuccess) { fprintf(stderr, "kernel_launch: hipMemsetAsync failed\n"); return; }
    hipLaunchKernelGGL(mk_fwd, dim3(grid), dim3(NWAVES * 64), LDS_BYTES, stream, a);
    const hipError_t e = hipPeekAtLastError();
    if (e != hipSuccess) fprintf(stderr, "kernel_launch: launch failed: %s (grid %d)\n", hipGetErrorString(e), grid);
}
```

```cpp
#include <hip/hip_runtime.h>
#include <cstdio>
#include <cstdint>
namespace pg8 {
#define PG8_LAS __attribute__((address_space(3)))
typedef unsigned short bf16_t;
typedef short bf16x8 __attribute__((ext_vector_type(8)));
typedef float f32x4 __attribute__((ext_vector_type(4)));
typedef unsigned u32x4 __attribute__((ext_vector_type(4)));
constexpr int BM = 256, BK = 64, HALF = 128, HTB = HALF * BK * 2  , STAGE_BYTES = 8 * HTB, NXCD = 8, WGM = 8;

__host__ __device__ __forceinline__ int lds_byte(int r, int c) { const int st = (r >> 4) * 2 + (c >> 5), rr = r & 15, cc = c & 31, ob = rr * 64 + cc * 2; return st * 1024 + (ob ^ (((ob >> 9) & 1) << 5)); }
__host__ __device__ __forceinline__ void stage_rc(int b, int& R, int& C) { const int st = b / 1024, sb = b % 1024, swz = sb ^ (((sb >> 9) & 1) << 5); R = (st >> 1) * 16 + swz / 64; C = (st & 1) * 32 + (swz % 64) / 2; }
__host__ __device__ __forceinline__ int perm32(int rho) { const int n = rho >> 4, i = rho & 15; return 8 * (i >> 2) + 4 * n + (i & 3); }

struct Unit { int pm, pn; };
struct Gemm { const bf16_t* A; const bf16_t* Bt; int M, N, K; int bdiv; };
__device__ __forceinline__ int btile(const Gemm& g, const Unit& u) { return u.pn + (g.bdiv ? (u.pm / g.bdiv) * (g.N / BM) : 0); }

struct StaticOrder {
    int nM, nN, nwg, G, c, nxcd, wgm;
    __host__ __device__ void init(int M, int N, int G_, int c_, int nxcd_, int wgm_ = WGM) { nM = M / BM; nN = N / BM; nwg = nM * nN; G = G_; c = c_; nxcd = nxcd_; wgm = wgm_; }
    __host__ __device__ bool next(int i, Unit& u) const {
        const long L = (long)i * G + c; if (L >= nwg) return false;
        int wgid = (int)L; { const int q = nwg / nxcd, r = nwg % nxcd, xcd = wgid % nxcd, off = wgid / nxcd; wgid = (xcd < r ? xcd * (q + 1) : r * (q + 1) + (xcd - r) * q) + off; }
        const int nig = wgm * nN, gid = wgid / nig, fm = gid * wgm, gsz = (nM - fm) < wgm ? (nM - fm) : wgm;
        u.pm = fm + ((wgid % nig) % gsz); u.pn = (wgid % nig) / gsz; return true;
    }
    __device__ __forceinline__ void a_ready(const Unit&) const {}
    __device__ __forceinline__ void done(const Unit&) const {}
};

__device__ __forceinline__ unsigned cvt_pk_bf16(float lo, float hi) { unsigned r; asm volatile("v_cvt_pk_bf16_f32 %0, %1, %2" : "=v"(r) : "v"(lo), "v"(hi)); return r; }

struct EpiBf16 {
    static constexpr bool PERM = true, AFTER_DRAIN = false;
    bf16_t* O; int ldc;
    __device__ __forceinline__ void operator()(const f32x4 (&acc)[2][2][4][2], const Unit& u, int wr, int wc, int fr, int fq) const {
        const int row0 = u.pm * BM + wr * 64 + fr; const int col0 = u.pn * BM + wc * 32 + 8 * fq;
#pragma unroll
        for (int ai = 0; ai < 2; ++ai)
#pragma unroll
            for (int m = 0; m < 4; ++m) { bf16_t* rowp = O + (size_t)(row0 + ai * HALF + m * 16) * ldc + col0;
#pragma unroll
                for (int bj = 0; bj < 2; ++bj) { const f32x4 v0 = acc[ai][bj][m][0], v1 = acc[ai][bj][m][1];
                    u32x4 w; w.x = cvt_pk_bf16(v0[0], v0[1]); w.y = cvt_pk_bf16(v0[2], v0[3]); w.z = cvt_pk_bf16(v1[0], v1[1]); w.w = cvt_pk_bf16(v1[2], v1[3]);
                    __builtin_nontemporal_store(w, (u32x4*)(rowp + bj * HALF)); } }
    }
};

__device__ __forceinline__ float silu_mul(float g, float u) { const float e = __builtin_amdgcn_exp2f(g * -1.4426950408889634f); return g * __builtin_amdgcn_rcpf(1.0f + e) * u; }
struct EpiSwiGLU {
    static constexpr bool PERM = true, AFTER_DRAIN = false;
    bf16_t* O; int ldc;
    __device__ __forceinline__ void operator()(const f32x4 (&acc)[2][2][4][2], const Unit& u, int wr, int wc, int fr, int fq) const {
        const int row0 = u.pm * BM + wr * 64 + fr; const int col0 = u.pn * HALF + wc * 32 + 8 * fq;
#pragma unroll
        for (int ai = 0; ai < 2; ++ai)
#pragma unroll
            for (int m = 0; m < 4; ++m) { bf16_t* rowp = O + (size_t)(row0 + ai * HALF + m * 16) * ldc + col0;
                const f32x4 g0 = acc[ai][0][m][0], g1 = acc[ai][0][m][1], u0 = acc[ai][1][m][0], u1 = acc[ai][1][m][1];
                u32x4 w; w.x = cvt_pk_bf16(silu_mul(g0[0], u0[0]), silu_mul(g0[1], u0[1])); w.y = cvt_pk_bf16(silu_mul(g0[2], u0[2]), silu_mul(g0[3], u0[3]));
                w.z = cvt_pk_bf16(silu_mul(g1[0], u1[0]), silu_mul(g1[1], u1[1])); w.w = cvt_pk_bf16(silu_mul(g1[2], u1[2]), silu_mul(g1[3], u1[3]));
                __builtin_nontemporal_store(w, (u32x4*)rowp); }
    }
};

struct EpiBf16Stat {
    static constexpr bool PERM = true, AFTER_DRAIN = false;
    bf16_t* O; int ldc; float* part;
    __device__ __forceinline__ void operator()(const f32x4 (&acc)[2][2][4][2], const Unit& u, int wr, int wc, int fr, int fq) const {
        const int col0 = u.pn * BM + wc * 32 + 8 * fq;
#pragma unroll
        for (int ai = 0; ai < 2; ++ai)
#pragma unroll
            for (int m = 0; m < 4; ++m) { const int r = u.pm * BM + ai * HALF + wr * 64 + m * 16 + fr; bf16_t* rowp = O + (size_t)r * ldc + col0; float s = 0.f;
#pragma unroll
                for (int bj = 0; bj < 2; ++bj) { const f32x4 v0 = acc[ai][bj][m][0], v1 = acc[ai][bj][m][1];
                    s += ((v0[0] * v0[0] + v0[1] * v0[1]) + (v0[2] * v0[2] + v0[3] * v0[3])) + ((v1[0] * v1[0] + v1[1] * v1[1]) + (v1[2] * v1[2] + v1[3] * v1[3]));
                    u32x4 w; w.x = cvt_pk_bf16(v0[0], v0[1]); w.y = cvt_pk_bf16(v0[2], v0[3]); w.z = cvt_pk_bf16(v1[0], v1[1]); w.w = cvt_pk_bf16(v1[2], v1[3]);
                    *(u32x4*)(rowp + bj * HALF) = w; }
                s += __shfl_xor(s, 16); s += __shfl_xor(s, 32);
                if (fq == 0) part[(size_t)r * 32 + u.pn * 4 + wc] = s; }
    }
};

struct EpiPool {
    static constexpr bool PERM = true, AFTER_DRAIN = true;
    bf16_t* O; int ldc; const float* scale; PG8_LAS float* scr; float eps; int sh;
    __device__ __forceinline__ void fused(const f32x4 (&acc)[2][2][4][2], const Unit& u, int wr, int wc, int fr, int fq, PG8_LAS unsigned char*, int, int) const {
        const int grp = u.pm >> sh, rb = u.pm & ((1 << sh) - 1);
#pragma unroll
        for (int ai = 0; ai < 2; ++ai)
#pragma unroll
            for (int m = 0; m < 4; ++m) { float s = 0.f;
#pragma unroll
                for (int bj = 0; bj < 2; ++bj)
#pragma unroll
                    for (int n = 0; n < 2; ++n) { const f32x4 v = acc[ai][bj][m][n]; s += (v[0] * v[0] + v[1] * v[1]) + (v[2] * v[2] + v[3] * v[3]); }
                s += __shfl_xor(s, 16); s += __shfl_xor(s, 32);
                if (fq == 0) scr[(ai * HALF + wr * 64 + m * 16 + fr) * 4 + wc] = s;
                asm volatile("" ::: "memory"); }
        asm volatile("s_waitcnt lgkmcnt(0)" ::: "memory"); __builtin_amdgcn_s_barrier(); asm volatile("" ::: "memory");
        const int gc0 = grp * BM + wc * 32 + 8 * fq;
#pragma unroll
        for (int ai = 0; ai < 2; ++ai)
#pragma unroll
            for (int m = 0; m < 4; ++m) { const int rl = ai * HALF + wr * 64 + m * 16 + fr; const f32x4 p = *(const PG8_LAS f32x4*)(scr + rl * 4);
                const float rstd = __builtin_amdgcn_rsqf(((p[0] + p[1]) + (p[2] + p[3])) * (1.0f / 256.0f) + eps);
                bf16_t* rowp = O + (size_t)(rb * BM + rl) * ldc + 1024 + gc0;
#pragma unroll
                for (int bj = 0; bj < 2; ++bj) { const f32x4 s0 = *(const f32x4*)(scale + gc0 + bj * HALF), s1 = *(const f32x4*)(scale + gc0 + bj * HALF + 4);
                    const f32x4 v0 = acc[ai][bj][m][0] * rstd * s0, v1 = acc[ai][bj][m][1] * rstd * s1;
                    u32x4 w; w.x = cvt_pk_bf16(v0[0], v0[1]); w.y = cvt_pk_bf16(v0[2], v0[3]); w.z = cvt_pk_bf16(v1[0], v1[1]); w.w = cvt_pk_bf16(v1[2], v1[3]);
                    *(u32x4*)(rowp + bj * HALF) = w; }
                asm volatile("" ::: "memory"); }
        asm volatile("s_waitcnt lgkmcnt(0)" ::: "memory"); __builtin_amdgcn_s_barrier(); asm volatile("" ::: "memory");
    }
};

template <class Epi, class Sched, bool ALIGN_EPI = false, bool SP2 = false>
__device__ __forceinline__ void gemm_phase(PG8_LAS unsigned char* lds, const Gemm g, const Sched& S, const Epi& E) {
    const int tid = threadIdx.x, wid = __builtin_amdgcn_readfirstlane(tid >> 6), lane = tid & 63, wr = wid >> 2, wc = wid & 3, fr = lane & 15, fq = lane >> 4;
    const int K = g.K, nt = K / BK;
    unsigned voffA[2], voffB[2];
#pragma unroll
    for (int i = 0; i < 2; ++i) { int R, C; stage_rc(tid * 16 + i * 8192, R, C); const int Rb = Epi::PERM ? ((R & ~31) + perm32(R & 31)) : R;
        voffA[i] = (unsigned)(R * K + C) * 2u; voffB[i] = (unsigned)(Rb * K + C) * 2u; }
    const size_t kstep = (size_t)(BK * 2);
    const size_t hstep = (size_t)HALF * K * 2;
    const size_t tstep = 2 * hstep;
    const unsigned ldsw = (unsigned)wid * 1024u;
    const int aoff = lds_byte(wr * 64 + fr, fq * 8), boff = lds_byte(wc * 32 + fr, fq * 8);
#define PG8_SA(b, h) (((b) * 2 + (h)) * HTB)
#define PG8_SB(b, h) ((4 + (b) * 2 + (h)) * HTB)
#define PG8_STAGE(bufoff, gbase, voff) do { _Pragma("unroll") for (int _i = 0; _i < 2; ++_i) \
        __builtin_amdgcn_global_load_lds((const unsigned*)((const char*)(gbase) + (voff)[_i]), (PG8_LAS unsigned*)(lds + (bufoff) + ldsw + _i * 8192), 16, 0, 0); } while (0)
#define PG8_LDA(dst, b, h) do { _Pragma("unroll") for (int m = 0; m < 4; ++m) _Pragma("unroll") for (int k = 0; k < 2; ++k) dst[m][k] = *(const PG8_LAS bf16x8*)(lds + PG8_SA(b, h) + aoff + m * 2048 + k * 1024); } while (0)
#define PG8_LDB(dst, b, h) do { _Pragma("unroll") for (int n = 0; n < 2; ++n) _Pragma("unroll") for (int k = 0; k < 2; ++k) dst[n][k] = *(const PG8_LAS bf16x8*)(lds + PG8_SB(b, h) + boff + n * 2048 + k * 1024); } while (0)
#define PG8_MMA(ai, bj, At, Bt) do { __builtin_amdgcn_s_setprio(1); _Pragma("unroll") for (int m = 0; m < 4; ++m) _Pragma("unroll") for (int n = 0; n < 2; ++n) _Pragma("unroll") for (int k = 0; k < 2; ++k) \
        acc[ai][bj][m][n] = __builtin_amdgcn_mfma_f32_16x16x32_bf16(Bt[n][k], At[m][k], acc[ai][bj][m][n], 0, 0, 0); __builtin_amdgcn_s_setprio(0); } while (0)
#define PG8_WAIT_V(n) asm volatile("s_waitcnt vmcnt(" #n ")" ::: "memory")
#define PG8_WAIT_L(n) asm volatile("s_waitcnt lgkmcnt(" #n ")" ::: "memory")
#define PG8_BAR __builtin_amdgcn_s_barrier()
#define PG8_SCHED __builtin_amdgcn_sched_barrier(0)
    Unit cur, nxt; int ui = 0;
    if (!S.next(0, cur)) return;
    f32x4 acc[2][2][4][2];
#pragma unroll
    for (int a = 0; a < 2; ++a)
#pragma unroll
        for (int b = 0; b < 2; ++b)
#pragma unroll
            for (int m = 0; m < 4; ++m)
#pragma unroll
                for (int n = 0; n < 2; ++n) acc[a][b][m][n] = (f32x4){0.f, 0.f, 0.f, 0.f};
    bf16x8 At[4][2], B0[2][2], B1[2][2];
    const char* cA = (const char*)g.A + (size_t)cur.pm * tstep; const char* cB = (const char*)g.Bt + (size_t)btile(g, cur) * tstep;
    S.a_ready(cur);
    if constexpr (SP2) {
        PG8_STAGE(PG8_SB(0, 0), cB, voffB); PG8_STAGE(PG8_SB(0, 1), cB + hstep, voffB); PG8_STAGE(PG8_SA(0, 0), cA, voffA); PG8_STAGE(PG8_SA(0, 1), cA + hstep, voffA);
        if (wr == 1) PG8_BAR;
        PG8_WAIT_V(2); PG8_BAR;
        PG8_STAGE(PG8_SB(1, 0), cB + kstep, voffB); PG8_STAGE(PG8_SA(1, 0), cA + kstep, voffA); PG8_STAGE(PG8_SB(1, 1), cB + hstep + kstep, voffB);
        PG8_WAIT_V(6); PG8_BAR;
    } else {
        PG8_STAGE(PG8_SB(0, 0), cB, voffB); PG8_STAGE(PG8_SA(0, 0), cA, voffA); PG8_STAGE(PG8_SB(0, 1), cB + hstep, voffB); PG8_STAGE(PG8_SA(0, 1), cA + hstep, voffA);
        if (wr == 1) PG8_BAR;
        PG8_WAIT_V(4); PG8_BAR;
        PG8_STAGE(PG8_SB(1, 0), cB + kstep, voffB); PG8_STAGE(PG8_SA(1, 0), cA + kstep, voffA); PG8_STAGE(PG8_SB(1, 1), cB + hstep + kstep, voffB);
        PG8_WAIT_V(6); PG8_BAR;
    }
    for (;;) {
        const bool has_next = S.next(ui + 1, nxt);
        const char* nA = has_next ? (const char*)g.A + (size_t)nxt.pm * tstep : cA; const char* nB = has_next ? (const char*)g.Bt + (size_t)btile(g, nxt) * tstep : cB;
        for (int t = 0; t < nt; t += 2) {
            const bool last = (t == nt - 2);
            const char* a1 = cA + (size_t)(t + 1) * kstep;
            const char* a2 = last ? nA : cA + (size_t)(t + 2) * kstep; const char* b2 = last ? nB : cB + (size_t)(t + 2) * kstep;
            const char* a3 = a2 + kstep; const char* b3 = b2 + kstep;
            if (last && has_next) S.a_ready(nxt);
            if constexpr (SP2) {
            PG8_LDB(B0, 0, 0); PG8_LDB(B1, 0, 1); PG8_SCHED; PG8_LDA(At, 0, 0); PG8_STAGE(PG8_SA(1, 1), a1 + hstep, voffA);
            PG8_WAIT_V(8); PG8_WAIT_L(0); PG8_BAR; PG8_MMA(0, 0, At, B0); PG8_MMA(0, 1, At, B1); PG8_BAR; PG8_SCHED;
            PG8_LDA(At, 0, 1); PG8_STAGE(PG8_SB(0, 0), b2, voffB); PG8_STAGE(PG8_SB(0, 1), b2 + hstep, voffB); PG8_STAGE(PG8_SA(0, 0), a2, voffA);
            PG8_WAIT_V(8); PG8_WAIT_L(0); PG8_BAR; PG8_MMA(1, 0, At, B0); PG8_MMA(1, 1, At, B1); PG8_BAR; PG8_SCHED;
            PG8_LDB(B0, 1, 0); PG8_LDB(B1, 1, 1); PG8_SCHED; PG8_LDA(At, 1, 0); PG8_STAGE(PG8_SA(0, 1), a2 + hstep, voffA);
            PG8_WAIT_V(8); PG8_WAIT_L(0); PG8_BAR; PG8_MMA(0, 0, At, B0); PG8_MMA(0, 1, At, B1); PG8_BAR; PG8_SCHED;
            PG8_LDA(At, 1, 1); PG8_STAGE(PG8_SB(1, 0), b3, voffB); PG8_STAGE(PG8_SB(1, 1), b3 + hstep, voffB); PG8_STAGE(PG8_SA(1, 0), a3, voffA);
            PG8_WAIT_V(8); PG8_WAIT_L(0); PG8_BAR; PG8_MMA(1, 0, At, B0); PG8_MMA(1, 1, At, B1); PG8_BAR; PG8_SCHED;
            } else {
            PG8_LDB(B0, 0, 0); PG8_SCHED; PG8_LDA(At, 0, 0); PG8_STAGE(PG8_SA(1, 1), a1 + hstep, voffA);
            PG8_WAIT_L(8); PG8_BAR; PG8_WAIT_L(0); PG8_MMA(0, 0, At, B0); PG8_BAR; PG8_SCHED;
            PG8_LDB(B1, 0, 1); PG8_STAGE(PG8_SB(0, 0), b2, voffB);
            PG8_BAR; PG8_WAIT_L(0); PG8_MMA(0, 1, At, B1); PG8_BAR;
            PG8_LDA(At, 0, 1); PG8_STAGE(PG8_SA(0, 0), a2, voffA);
            PG8_BAR; PG8_WAIT_L(0); PG8_MMA(1, 0, At, B0); PG8_BAR; PG8_SCHED;
            PG8_STAGE(PG8_SB(0, 1), b2 + hstep, voffB);
            PG8_WAIT_V(6); PG8_BAR; PG8_MMA(1, 1, At, B1); PG8_BAR;
            PG8_LDB(B0, 1, 0); PG8_SCHED; PG8_LDA(At, 1, 0); PG8_STAGE(PG8_SA(0, 1), a2 + hstep, voffA);
            PG8_WAIT_L(8); PG8_BAR; PG8_WAIT_L(0); PG8_MMA(0, 0, At, B0); PG8_BAR; PG8_SCHED;
            PG8_LDB(B1, 1, 1); PG8_STAGE(PG8_SB(1, 0), b3, voffB);
            PG8_BAR; PG8_WAIT_L(0); PG8_MMA(0, 1, At, B1); PG8_BAR;
            PG8_LDA(At, 1, 1); PG8_STAGE(PG8_SA(1, 0), a3, voffA);
            PG8_BAR; PG8_WAIT_L(0); PG8_MMA(1, 0, At, B0); PG8_BAR; PG8_SCHED;
            PG8_STAGE(PG8_SB(1, 1), b3 + hstep, voffB);
            PG8_WAIT_V(6); PG8_BAR; PG8_MMA(1, 1, At, B1); PG8_BAR;
            }
        }
        if constexpr (ALIGN_EPI) { if (wr == 0) PG8_BAR; }
        if constexpr (!Epi::AFTER_DRAIN) { E(acc, cur, wr, wc, fr, fq); S.done(cur); }
        if (!has_next) break;
#pragma unroll
        for (int a = 0; a < 2; ++a)
#pragma unroll
            for (int b = 0; b < 2; ++b)
#pragma unroll
                for (int m = 0; m < 4; ++m)
#pragma unroll
                    for (int n = 0; n < 2; ++n) acc[a][b][m][n] = (f32x4){0.f, 0.f, 0.f, 0.f};
        cur = nxt; cA = nA; cB = nB; ++ui;
        if constexpr (ALIGN_EPI) { if (wr == 1) PG8_BAR; }
    }
    PG8_WAIT_V(0);
    if constexpr (!ALIGN_EPI) { if (wr == 0) PG8_BAR; }
    PG8_BAR;
    if constexpr (Epi::AFTER_DRAIN) { E.fused(acc, cur, wr, wc, fr, fq, lds, wid, lane); S.done(cur); }
#undef PG8_SA
#undef PG8_SB
#undef PG8_STAGE
#undef PG8_LDA
#undef PG8_LDB
#undef PG8_MMA
#undef PG8_WAIT_V
#undef PG8_WAIT_L
#undef PG8_BAR
#undef PG8_SCHED
}
}

constexpr int NWAVES = 8;
constexpr int BATCH = 2, SEQ = 8192, D = 2048, CW = 1024, PW = 1024, NPROJ = 4096, FF = 5632;
constexpr int M = BATCH * SEQ;
constexpr float EPS = 1e-6f;
constexpr int NGRP = 2, GW = 128, MG = SEQ;

constexpr size_t MiB = 1u << 20;
constexpr size_t WS_CTL = 0, CTL_ZERO_BYTES = 49152;
constexpr int CW_HALO = 9728;
constexpr int CW_P4 = 9600;
constexpr int CW_SLAB = 8448;
constexpr int CW_FLAG = 8192 - 128;
constexpr size_t WS_PART1 = 1 * MiB, WS_PART2 = 3 * MiB;
constexpr size_t WS_WD = 5 * MiB;
constexpr size_t WS_WIN = 27 * MiB;
constexpr size_t WS_WOUT = 43 * MiB;
constexpr size_t WS_WGU = 51 * MiB;
constexpr size_t WS_WPOOL = 95 * MiB;
constexpr size_t WS_H = 96 * MiB;
constexpr size_t WS_MIXOUT = 160 * MiB;
constexpr size_t WS_BLK = 224 * MiB, BLK_STRIDE = 120 * MiB;
#define WS_PROJ   (WS_BLK + (size_t)F.grp * BLK_STRIDE - (size_t)F.row0 * NPROJ * 2)
#define WS_POOLED (WS_BLK + (size_t)F.grp * BLK_STRIDE + 64 * MiB - (size_t)F.grp * 4 * MG * 256 * 2)
#define WS_MIXED  (WS_BLK + (size_t)F.grp * BLK_STRIDE + 80 * MiB - (size_t)F.row0 * D * 2)
#define WS_ACT    (WS_BLK + (size_t)F.grp * BLK_STRIDE - (size_t)F.row0 * FF * 2)
#define WS_FF     (WS_BLK + (size_t)F.grp * BLK_STRIDE + 88 * MiB - (size_t)F.row0 * D * 2)
constexpr size_t WS_END = WS_BLK + 2 * BLK_STRIDE;
static_assert(WS_WD + (size_t)D * FF * 2 <= WS_WIN && WS_WPOOL + 4 * 65536 * 2 <= WS_H && WS_H + (size_t)M * D * 2 <= WS_MIXOUT && WS_MIXOUT + (size_t)M * D * 2 <= WS_BLK
              && (size_t)MG * FF * 2 <= 88 * MiB && (size_t)MG * NPROJ * 2 <= 64 * MiB && 88 * MiB + (size_t)MG * D * 2 <= BLK_STRIDE && BLK_STRIDE <= WS_BLK, "d_ws map");

constexpr int RING_BYTES = 131072, EPI_SCR_OFF = RING_BYTES, MISC_OFF = RING_BYTES + 4096, LDS_BYTES = 147456;

#define GAS __attribute__((address_space(1)))
#define LAS __attribute__((address_space(3)))
typedef unsigned short bf16;
typedef unsigned v4u __attribute__((ext_vector_type(4)));
typedef unsigned v2u __attribute__((ext_vector_type(2)));
typedef float f32x4 __attribute__((ext_vector_type(4)));
#define LDS_WAIT() asm volatile("s_waitcnt lgkmcnt(0)" ::: "memory")
__device__ __forceinline__ unsigned f2bf(float f) { unsigned u = __builtin_bit_cast(unsigned, f); return (u + 0x7fffu + ((u >> 16) & 1u)) >> 16; }
__device__ __forceinline__ unsigned pk2(float lo, float hi) { return f2bf(lo) | (f2bf(hi) << 16); }
__device__ __forceinline__ float bflo(unsigned w) { return __builtin_bit_cast(float, w << 16); }
__device__ __forceinline__ float bfhi(unsigned w) { return __builtin_bit_cast(float, w & 0xffff0000u); }
__device__ __forceinline__ float wave_sum(float v) {
#pragma unroll
    for (int o = 1; o < 64; o <<= 1) v += __shfl_xor(v, o);
    return v;
}

typedef GAS unsigned gu32;
#define RLX_AGENT __ATOMIC_RELAXED, __HIP_MEMORY_SCOPE_AGENT
#define XB_TMO      128
#define XB_XCNT(j)  (256  + 64 * (j))
#define XB_XSUB(j)  (1280 + 64 * (j))
#define XB_XGEN(j)  (2304 + 64 * (j))
#define XB_TOP      3328
#define XB_TOPGEN   3392
#define XCD_BAR_WORDS 3456
#define XB_SPIN_CAP (1u << 18)

__device__ __forceinline__ unsigned xb_ld(unsigned* p)              { return __hip_atomic_load(p, __ATOMIC_RELAXED, __HIP_MEMORY_SCOPE_AGENT); }
__device__ __forceinline__ unsigned xb_add(unsigned* p, unsigned v) { return __hip_atomic_fetch_add(p, v, __ATOMIC_RELAXED, __HIP_MEMORY_SCOPE_AGENT); }
__device__ __forceinline__ unsigned xb_xcc_id() { return (unsigned)__builtin_amdgcn_s_getreg((3 << 11) | 20) & 0xFu; }
#define XB_SPIN(cond, bar) do { unsigned _sp = 0; while (cond) { __builtin_amdgcn_s_sleep(1); \
    if ((++_sp & 255u) == 0u) { if (xb_ld(&(bar)[XB_TMO])) break; if (_sp > XB_SPIN_CAP) { atomicAdd(&(bar)[XB_TMO], 1u); break; } } } } while (0)

struct XcdBarrier {
    unsigned* bar; unsigned x; unsigned G;
    volatile LAS unsigned* st;
};

__device__ __forceinline__ XcdBarrier xcd_barrier_post(unsigned* bar, volatile LAS unsigned* st, unsigned G) {
    XcdBarrier b; b.bar = bar; b.x = xb_xcc_id(); b.st = st; b.G = G;
    if (threadIdx.x == 0) (void)xb_add(&bar[XB_XCNT(b.x)], 1u);
    return b;
}
__device__ __forceinline__ void xcd_barrier_complete(unsigned* bar, unsigned x, unsigned G, unsigned& nloc, unsigned& nx) {
    unsigned sum, cnt, mine, sp = 0u;
    for (;;) {
        sum = 0u; cnt = 0u; mine = 0u;
#pragma unroll
        for (unsigned j = 0; j < 16; ++j) { const unsigned c = xb_ld(&bar[XB_XCNT(j)]); sum += c; cnt += (c > 0u) ? 1u : 0u; mine = (j == x) ? c : mine; }
        if (sum == G) break;
        __builtin_amdgcn_s_sleep(1);
        if ((++sp & 255u) == 0u) { if (xb_ld(&bar[XB_TMO])) break; if (sp > XB_SPIN_CAP) { atomicAdd(&bar[XB_TMO], 1u); break; } }
    }
    nloc = mine > 0u ? mine : 1u; nx = cnt > 0u ? cnt : 1u;
}

__device__ __forceinline__ void xcd_barrier(const XcdBarrier& b) {
    asm volatile("s_waitcnt vmcnt(0)" ::: "memory");
    __syncthreads();
    if (threadIdx.x == 0) {
        unsigned* bar = b.bar;
        __builtin_amdgcn_s_waitcnt(0);
        unsigned nloc = b.st[0], nx = b.st[1];
        if (nloc == 0u) { xcd_barrier_complete(bar, b.x, b.G, nloc, nx); b.st[0] = nloc; b.st[1] = nx; }
        const unsigned old = xb_add(&bar[XB_XSUB(b.x)], 1u);
        const unsigned gen = old / nloc;
        if (old + 1u == (gen + 1u) * nloc) {
            __builtin_amdgcn_fence(__ATOMIC_RELEASE, "agent");
            asm volatile("s_waitcnt vmcnt(0)" ::: "memory");
            const unsigned og = xb_add(&bar[XB_TOP], 1u);
            const unsigned tg = og / nx;
            if (og + 1u == (tg + 1u) * nx) xb_add(&bar[XB_TOPGEN], 1u);
            else XB_SPIN(xb_ld(&bar[XB_TOPGEN]) == tg, bar);
            __builtin_amdgcn_fence(__ATOMIC_ACQUIRE, "agent");
            xb_add(&bar[XB_XGEN(b.x)], 1u);
            asm volatile("s_waitcnt vmcnt(0)" ::: "memory");
        } else {
            XB_SPIN(xb_ld(&bar[XB_XGEN(b.x)]) == gen, bar);
            __builtin_amdgcn_fence(__ATOMIC_ACQUIRE, "agent");
            asm volatile("s_waitcnt vmcnt(0)" ::: "memory");
        }
    }
    __syncthreads();
}

struct Frame {
    LAS unsigned char* lds;
    int tid, lane, wave;
    int grp, c, row0, sw;
    const float *x, *g_pre, *w_in, *conv_w, *pool_w, *pool_scale, *w_out, *g_post, *g_fpre, *w_gate, *w_up, *w_down, *g_fpost;
    float* out; unsigned char* ws;
};

__device__ __forceinline__ int opq(int v) { asm volatile("" : "+v"(v)); return v; }
__device__ __forceinline__ unsigned pkbf(float lo, float hi) { return pg8::cvt_pk_bf16(lo, hi); }
constexpr int TSCR_BYTES = 64 * 65 * 4;
struct TItem { const float* W; bf16* WT; int K, N, drow0, k0, n0; };
__device__ __forceinline__ TItem titem(const float* W, int K, int N, bf16* WT, int mode, int item) {
    TItem t; t.W = W; t.WT = WT; t.K = K; t.N = N;
    const int nblk = N / 64, kb = item / nblk, nb = item % nblk; t.k0 = 64 * kb; t.n0 = 64 * nb;
    t.drow0 = mode == 0 ? t.n0 : ((t.n0 >> 7) * 256 + (t.n0 & 127) + (mode == 2 ? 128 : 0));
    return t;
}
__device__ __forceinline__ void titem_load(const TItem& t, f32x4 (&r)[16], int lane) {
    const GAS f32x4* src = (const GAS f32x4*)(t.W + (size_t)(t.k0 + (lane >> 4)) * t.N + t.n0 + 4 * (lane & 15));
#pragma unroll
    for (int i = 0; i < 16; ++i) r[i] = __builtin_nontemporal_load(src + (size_t)i * t.N);
}
template <bool NTS>
__device__ __forceinline__ void titem_store(const TItem& t, const f32x4 (&r)[16], LAS float* scr, int lane) {
#pragma unroll
    for (int i = 0; i < 16; ++i) { LAS float* d = scr + (4 * i + (lane >> 4)) * 65 + 4 * (lane & 15); d[0] = r[i].x; d[1] = r[i].y; d[2] = r[i].z; d[3] = r[i].w; }
    LDS_WAIT(); asm volatile("" ::: "memory");
    const int c = lane & 7;
#pragma unroll
    for (int j = 0; j < 8; ++j) { const int n = (lane >> 3) + 8 * j; const LAS float* s = scr + (8 * c) * 65 + n;
        v4u o; o.x = pkbf(s[0 * 65], s[1 * 65]); o.y = pkbf(s[2 * 65], s[3 * 65]); o.z = pkbf(s[4 * 65], s[5 * 65]); o.w = pkbf(s[6 * 65], s[7 * 65]);
        if (NTS) __builtin_nontemporal_store(o, (GAS v4u*)(t.WT + (size_t)(t.drow0 + n) * t.K + t.k0 + 8 * c)); else *(GAS v4u*)(t.WT + (size_t)(t.drow0 + n) * t.K + t.k0 + 8 * c) = o; }
    LDS_WAIT(); asm volatile("" ::: "memory");
}
__device__ __forceinline__ TItem win_item(Frame& F, int r) {
    constexpr int I_IN = (D / 64) * (NPROJ / 64), I_OUT = (D / 64) * (D / 64), I_P1 = (256 / 64) * (256 / 64);
    if (r < I_IN) return titem(F.w_in, D, NPROJ, (bf16*)(F.ws + WS_WIN), 0, r);
    r -= I_IN;
    if (r < I_OUT) return titem(F.w_out, D, D, (bf16*)(F.ws + WS_WOUT), 0, r);
    r -= I_OUT;
    const int g = r / I_P1; return titem(F.pool_w + (size_t)g * 65536, 256, 256, (bf16*)(F.ws + WS_WPOOL) + (size_t)g * 65536, 0, r % I_P1);
}
__device__ __forceinline__ TItem wrest_item(Frame& F, int r) {
    constexpr int I_G = (D / 64) * (FF / 64);
    if (r < I_G) return titem(F.w_gate, D, FF, (bf16*)(F.ws + WS_WGU), 1, r);
    r -= I_G;
    if (r < I_G) return titem(F.w_up, D, FF, (bf16*)(F.ws + WS_WGU), 2, r);
    r -= I_G;
    return titem(F.w_down, FF, D, (bf16*)(F.ws + WS_WD), 0, r);
}
template <bool REST>
__device__ __forceinline__ void p0_weights(Frame& F) {
    LAS float* scr = (LAS float*)(F.lds + F.wave * TSCR_BYTES);
    const int gw = F.c * NWAVES + F.wave, NGW = GW * NWAVES;
    constexpr int NITEMS = REST ? 2 * (D / 64) * (FF / 64) + (FF / 64) * (D / 64) : (D / 64) * (NPROJ / 64) + (D / 64) * (D / 64) + 4 * 16;
    int it = gw; if (it >= NITEMS) return;
    TItem cur = REST ? wrest_item(F, it) : win_item(F, it); f32x4 rc[16]; titem_load(cur, rc, F.lane);
#pragma unroll 1
    for (;;) {
        const int itn = it + NGW; const bool has = itn < NITEMS;
        TItem nxt = cur; f32x4 rn[16];
        if (has) { nxt = REST ? wrest_item(F, itn) : win_item(F, itn); titem_load(nxt, rn, F.lane); }
        titem_store<REST>(cur, rc, scr, F.lane);
        if (!has) break;
        cur = nxt; it = itn;
#pragma unroll
        for (int i = 0; i < 16; ++i) rc[i] = rn[i];
    }
}
__device__ __forceinline__ void p0_hrows(Frame& F) {
    const int gw = F.c * NWAVES + F.wave, NGW = GW * NWAVES;
    f32x4 gv[8];
#pragma unroll
    for (int j = 0; j < 8; ++j) gv[j] = ((const GAS f32x4*)F.g_pre)[F.lane + 64 * j];
    bf16* H = (bf16*)(F.ws + WS_H);
    for (int blk = gw; blk < MG / 8; blk += NGW) {
        const int m0 = F.row0 + 8 * blk;
        f32x4 v[2][8], w[2][8];
#pragma unroll
        for (int q = 0; q < 2; ++q) { const GAS f32x4* xr = (const GAS f32x4*)(F.x + (size_t)(m0 + q) * D) + F.lane;
#pragma unroll
            for (int j = 0; j < 8; ++j) v[q][j] = __builtin_nontemporal_load(xr + 64 * j); }
#pragma unroll 1
        for (int pr = 0; pr < 4; ++pr) {
            if (pr < 3) {
#pragma unroll
                for (int q = 0; q < 2; ++q) { const GAS f32x4* xr = (const GAS f32x4*)(F.x + (size_t)(m0 + 2 * pr + 2 + q) * D) + F.lane;
#pragma unroll
                    for (int j = 0; j < 8; ++j) w[q][j] = __builtin_nontemporal_load(xr + 64 * j); } }
#pragma unroll
            for (int q = 0; q < 2; ++q) { float s = 0.f;
#pragma unroll
                for (int j = 0; j < 8; ++j) s += (v[q][j].x * v[q][j].x + v[q][j].y * v[q][j].y) + (v[q][j].z * v[q][j].z + v[q][j].w * v[q][j].w);
                const float rstd = 1.0f / sqrtf(wave_sum(s) * (1.0f / D) + EPS);
                GAS v2u* o8 = (GAS v2u*)(H + (size_t)(m0 + 2 * pr + q) * D) + F.lane;
#pragma unroll
                for (int j = 0; j < 8; ++j) { const f32x4 y = v[q][j] * rstd * gv[j]; v2u o; o.x = pkbf(y.x, y.y); o.y = pkbf(y.z, y.w); o8[64 * j] = o; } }
            if (pr < 3) {
#pragma unroll
                for (int q = 0; q < 2; ++q)
#pragma unroll
                    for (int j = 0; j < 8; ++j) v[q][j] = w[q][j]; }
        }
    }
}

__device__ __forceinline__ void up8(const v4u w, float (&f)[8]) { f[0] = bflo(w.x); f[1] = bfhi(w.x); f[2] = bflo(w.y); f[3] = bfhi(w.y); f[4] = bflo(w.z); f[5] = bfhi(w.z); f[6] = bflo(w.w); f[7] = bfhi(w.w); }
__device__ __forceinline__ v4u pk8(const float (&f)[8]) { v4u o; o.x = pkbf(f[0], f[1]); o.y = pkbf(f[2], f[3]); o.z = pkbf(f[4], f[5]); o.w = pkbf(f[6], f[7]); return o; }
__device__ __forceinline__ v4u ldg16(const bf16* p) { return __builtin_nontemporal_load((const GAS v4u*)p); }
struct ConvB { v4u b[4], c[4], u[4]; };
__device__ __forceinline__ void convb_load(ConvB& X, const bf16* row) {
#pragma unroll
    for (int r = 0; r < 4; ++r) { const bf16* q = row + (size_t)r * NPROJ + CW; X.b[r] = ldg16(q - CW); X.c[r] = ldg16(q); X.u[r] = ldg16(q + CW); }
}
__device__ __forceinline__ void conv_halo(const bf16* P, int t0, int m0, v4u (&hc)[2], v4u (&hu)[2]) {
    const v4u z = {0u, 0u, 0u, 0u};
#pragma unroll
    for (int j = 0; j < 2; ++j) { hc[j] = z; hu[j] = z; }
    if (t0 > 0) {
#pragma unroll
        for (int j = 0; j < 2; ++j) { hc[j] = ldg16(P + (size_t)(m0 - 1 - j) * NPROJ + CW); hu[j] = ldg16(P + (size_t)(m0 - 1 - j) * NPROJ + 2 * CW); } }
}
__device__ __forceinline__ void conv_cu_init(const v4u (&hc)[2], const v4u (&hu)[2], float (&cu1)[8], float (&cu2)[8]) {
    float c[8], u[8]; up8(hc[0], c); up8(hu[0], u);
#pragma unroll
    for (int i = 0; i < 8; ++i) cu1[i] = c[i] * u[i];
    up8(hc[1], c); up8(hu[1], u);
#pragma unroll
    for (int i = 0; i < 8; ++i) cu2[i] = c[i] * u[i];
}
__device__ __forceinline__ void conv_rows(const ConvB& X, float (&cu1)[8], float (&cu2)[8], const LAS float* wl, bf16* mixrow) {
#pragma unroll
    for (int r = 0; r < 4; ++r) {
        float b[8], c[8], u[8], y[8]; up8(X.b[r], b); up8(X.c[r], c); up8(X.u[r], u);
        float w0[8], w1[8], w2[8];
#pragma unroll
        for (int i = 0; i < 8; ++i) { w0[i] = wl[i]; w1[i] = wl[CW + i]; w2[i] = wl[2 * CW + i]; }
        float ss = 0.f;
#pragma unroll
        for (int i = 0; i < 8; ++i) { const float cu0 = c[i] * u[i]; y[i] = b[i] * (w0[i] * cu2[i] + w1[i] * cu1[i] + w2[i] * cu0); ss += y[i] * y[i]; cu2[i] = cu1[i]; cu1[i] = cu0; }
        ss += __shfl_xor(ss, 1); ss += __shfl_xor(ss, 2); ss += __shfl_xor(ss, 4); ss += __shfl_xor(ss, 8);
        const float rstd = 1.0f / sqrtf(ss * (1.0f / 128.0f) + EPS);
#pragma unroll
        for (int i = 0; i < 8; ++i) y[i] *= rstd;
        *(GAS v4u*)(mixrow + (size_t)r * D) = pk8(y);
        __builtin_amdgcn_sched_barrier(0);
    }
}
__device__ __forceinline__ void conv_chunk(Frame& F, int t0, int m0) {
    const int l = opq(F.lane);
    const bf16* P = (const bf16*)(F.ws + WS_PROJ) + 8 * l; bf16* MIX = (bf16*)(F.ws + WS_MIXED) + 8 * l;
    const LAS float* WL = (const LAS float*)F.lds + 8 * l;
    ConvB A, B; v4u hc[2], hu[2]; float cu1[8], cu2[8];
    conv_halo(P, t0, m0, hc, hu); convb_load(A, P + (size_t)m0 * NPROJ);
    convb_load(B, P + (size_t)(m0 + 4) * NPROJ);
    conv_cu_init(hc, hu, cu1, cu2);
    conv_rows(A, cu1, cu2, WL, MIX + (size_t)m0 * D);
    conv_halo(P + 512, t0, m0, hc, hu); convb_load(A, P + 512 + (size_t)m0 * NPROJ);
    conv_rows(B, cu1, cu2, WL, MIX + (size_t)(m0 + 4) * D);
    convb_load(B, P + 512 + (size_t)(m0 + 4) * NPROJ);
    conv_cu_init(hc, hu, cu1, cu2);
    conv_rows(A, cu1, cu2, WL + 512, MIX + 512 + (size_t)m0 * D);
    conv_rows(B, cu1, cu2, WL + 512, MIX + 512 + (size_t)(m0 + 4) * D);
}
template <int WLO, int WHI>
__device__ __forceinline__ void pool_pass(Frame& F, int p, int t0, int m0) {
    const int l = opq(F.lane); const bool lo = l < 32;
    const bf16* V = (const bf16*)(F.ws + WS_PROJ) + 3 * CW + 512 * p + 8 * l;
    bf16* PO = (bf16*)(F.ws + WS_POOLED) + ((size_t)(F.grp * 4 + 2 * p + (l >> 5)) * MG + t0) * 256 + 8 * (l & 31);
    const v4u z = {0u, 0u, 0u, 0u};
    v4u pv[WHI], cv[8];
#pragma unroll
    for (int j = 1; j < WHI; ++j) pv[j] = z;
    if (t0 >= 16) {
#pragma unroll
        for (int j = 1; j < WHI; ++j) pv[j] = ldg16(V + (size_t)(m0 - j) * NPROJ);
    } else if (t0 == 8) {
#pragma unroll
        for (int j = 1; j < WHI && j <= 8; ++j) pv[j] = ldg16(V + (size_t)(m0 - j) * NPROJ);
    }
#pragma unroll
    for (int r = 0; r < 8; ++r) cv[r] = ldg16(V + (size_t)(m0 + r) * NPROJ);
    float Wl[8], Wh[8];
#pragma unroll
    for (int i = 0; i < 8; ++i) { Wl[i] = 0.f; Wh[i] = 0.f; }
#pragma unroll
    for (int j = 1; j < WHI; ++j) { float f[8]; up8(pv[j], f);
#pragma unroll
        for (int i = 0; i < 8; ++i) { if (j < WLO) Wl[i] += f[i]; Wh[i] += f[i]; } }
#pragma unroll
    for (int r = 0; r < 8; ++r) {
        const int t = t0 + r; float v[8], o[8]; up8(cv[r], v);
        const float il = 1.0f / (float)((t + 1) < WLO ? (t + 1) : WLO), ih = 1.0f / (float)((t + 1) < WHI ? (t + 1) : WHI);
#pragma unroll
        for (int i = 0; i < 8; ++i) { Wl[i] += v[i]; Wh[i] += v[i]; o[i] = (lo ? Wl[i] * il : Wh[i] * ih) - v[i]; }
        *(GAS v4u*)(PO + (size_t)r * 256) = pk8(o);
        { float f[8]; up8((r - WLO + 1 >= 0) ? cv[(r - WLO + 1 >= 0) ? r - WLO + 1 : 0] : pv[(WLO - 1 - r > 0) ? WLO - 1 - r : 1], f);
#pragma unroll
          for (int i = 0; i < 8; ++i) Wl[i] -= f[i]; }
        { float f[8]; up8((r - WHI + 1 >= 0) ? cv[(r - WHI + 1 >= 0) ? r - WHI + 1 : 0] : pv[(WHI - 1 - r > 0) ? WHI - 1 - r : 1], f);
#pragma unroll
          for (int i = 0; i < 8; ++i) Wh[i] -= f[i]; }
        __builtin_amdgcn_sched_barrier(0);
    }
}
__device__ __forceinline__ void p2_mixer(Frame& F) {
    { LAS f32x4* W4 = (LAS f32x4*)F.lds; for (int i = F.tid; i < 3 * CW / 4; i += NWAVES * 64) W4[i] = ((const GAS f32x4*)F.conv_w)[i]; }
    __syncthreads();
    const int gw = F.sw * NWAVES + F.wave, NGW = GW * NWAVES;
    for (int chunk = gw; chunk < MG / 8; chunk += NGW) {
        const int t0 = chunk * 8, m0 = F.row0 + t0;
        conv_chunk(F, t0, m0); asm volatile("" ::: "memory");
        pool_pass<2, 4>(F, 0, t0, m0); asm volatile("" ::: "memory"); pool_pass<8, 16>(F, 1, t0, m0); asm volatile("" ::: "memory");
    }
}

__device__ __forceinline__ float sq4(const f32x4 v) { return (v.x * v.x + v.y * v.y) + (v.z * v.z + v.w * v.w); }
__device__ __forceinline__ f32x4 bf4lo(const v4u w) { return (f32x4){bflo(w.x), bfhi(w.x), bflo(w.y), bfhi(w.y)}; }
__device__ __forceinline__ f32x4 bf4hi(const v4u w) { return (f32x4){bflo(w.z), bfhi(w.z), bflo(w.w), bfhi(w.w)}; }
struct Row5 { f32x4 x[4][2]; v4u mo[4]; float p; };
__device__ __forceinline__ void ld_row5(Row5& R, const float* x, const bf16* MO, const float* part, int m, int l) {
    const GAS f32x4* xr = (const GAS f32x4*)(x + (size_t)m * D + 8 * l); const GAS v4u* mr = (const GAS v4u*)(MO + (size_t)m * D + 8 * l);
#pragma unroll
    for (int j = 0; j < 4; ++j) { R.x[j][0] = xr[128 * j]; R.x[j][1] = xr[128 * j + 1]; R.mo[j] = mr[64 * j]; }
    R.p = part[(size_t)m * 32 + (l & 31)];
}
__device__ __forceinline__ void p5_resnorm(Frame& F) {
    const int gw = F.sw * NWAVES + F.wave, NGW = GW * NWAVES, l = opq(F.lane);
    const bf16* MO = (const bf16*)(F.ws + WS_MIXOUT); const float* part = (const float*)(F.ws + WS_PART1); bf16* H = (bf16*)(F.ws + WS_H);
    LAS f32x4* G1 = (LAS f32x4*)F.lds; LAS f32x4* G2 = (LAS f32x4*)(F.lds + 8192);
    if (F.tid < 512) { G1[F.tid] = ((const GAS f32x4*)F.g_post)[F.tid]; G2[F.tid] = ((const GAS f32x4*)F.g_fpre)[F.tid]; }
    __syncthreads();
    for (int blk = gw; blk < MG / 8; blk += NGW) {
        const int m0 = F.row0 + 8 * blk;
        Row5 cur, nxt, nx2; ld_row5(cur, F.x, MO, part, m0, l); ld_row5(nxt, F.x, MO, part, m0 + 1, l);
#pragma unroll 1
        for (int r = 0; r < 8; ++r) {
            if (r + 2 < 8) ld_row5(nx2, F.x, MO, part, m0 + r + 2, l);
            const float rstd1 = 1.0f / sqrtf(wave_sum(l < 32 ? cur.p : 0.f) * (1.0f / D) + EPS);
            f32x4 v[4][2]; float s = 0.f;
#pragma unroll
            for (int j = 0; j < 4; ++j) { v[j][0] = cur.x[j][0] + bf4lo(cur.mo[j]) * rstd1 * G1[2 * l + 128 * j]; v[j][1] = cur.x[j][1] + bf4hi(cur.mo[j]) * rstd1 * G1[2 * l + 128 * j + 1]; s += sq4(v[j][0]) + sq4(v[j][1]); }
            const float rstd2 = 1.0f / sqrtf(wave_sum(s) * (1.0f / D) + EPS);
            GAS v4u* hr = (GAS v4u*)(H + (size_t)(m0 + r) * D + 8 * l);
#pragma unroll
            for (int j = 0; j < 4; ++j) { const f32x4 y0 = v[j][0] * rstd2 * G2[2 * l + 128 * j], y1 = v[j][1] * rstd2 * G2[2 * l + 128 * j + 1];
                v4u w; w.x = pkbf(y0.x, y0.y); w.y = pkbf(y0.z, y0.w); w.z = pkbf(y1.x, y1.y); w.w = pkbf(y1.z, y1.w); hr[64 * j] = w; __builtin_amdgcn_sched_barrier(0); }
            cur = nxt; nxt = nx2;
        }
    }
}
struct Row8 { f32x4 x[4][2]; v4u mo[4], ff[4]; float p1, p2; };
__device__ __forceinline__ void ld_row8(Row8& R, const float* x, const bf16* MO, const bf16* FFO, const float* part1, const float* part2, int m, int l) {
    const GAS f32x4* xr = (const GAS f32x4*)(x + (size_t)m * D + 8 * l); const GAS v4u* mr = (const GAS v4u*)(MO + (size_t)m * D + 8 * l); const GAS v4u* fr = (const GAS v4u*)(FFO + (size_t)m * D + 8 * l);
#pragma unroll
    for (int j = 0; j < 4; ++j) { R.x[j][0] = xr[128 * j]; R.x[j][1] = xr[128 * j + 1]; R.mo[j] = mr[64 * j]; R.ff[j] = fr[64 * j]; }
    R.p1 = part1[(size_t)m * 32 + (l & 31)]; R.p2 = part2[(size_t)m * 32 + (l & 31)];
}
__device__ __forceinline__ void p8_final(Frame& F) {
    const int gw = F.sw * NWAVES + F.wave, NGW = GW * NWAVES, l = opq(F.lane);
    const bf16* MO = (const bf16*)(F.ws + WS_MIXOUT); const bf16* FFO = (const bf16*)(F.ws + WS_FF);
    const float* part1 = (const float*)(F.ws + WS_PART1); const float* part2 = (const float*)(F.ws + WS_PART2);
    LAS f32x4* G1 = (LAS f32x4*)F.lds; LAS f32x4* G3 = (LAS f32x4*)(F.lds + 8192);
    if (F.tid < 512) { G1[F.tid] = ((const GAS f32x4*)F.g_post)[F.tid]; G3[F.tid] = ((const GAS f32x4*)F.g_fpost)[F.tid]; }
    __syncthreads();
    for (int blk = gw; blk < MG / 8; blk += NGW) {
        const int m0 = F.row0 + 8 * blk;
        Row8 cur, nxt, nx2; ld_row8(cur, F.x, MO, FFO, part1, part2, m0, l); ld_row8(nxt, F.x, MO, FFO, part1, part2, m0 + 1, l);
#pragma unroll 1
        for (int r = 0; r < 8; ++r) {
            if (r + 2 < 8) ld_row8(nx2, F.x, MO, FFO, part1, part2, m0 + r + 2, l);
            const float rstd1 = 1.0f / sqrtf(wave_sum(l < 32 ? cur.p1 : 0.f) * (1.0f / D) + EPS), rstd2 = 1.0f / sqrtf(wave_sum(l < 32 ? cur.p2 : 0.f) * (1.0f / D) + EPS);
            GAS f32x4* orow = (GAS f32x4*)(F.out + (size_t)(m0 + r) * D + 8 * l);
#pragma unroll
            for (int j = 0; j < 4; ++j) { orow[128 * j] = cur.x[j][0] + bf4lo(cur.mo[j]) * rstd1 * G1[2 * l + 128 * j] + bf4lo(cur.ff[j]) * rstd2 * G3[2 * l + 128 * j];
                orow[128 * j + 1] = cur.x[j][1] + bf4hi(cur.mo[j]) * rstd1 * G1[2 * l + 128 * j + 1] + bf4hi(cur.ff[j]) * rstd2 * G3[2 * l + 128 * j + 1]; __builtin_amdgcn_sched_barrier(0); }
            cur = nxt; nxt = nx2;
        }
    }
}

__device__ __forceinline__ void flag_set(unsigned* flag) { __hip_atomic_store(flag, 1u, __ATOMIC_RELAXED, __HIP_MEMORY_SCOPE_AGENT); }
__device__ __forceinline__ void flag_wait(unsigned* flag, unsigned* tmo) {
    if (threadIdx.x == 0) {
        unsigned sp = 0u;
        while (xb_ld(flag) == 0u) { __builtin_amdgcn_s_sleep(2); if ((++sp & 255u) == 0u) { if (xb_ld(tmo)) break; if (sp > XB_SPIN_CAP) { atomicAdd(tmo, 1u); break; } } }
        __builtin_amdgcn_fence(__ATOMIC_ACQUIRE, "agent");
        asm volatile("s_waitcnt vmcnt(0)" ::: "memory");
    }
    __syncthreads();
}

__device__ __forceinline__ void slab_barrier(unsigned* cnt, unsigned target, unsigned* tmo, unsigned samex) {
    asm volatile("s_waitcnt vmcnt(0)" ::: "memory");
    __syncthreads();
    if (threadIdx.x == 0) {
        if (!samex) { __builtin_amdgcn_fence(__ATOMIC_RELEASE, "agent"); asm volatile("s_waitcnt vmcnt(0)" ::: "memory"); }
        (void)xb_add(cnt, 1u);
        unsigned sp = 0u;
        while (xb_ld(cnt) < target) { __builtin_amdgcn_s_sleep(1); if ((++sp & 255u) == 0u) { if (xb_ld(tmo)) break; if (sp > XB_SPIN_CAP) { atomicAdd(tmo, 1u); break; } } }
        __builtin_amdgcn_fence(__ATOMIC_ACQUIRE, "agent");
        asm volatile("s_waitcnt vmcnt(0)" ::: "memory");
    }
    __syncthreads();
}
struct SlabPoolOrder {
    int c;
    __device__ __forceinline__ bool next(int i, pg8::Unit& u) const { if (i) return false; u.pm = ((c >> 3) >> 2) * 32 + 4 * (c & 7) + ((c >> 3) & 3); u.pn = 0; return true; }
    __device__ __forceinline__ void a_ready(const pg8::Unit&) const {}
    __device__ __forceinline__ void done(const pg8::Unit&) const {}
};

#ifndef WGMG
#define WGMG 4
#endif
constexpr int NXG = 8;
struct Args { const float* in[13]; float* out; unsigned char* ws; };
__global__ void __launch_bounds__(NWAVES * 64, 2) mk_fwd(Args args) {
    extern __shared__ __attribute__((aligned(16))) unsigned char lds[];
    Frame F;
    F.lds = (LAS unsigned char*)lds;
    F.tid = threadIdx.x; F.lane = F.tid & 63; F.wave = __builtin_amdgcn_readfirstlane(F.tid >> 6);
    { const int bx = blockIdx.x; F.grp = (bx >> 3) & 1; F.c = (bx >> 4) * 8 + (bx & 7); F.row0 = F.grp * MG; F.sw = (F.c & 7) * 16 + (F.c >> 3); }
    F.x = args.in[0]; F.g_pre = args.in[1]; F.w_in = args.in[2]; F.conv_w = args.in[3]; F.pool_w = args.in[4]; F.pool_scale = args.in[5]; F.w_out = args.in[6];
    F.g_post = args.in[7]; F.g_fpre = args.in[8]; F.w_gate = args.in[9]; F.w_up = args.in[10]; F.w_down = args.in[11]; F.g_fpost = args.in[12];
    F.out = args.out; F.ws = args.ws;
    unsigned char* ws = args.ws;
    unsigned* ctl = (unsigned*)(ws + WS_CTL);
    volatile LAS unsigned* MISC = (volatile LAS unsigned*)(F.lds + MISC_OFF);
    if (F.tid < 64) MISC[F.tid] = 0u;
    __syncthreads();
    const XcdBarrier bar = xcd_barrier_post(ctl + 4096 * F.grp, MISC + 8, (unsigned)GW);
    unsigned* flagA = ctl + CW_FLAG; unsigned* flagB = ctl + CW_FLAG + 64; unsigned* tmo = ctl + 4096 * F.grp + XB_TMO;
#define BAR() xcd_barrier(bar)
    unsigned* slabcnt = ctl + CW_SLAB + 64 * (8 * F.grp + (F.c & 7));
    if (F.tid == 0) (void)__hip_atomic_fetch_or(slabcnt + 1, 1u << bar.x, __ATOMIC_RELAXED, __HIP_MEMORY_SCOPE_AGENT);
    unsigned samex = 0u;
#define SBAR(k) slab_barrier(slabcnt, 16u * (k), ctl + 4096 * F.grp + XB_TMO, samex)
#ifndef PROBE_B
#define PROBE_G 0
#define PROBE_A 0
#define PROBE_B 0
#define PROBE_MUL 4
#endif
    unsigned long long* stamps = (unsigned long long*)(ctl + 8192);
#define STAMP(k) do { if (PROBE_B > PROBE_A && F.c == 0 && F.tid == 0) __hip_atomic_store(stamps + F.grp * 16 + (k), (unsigned long long)__builtin_amdgcn_s_memrealtime(), __ATOMIC_RELAXED, __HIP_MEMORY_SCOPE_AGENT); } while (0)
    STAMP(0);
    typedef pg8::bf16_t bt;
    const size_t r0 = (size_t)F.row0;
    if (F.grp == 0) { p0_weights<false>(F); p0_hrows(F); BAR(); if (F.c == 0 && F.tid == 0) flag_set(flagA); }
    else { p0_weights<true>(F); p0_hrows(F); BAR(); if (F.c == 0 && F.tid == 0) flag_set(flagB); flag_wait(flagA, tmo); }
    STAMP(1);
    if (F.tid == 0) MISC[12] = (__builtin_popcount(xb_ld(slabcnt + 1)) == 1) ? 1u : 0u;
    __syncthreads();
    samex = MISC[12];
#ifndef PHMASK
#define PHMASK 0x1ff
#endif
    if (PHMASK & 2) {
        pg8::Gemm g{(const bt*)(ws + WS_H) + r0 * D, (const bt*)(ws + WS_WIN), MG, NPROJ, D, 0}; pg8::StaticOrder S; S.init(MG, NPROJ, GW, F.c, NXG, WGMG);
        pg8::EpiBf16 E{(bt*)(ws + WS_PROJ) + r0 * NPROJ, NPROJ};
        pg8::gemm_phase<pg8::EpiBf16, pg8::StaticOrder, true, true>(F.lds, g, S, E);
    }
    asm volatile("s_waitcnt vmcnt(0)" ::: "memory"); __syncthreads();
    if ((((F.c >> 3) & 3) == 3) && F.tid == 0) { __builtin_amdgcn_fence(__ATOMIC_RELEASE, "agent"); asm volatile("s_waitcnt vmcnt(0)" ::: "memory"); (void)xb_add(ctl + CW_HALO + 64 * (8 * F.grp + (F.c & 7)), 1u); }
    SBAR(1); STAMP(2);
    if ((F.c >> 3) == 0 && (F.c & 7) > 0) {
        if (F.tid == 0) { unsigned sp = 0u; unsigned* w = ctl + CW_HALO + 64 * (8 * F.grp + (F.c & 7) - 1);
            while (xb_ld(w) < 4u) { __builtin_amdgcn_s_sleep(2); if ((++sp & 255u) == 0u) { if (xb_ld(tmo)) break; if (sp > XB_SPIN_CAP) { atomicAdd(tmo, 1u); break; } } }
            __builtin_amdgcn_fence(__ATOMIC_ACQUIRE, "agent"); asm volatile("s_waitcnt vmcnt(0)" ::: "memory"); }
        __syncthreads();
    }
    if (PHMASK & 4) p2_mixer(F);
    SBAR(2);
    STAMP(3);
    if (PHMASK & 8) {
        int kpool = 256; asm volatile("" : "+s"(kpool));
        pg8::Gemm g{(const bt*)(ws + WS_POOLED) + (size_t)F.grp * 4 * MG * 256, (const bt*)(ws + WS_WPOOL), 4 * MG, 256, kpool, MG / 256}; SlabPoolOrder S{F.c};
        pg8::EpiPool E{(bt*)(ws + WS_MIXED) + r0 * D, D, F.pool_scale, (LAS float*)(F.lds + EPI_SCR_OFF), EPS, 5};
        pg8::gemm_phase<pg8::EpiPool, SlabPoolOrder, false, true>(F.lds, g, S, E);
    }
    SBAR(3); STAMP(4);
    if (PHMASK & 16) {
        pg8::Gemm g{(const bt*)(ws + WS_MIXED) + r0 * D, (const bt*)(ws + WS_WOUT), MG, D, D, 0}; pg8::StaticOrder S; S.init(MG, D, GW, F.c, NXG, WGMG);
        pg8::EpiBf16Stat E{(bt*)(ws + WS_MIXOUT) + r0 * D, D, (float*)(ws + WS_PART1) + r0 * 32};
        pg8::gemm_phase<pg8::EpiBf16Stat, pg8::StaticOrder, false, true>(F.lds, g, S, E);
    }
    SBAR(4); STAMP(5);
    if (F.tid == 0) (void)xb_add(ctl + CW_P4 + 64 * F.grp, 1u);
    if (PHMASK & 32) p5_resnorm(F);
    SBAR(5);
    if (F.tid == 0) { unsigned sp = 0u; unsigned* w = ctl + CW_P4 + 64 * F.grp;
        while (xb_ld(w) < (unsigned)GW) { __builtin_amdgcn_s_sleep(2); if ((++sp & 255u) == 0u) { if (xb_ld(tmo)) break; if (sp > XB_SPIN_CAP) { atomicAdd(tmo, 1u); break; } } } }
    __syncthreads();
    if (F.grp == 0) flag_wait(flagB, tmo);
    STAMP(6);
    if (PHMASK & 64) {
        pg8::Gemm g{(const bt*)(ws + WS_H) + r0 * D, (const bt*)(ws + WS_WGU), MG, 2 * FF, D, 0}; pg8::StaticOrder S; S.init(MG, 2 * FF, GW, F.c, NXG, WGMG);
        pg8::EpiSwiGLU E{(bt*)(ws + WS_ACT) + r0 * FF, FF};
        pg8::gemm_phase<pg8::EpiSwiGLU, pg8::StaticOrder, false, true>(F.lds, g, S, E);
    }
    SBAR(6); STAMP(7);
    if (PHMASK & 128) {
        pg8::Gemm g{(const bt*)(ws + WS_ACT) + r0 * FF, (const bt*)(ws + WS_WD), MG, D, FF, 0}; pg8::StaticOrder S; S.init(MG, D, GW, F.c, NXG, WGMG);
        pg8::EpiBf16Stat E{(bt*)(ws + WS_FF) + r0 * D, D, (float*)(ws + WS_PART2) + r0 * 32};
        pg8::gemm_phase<pg8::EpiBf16Stat, pg8::StaticOrder, false, true>(F.lds, g, S, E);
    }
    SBAR(7); STAMP(8);
    if (PHMASK & 256) p8_final(F);
    if (PROBE_B > PROBE_A) {
        asm volatile("s_waitcnt vmcnt(0)" ::: "memory"); __syncthreads(); STAMP(9);
        if (F.grp == 1 && F.c == 0 && F.tid == 0) {
            asm volatile("s_waitcnt vmcnt(0)" ::: "memory");
            const unsigned long long a = __hip_atomic_load(stamps + PROBE_G * 16 + PROBE_A, __ATOMIC_RELAXED, __HIP_MEMORY_SCOPE_AGENT), b = __hip_atomic_load(stamps + PROBE_G * 16 + PROBE_B, __ATOMIC_RELAXED, __HIP_MEMORY_SCOPE_AGENT);
            const unsigned long long span = (b > a && b - a < 400000ull) ? (b - a) * PROBE_MUL : 1000000ull;
            const unsigned long long t0 = __builtin_amdgcn_s_memrealtime();
            while (__builtin_amdgcn_s_memrealtime() - t0 < span) __builtin_amdgcn_s_sleep(8);
        }
    }
#undef BAR
#undef SBAR
#undef STAMP
}

extern "C" void kernel_launch(void* const* d_in, const int* in_sizes, int n_in, void* d_out, int out_size, void* d_ws, size_t ws_size, hipStream_t stream) {
    static int grid = 0;
    if (grid == 0) {
        if (n_in != 13 || in_sizes[0] != M * D || out_size != M * D || ws_size < WS_END) { fprintf(stderr, "kernel_launch: shape/workspace mismatch (n_in %d, in0 %d, out %d, ws %zu, need %zu); nothing launched\n", n_in, n_in > 0 ? in_sizes[0] : -1, out_size, ws_size, (size_t)WS_END); grid = -1; return; }
        int dev = 0, cus = 0, per_cu = 0;
        if (hipGetDevice(&dev) != hipSuccess || hipDeviceGetAttribute(&cus, hipDeviceAttributeMultiprocessorCount, dev) != hipSuccess) { fprintf(stderr, "kernel_launch: device query failed\n"); grid = -1; return; }
        if (hipFuncSetAttribute((const void*)mk_fwd, hipFuncAttributeMaxDynamicSharedMemorySize, LDS_BYTES) != hipSuccess) { fprintf(stderr, "kernel_launch: hipFuncSetAttribute failed\n"); grid = -1; return; }
        if (hipOccupancyMaxActiveBlocksPerMultiprocessor(&per_cu, (const void*)mk_fwd, NWAVES * 64, LDS_BYTES) != hipSuccess || per_cu < 1) { fprintf(stderr, "kernel_launch: occupancy query says %d blocks per CU\n", per_cu); per_cu = 1; }
        (void)hipGetLastError();
        if (cus * per_cu < NGRP * GW) { fprintf(stderr, "kernel_launch: needs %d co-resident workgroups, the device holds %d; nothing launched\n", NGRP * GW, cus * per_cu); grid = -1; return; }
        grid = NGRP * GW;
    }
    if (grid < 0) return;
    Args a{};
    for (int i = 0; i < 13; ++i) a.in[i] = (const float*)d_in[i];
    a.out = (float*)d_out; a.ws = (unsigned char*)d_ws;
    if (hipMemsetAsync((char*)d_ws + WS_CTL, 0, CTL_ZERO_BYTES, stream) != hipSuccess) { fprintf(stderr, "kernel_launch: hipMemsetAsync failed\n"); return; }
    hipLaunchKernelGGL(mk_fwd, dim3(grid), dim3(NWAVES * 64), LDS_BYTES, stream, a);
    const hipError_t e = hipPeekAtLastError();
    if (e != hipSuccess) fprintf(stderr, "kernel_launch: launch failed: %s (grid %d)\n", hipGetErrorString(e), grid);
}
```
